# Optimizing an MI355X kernel written in HIP

```python
import jax, jax.numpy as jnp
from jax import lax
import numpy as np

D_MODEL = 2048
BATCH = 4
SEQ = 2048
DEPTH = 1
DEC_BATCH = 128
DEC_SEQ = 8
PAST_LEN = 16384
PAGE_SIZE = 128

N_META = 16
W_A = D_MODEL // 2
HEAD_A = 64
H_A = W_A // HEAD_A
LORA_W = 64
LORA_A = 64
W_B = D_MODEL - W_A
H_B = 8
DK_B = W_B // H_B
CHUNK = 128
N_A_COLS = 4 * W_A + LORA_W + LORA_A
N_B_COLS = 4 * W_B
N_IN = N_A_COLS + N_B_COLS
ALPHA = (2.0 * DEPTH) ** 0.25
BETA = (8.0 * DEPTH) ** -0.25
ROPE_BASE = 10000.0
LN_EPS = 1e-5
GN_EPS_A = 64e-5
GN_EPS_B = 1e-5

kernel_name = "hymba_rwkv7_retention_deepnorm_step"


def _layer_norm(x, g, b):
    xf = x.astype(jnp.float32)
    mu = jnp.mean(xf, -1, keepdims=True)
    var = jnp.mean(jnp.square(xf - mu), -1, keepdims=True)
    return ((xf - mu) * lax.rsqrt(var + LN_EPS) * g.astype(jnp.float32) + b.astype(jnp.float32)).astype(x.dtype)


def _group_norm(x, n_heads, g, b, eps):
    shp = x.shape
    xh = x.astype(jnp.float32).reshape(shp[:-1] + (n_heads, shp[-1] // n_heads))
    mu = jnp.mean(xh, -1, keepdims=True)
    var = jnp.mean(jnp.square(xh - mu), -1, keepdims=True)
    xh = ((xh - mu) * lax.rsqrt(var + eps)).reshape(shp)
    return xh * g.astype(jnp.float32) + b.astype(jnp.float32)


def _rotary(x, pos):
    half = x.shape[-1] // 2
    inv = ROPE_BASE ** (-jnp.arange(half, dtype=jnp.float32) / half)
    ang = pos.astype(jnp.float32)[:, None] * inv[None, :]
    cos = jnp.cos(ang)[None, :, None, :]
    sin = jnp.sin(ang)[None, :, None, :]
    x1, x2 = x[..., :half], x[..., half:]
    return jnp.concatenate([x1 * cos - x2 * sin, x1 * sin + x2 * cos], axis=-1)


def _rwkv7_mixer(za, shift_in, s0, shift_mix, w0, w_up, a0, a_up, k_k, k_a, r_k, gn_g, gn_b):
    B, T, _ = za.shape
    f32 = jnp.float32
    za = za.astype(f32)
    prev = jnp.concatenate([shift_in.astype(f32)[:, None, :], za[:, :-1]], axis=1)
    zs = za + (prev - za) * shift_mix.astype(f32)
    r, k, v, g, zw, zx = jnp.split(zs, [W_A, 2 * W_A, 3 * W_A, 4 * W_A, 4 * W_A + LORA_W], axis=-1)
    w_logit = w0.astype(f32) + jnp.tanh(zw) @ w_up.astype(f32)
    log_w = -jnp.exp(-jax.nn.softplus(-w_logit) - 0.5)
    a = jax.nn.sigmoid(a0.astype(f32) + zx @ a_up.astype(f32))
    hd = lambda t: t.reshape(B, T, H_A, HEAD_A)
    kk = hd(k * k_k.astype(f32))
    kk = kk / jnp.maximum(jnp.sqrt(jnp.sum(kk * kk, -1, keepdims=True)), 1e-12)
    k = k * (1.0 + (a - 1.0) * k_a.astype(f32))
    rh, kh, vh, ah, wh = hd(r), hd(k), hd(v), hd(a), jnp.exp(hd(log_w))

    def step(S, inp):
        r_t, w_t, k_t, v_t, kk_t, b_t = inp
        sa = jnp.einsum('bhvk,bhk->bhv', S, -kk_t)
        S = S * w_t[:, :, None, :] + sa[..., None] * b_t[:, :, None, :] + v_t[..., None] * k_t[:, :, None, :]
        return S, jnp.einsum('bhvk,bhk->bhv', S, r_t)

    xs = tuple(jnp.swapaxes(t, 0, 1) for t in (rh, wh, kh, vh, kk, kk * ah))
    s_T, o = lax.scan(step, s0.astype(f32), xs)
    o = _group_norm(jnp.swapaxes(o, 0, 1).reshape(B, T, W_A), H_A, gn_g, gn_b, GN_EPS_A)
    bonus = (jnp.sum(rh * kh * r_k.astype(f32), -1, keepdims=True) * vh).reshape(B, T, W_A)
    return (o + bonus) * jax.nn.silu(g), s_T, za[:, -1]


def _retention_block(S, q, k, v, log_g):
    C = q.shape[1]
    i = jnp.arange(C, dtype=jnp.float32)
    diff = i[:, None] - i[None, :]
    dmask = jnp.where(diff >= 0, jnp.exp(jnp.maximum(diff, 0.0)[None] * log_g[:, None, None]), 0.0)
    scores = jnp.einsum('bihd,bjhd->bhij', q, k) * dmask[None]
    inner = jnp.einsum('bhij,bjhe->bihe', scores, v)
    q_dec = q * jnp.exp((i + 1.0)[:, None] * log_g[None, :])[None, :, :, None]
    cross = jnp.einsum('bihd,bhde->bihe', q_dec, S)
    k_dec = k * jnp.exp((C - 1.0 - i)[:, None] * log_g[None, :])[None, :, :, None]
    S = jnp.exp(C * log_g)[None, :, None, None] * S + jnp.einsum('bjhd,bjhe->bhde', k_dec, v)
    return S, inner + cross


def _retention_blocks(S, q, k, v, log_g, block):
    B, T, H, _ = q.shape
    n = T // block
    xs = tuple(jnp.swapaxes(t.reshape(B, n, block, H, t.shape[-1]), 0, 1) for t in (q, k, v))
    S, o = lax.scan(lambda s, qkv: _retention_block(s, qkv[0], qkv[1], qkv[2], log_g), S, xs)
    return S, jnp.swapaxes(o, 0, 1).reshape(B, T, H, -1)


def _retention_mixer(zb, pos, s0, lead, block, gn_g, gn_b):
    B, T, _ = zb.shape
    f32 = jnp.float32
    q, k, v, g = jnp.split(zb.astype(f32), 4, axis=-1)
    hd = lambda t: t.reshape(B, T, H_B, DK_B)
    q = _rotary(hd(q), pos)
    k = _rotary(hd(k), pos) * (DK_B ** -0.5)
    v = hd(v)
    log_g = jnp.log1p(-jnp.exp2(-5.0 - jnp.arange(H_B, dtype=f32)))
    S = s0.astype(f32)
    outs = []
    if lead > 0:
        S, o_lead = _retention_block(S, q[:, :lead], k[:, :lead], v[:, :lead], log_g)
        outs.append(o_lead)
    S, o_rest = _retention_blocks(S, q[:, lead:], k[:, lead:], v[:, lead:], log_g, block)
    outs.append(o_rest)
    o = jnp.concatenate(outs, axis=1).reshape(B, T, W_B)
    o = _group_norm(o, H_B, gn_g, gn_b, GN_EPS_B)
    return o * jax.nn.silu(g), S


def _layer(x, pos, shift_in, s_a, s_b, lead, block, w_in, w_out, shift_mix, w0, w_up, a0, a_up,
           k_k, k_a, r_k, gn_a_g, gn_a_b, gn_b_g, gn_b_b, ln_g, ln_b):
    z = jnp.einsum('btd,dn->btn', x, w_in)
    o_a, s_a, shift = _rwkv7_mixer(z[..., :N_A_COLS], shift_in, s_a, shift_mix, w0, w_up, a0, a_up,
                                   k_k, k_a, r_k, gn_a_g, gn_a_b)
    o_b, s_b = _retention_mixer(z[..., N_A_COLS:], pos, s_b, lead, block, gn_b_g, gn_b_b)
    h = jnp.einsum('btc,cd->btd', jnp.concatenate([o_a, o_b], axis=-1).astype(x.dtype), w_out)
    y = _layer_norm(ALPHA * x + h, ln_g, ln_b)
    return y, s_a, shift, s_b


def _run_trunk(x, pos, s_rwkv, s_shift, s_ret, lead, block, w_in, w_out, shift_mix, w0, w_up, a0, a_up,
               k_k, k_a, r_k, gn_a_g, gn_a_b, gn_b_g, gn_b_b, ln_g, ln_b):
    new_rwkv, new_shift, new_ret = [], [], []
    for l in range(DEPTH):
        x, sa, sh, sb = _layer(x, pos, s_shift[l], s_rwkv[l], s_ret[l], lead, block, w_in[l], w_out[l],
                               shift_mix[l], w0[l], w_up[l], a0[l], a_up[l], k_k[l], k_a[l], r_k[l],
                               gn_a_g[l], gn_a_b[l], gn_b_g[l], gn_b_b[l], ln_g[l], ln_b[l])
        new_rwkv.append(sa.astype(x.dtype))
        new_shift.append(sh.astype(x.dtype))
        new_ret.append(sb.astype(x.dtype))
    return x, jnp.stack(new_rwkv), jnp.stack(new_shift), jnp.stack(new_ret)


def setup_inputs(seed: int = 0) -> dict:
    key = jax.random.key(seed)
    ks = jax.random.split(key, 24)
    f32 = jnp.float32
    nrm = lambda kk, shape, s: s * jax.random.normal(kk, shape, f32)
    return {
        'x_prompt': nrm(ks[0], (BATCH, SEQ, D_MODEL), 1.0),
        'x_sample': nrm(ks[1], (DEC_BATCH, DEC_SEQ, D_MODEL), 1.0),
        'state_rwkv': nrm(ks[2], (DEPTH, DEC_BATCH, H_A, HEAD_A, HEAD_A), 0.5),
        'state_shift': nrm(ks[3], (DEPTH, DEC_BATCH, N_A_COLS), 1.0),
        'state_ret': nrm(ks[4], (DEPTH, DEC_BATCH, H_B, DK_B, DK_B), 1.0),
        'meta_tokens': nrm(ks[5], (N_META, D_MODEL), 1.0),
        'w_in': nrm(ks[6], (DEPTH, D_MODEL, N_IN), D_MODEL ** -0.5),
        'w_out': nrm(ks[7], (DEPTH, W_A + W_B, D_MODEL), BETA * (W_A + W_B) ** -0.5),
        'shift_mix': jax.random.uniform(ks[8], (DEPTH, N_A_COLS), f32),
        'w0': jax.random.uniform(ks[9], (DEPTH, W_A), f32, -6.5, -1.5),
        'w_up': nrm(ks[10], (DEPTH, LORA_W, W_A), 0.5 * LORA_W ** -0.5),
        'a0': nrm(ks[11], (DEPTH, W_A), 0.1),
        'a_up': nrm(ks[12], (DEPTH, LORA_A, W_A), 0.5 * LORA_A ** -0.5),
        'k_k': 0.85 + nrm(ks[13], (DEPTH, W_A), 0.02),
        'k_a': 1.0 + nrm(ks[14], (DEPTH, W_A), 0.02),
        'r_k': nrm(ks[15], (DEPTH, H_A, HEAD_A), 0.1),
        'gn_a_g': 1.0 + nrm(ks[16], (DEPTH, W_A), 0.01),
        'gn_a_b': nrm(ks[17], (DEPTH, W_A), 0.01),
        'gn_b_g': 1.0 + nrm(ks[18], (DEPTH, W_B), 0.01),
        'gn_b_b': nrm(ks[19], (DEPTH, W_B), 0.01),
        'ln_g': 1.0 + nrm(ks[20], (DEPTH, D_MODEL), 0.01),
        'ln_b': nrm(ks[21], (DEPTH, D_MODEL), 0.01),
    }


def reference(x_prompt, x_sample, state_rwkv, state_shift, state_ret, meta_tokens, w_in, w_out, shift_mix,
              w0, w_up, a0, a_up, k_k, k_a, r_k, gn_a_g, gn_a_b, gn_b_g, gn_b_b, ln_g, ln_b):
    weights = (w_in, w_out, shift_mix, w0, w_up, a0, a_up, k_k, k_a, r_k, gn_a_g, gn_a_b, gn_b_g, gn_b_b, ln_g, ln_b)
    dt = x_prompt.dtype
    bp = x_prompt.shape[0]
    meta = jnp.broadcast_to(meta_tokens.astype(dt)[None], (bp, N_META, D_MODEL))
    xp = jnp.concatenate([meta, x_prompt], axis=1)
    pos_p = jnp.arange(xp.shape[1], dtype=jnp.int32)
    z_rwkv = jnp.zeros((DEPTH, bp, H_A, HEAD_A, HEAD_A), dt)
    z_shift = jnp.zeros((DEPTH, bp, N_A_COLS), dt)
    z_ret = jnp.zeros((DEPTH, bp, H_B, DK_B, DK_B), dt)
    yp, rwkv_p, shift_p, ret_p = _run_trunk(xp, pos_p, z_rwkv, z_shift, z_ret, N_META, CHUNK, *weights)
    y_prompt = yp[:, N_META:]
    pos_s = PAST_LEN + jnp.arange(x_sample.shape[1], dtype=jnp.int32)
    y_sample, rwkv_s, shift_s, ret_s = _run_trunk(x_sample, pos_s, state_rwkv, state_shift, state_ret,
                                                  0, x_sample.shape[1], *weights)
    return (y_prompt, y_sample, rwkv_p, shift_p, ret_p, rwkv_s, shift_s, ret_s)
```

```cpp
#include <hip/hip_runtime.h>
#include <cstdio>
#include <cstdint>
#ifndef MK_LAUNCHES
#define MK_LAUNCHES 1
#endif
__device__ const double ROPE_INV[64] = { 1, 0.86596432336006535, 0.74989420933245587, 0.64938163157621132, 0.56234132519034907, 0.48696752516586311, 0.42169650342858223, 0.36517412725483772, 0.31622776601683794, 0.27384196342643613, 0.23713737056616552, 0.20535250264571461, 0.17782794100389229, 0.15399265260594919, 0.1333521432163324, 0.11547819846894582, 0.10000000000000001, 0.086596432336006529, 0.074989420933245579, 0.064938163157621132, 0.056234132519034911, 0.048696752516586311, 0.042169650342858224, 0.036517412725483769, 0.031622776601683791, 0.027384196342643614, 0.023713737056616554, 0.02053525026457146, 0.017782794100389229, 0.015399265260594919, 0.013335214321633241, 0.011547819846894581, 0.01, 0.0086596432336006543, 0.0074989420933245579, 0.006493816315762113, 0.005623413251903491, 0.004869675251658631, 0.0042169650342858229, 0.0036517412725483771, 0.0031622776601683794, 0.0027384196342643613, 0.0023713737056616554, 0.002053525026457146, 0.0017782794100389228, 0.001539926526059492, 0.0013335214321633241, 0.0011547819846894581, 0.001, 0.00086596432336006539, 0.00074989420933245586, 0.00064938163157621134, 0.0005623413251903491, 0.0004869675251658631, 0.00042169650342858224, 0.0003651741272548377, 0.00031622776601683794, 0.00027384196342643611, 0.00023713737056616554, 0.00020535250264571461, 0.00017782794100389227, 0.00015399265260594919, 0.0001333521432163324, 0.00011547819846894582 };
namespace pg8 {
#define PG8_LAS __attribute__((address_space(3)))
typedef unsigned short bf16_t;
typedef short bf16x8 __attribute__((ext_vector_type(8)));
typedef float f32x4 __attribute__((ext_vector_type(4)));
typedef unsigned u32x4 __attribute__((ext_vector_type(4)));
constexpr int BM = 256, BK = 64, HALF = 128, HTB = HALF * BK * 2  , STAGE_BYTES = 8 * HTB, NXCD = 8, WGM = 8;

__host__ __device__ __forceinline__ int lds_byte(int r, int c) { const int st = (r >> 4) * 2 + (c >> 5), rr = r & 15, cc = c & 31, ob = rr * 64 + cc * 2; return st * 1024 + (ob ^ (((ob >> 9) & 1) << 5)); }
__host__ __device__ __forceinline__ void stage_rc(int b, int& R, int& C) { const int st = b / 1024, sb = b % 1024, swz = sb ^ (((sb >> 9) & 1) << 5); R = (st >> 1) * 16 + swz / 64; C = (st & 1) * 32 + (swz % 64) / 2; }
__host__ __device__ __forceinline__ int perm32(int rho) { const int n = rho >> 4, i = rho & 15; return 8 * (i >> 2) + 4 * n + (i & 3); }

struct Unit { int pm, pn; };
struct Gemm { const bf16_t* A; const bf16_t* Bt; int M, N, K; };

struct StaticOrder {
    int nM, nN, nwg, G, c;
    __host__ __device__ void init(int M, int N, int G_, int c_) { nM = M / BM; nN = N / BM; nwg = nM * nN; G = G_; c = c_; }
    __host__ __device__ bool next(int i, Unit& u) const {
        const long L = (long)i * G + c; if (L >= nwg) return false;
        int wgid = (int)L; { const int q = nwg / NXCD, r = nwg % NXCD, xcd = wgid % NXCD, off = wgid / NXCD; wgid = (xcd < r ? xcd * (q + 1) : r * (q + 1) + (xcd - r) * q) + off; }
        const int nig = WGM * nN, gid = wgid / nig, fm = gid * WGM, gsz = (nM - fm) < WGM ? (nM - fm) : WGM;
        u.pm = fm + ((wgid % nig) % gsz); u.pn = (wgid % nig) / gsz; return true;
    }
    __device__ __forceinline__ void a_ready(const Unit&) const {}
    __device__ __forceinline__ void done(const Unit&) const {}
};

__device__ __forceinline__ unsigned cvt_pk_bf16(float lo, float hi) { unsigned r; asm volatile("v_cvt_pk_bf16_f32 %0, %1, %2" : "=v"(r) : "v"(lo), "v"(hi)); return r; }
typedef float f32x2 __attribute__((ext_vector_type(2)));

struct EpiZ {
    static constexpr bool PERM = true, AFTER_DRAIN = false;
    bf16_t* ZB; bf16_t* ZA;
    __device__ __forceinline__ void operator()(const f32x4 (&acc)[2][2][4][2], const Unit& u, int wr, int wc, int fr, int fq) const {
        const int row0 = u.pm * BM + wr * 64 + fr;
        bf16_t* base; int ldc, colt;
        if (u.pn < 16) { base = ZB; ldc = 4096; colt = u.pn * BM; } else { base = ZA; ldc = 4352; colt = (u.pn - 16) * BM; }
        const int col0 = colt + wc * 32 + 8 * fq;
#pragma unroll
        for (int ai = 0; ai < 2; ++ai)
#pragma unroll
            for (int m = 0; m < 4; ++m) { bf16_t* rowp = base + (size_t)(row0 + ai * HALF + m * 16) * ldc + col0;
#pragma unroll
                for (int bj = 0; bj < 2; ++bj) { const f32x4 v0 = acc[ai][bj][m][0], v1 = acc[ai][bj][m][1];
                    u32x4 w; w.x = cvt_pk_bf16(v0[0], v0[1]); w.y = cvt_pk_bf16(v0[2], v0[3]); w.z = cvt_pk_bf16(v1[0], v1[1]); w.w = cvt_pk_bf16(v1[2], v1[3]);
                    *(u32x4*)(rowp + bj * HALF) = w; } }
    }
};
struct EpiY {
    static constexpr bool PERM = false, AFTER_DRAIN = false;
    const float* xp; const float* xs; float* out; float alpha;
    __device__ __forceinline__ void operator()(const f32x4 (&acc)[2][2][4][2], const Unit& u, int wr, int wc, int fr, int fq) const {
#pragma unroll
        for (int ai = 0; ai < 2; ++ai)
#pragma unroll
            for (int m = 0; m < 4; ++m) {
                const int zrow = u.pm * BM + ai * HALF + wr * 64 + m * 16 + fr; int yrow = -1;
                if (zrow < 8256) { const int b = zrow / 2064, t = zrow - b * 2064; if (t >= 16) yrow = b * 2048 + t - 16; }
                else if (zrow < 9280) yrow = zrow - 64;
                if (yrow >= 0) {
                    const float* xsrc = yrow < 8192 ? xp + (size_t)yrow * 2048 : xs + (size_t)(yrow - 8192) * 2048; float* o = out + (size_t)yrow * 2048;
#pragma unroll
                    for (int bj = 0; bj < 2; ++bj)
#pragma unroll
                        for (int n = 0; n < 2; ++n) { const int col = u.pn * BM + bj * HALF + wc * 32 + n * 16 + 4 * fq;
                            const f32x4 xv = *(const f32x4*)(xsrc + col); *(f32x4*)(o + col) = xv * alpha + acc[ai][bj][m][n]; }
                }
            }
    }
};
template <class Epi, class Sched, bool ALIGN_EPI = false, bool SP2 = false>
__device__ __forceinline__ void gemm_phase(PG8_LAS unsigned char* lds, const Gemm g, const Sched& S, const Epi& E) {
    const int tid = threadIdx.x, wid = __builtin_amdgcn_readfirstlane(tid >> 6), lane = tid & 63, wr = wid >> 2, wc = wid & 3, fr = lane & 15, fq = lane >> 4;
    const int K = g.K, nt = K / BK;
    unsigned voffA[2], voffB[2];
#pragma unroll
    for (int i = 0; i < 2; ++i) { int R, C; stage_rc(tid * 16 + i * 8192, R, C); const int Rb = Epi::PERM ? ((R & ~31) + perm32(R & 31)) : R;
        voffA[i] = (unsigned)(R * K + C) * 2u; voffB[i] = (unsigned)(Rb * K + C) * 2u; }
    const size_t kstep = (size_t)(BK * 2);
    const size_t hstep = (size_t)HALF * K * 2;
    const size_t tstep = 2 * hstep;
    const unsigned ldsw = (unsigned)wid * 1024u;
    const int aoff = lds_byte(wr * 64 + fr, fq * 8), boff = lds_byte(wc * 32 + fr, fq * 8);
#define PG8_SA(b, h) (((b) * 2 + (h)) * HTB)
#define PG8_SB(b, h) ((4 + (b) * 2 + (h)) * HTB)
#define PG8_STAGE(bufoff, gbase, voff) do { _Pragma("unroll") for (int _i = 0; _i < 2; ++_i) \
        __builtin_amdgcn_global_load_lds((const unsigned*)((const char*)(gbase) + (voff)[_i]), (PG8_LAS unsigned*)(lds + (bufoff) + ldsw + _i * 8192), 16, 0, 0); } while (0)
#define PG8_LDA(dst, b, h) do { _Pragma("unroll") for (int m = 0; m < 4; ++m) _Pragma("unroll") for (int k = 0; k < 2; ++k) dst[m][k] = *(const PG8_LAS bf16x8*)(lds + PG8_SA(b, h) + aoff + m * 2048 + k * 1024); } while (0)
#define PG8_LDB(dst, b, h) do { _Pragma("unroll") for (int n = 0; n < 2; ++n) _Pragma("unroll") for (int k = 0; k < 2; ++k) dst[n][k] = *(const PG8_LAS bf16x8*)(lds + PG8_SB(b, h) + boff + n * 2048 + k * 1024); } while (0)
#define PG8_MMA(ai, bj, At, Bt) do { __builtin_amdgcn_s_setprio(1); _Pragma("unroll") for (int m = 0; m < 4; ++m) _Pragma("unroll") for (int n = 0; n < 2; ++n) _Pragma("unroll") for (int k = 0; k < 2; ++k) \
        acc[ai][bj][m][n] = __builtin_amdgcn_mfma_f32_16x16x32_bf16(Bt[n][k], At[m][k], acc[ai][bj][m][n], 0, 0, 0); __builtin_amdgcn_s_setprio(0); } while (0)
#define PG8_WAIT_V(n) asm volatile("s_waitcnt vmcnt(" #n ")" ::: "memory")
#define PG8_WAIT_L(n) asm volatile("s_waitcnt lgkmcnt(" #n ")" ::: "memory")
#define PG8_BAR __builtin_amdgcn_s_barrier()
#define PG8_SCHED __builtin_amdgcn_sched_barrier(0)
    Unit cur, nxt; int ui = 0;
    if (!S.next(0, cur)) return;
    f32x4 acc[2][2][4][2];
#pragma unroll
    for (int a = 0; a < 2; ++a)
#pragma unroll
        for (int b = 0; b < 2; ++b)
#pragma unroll
            for (int m = 0; m < 4; ++m)
#pragma unroll
                for (int n = 0; n < 2; ++n) acc[a][b][m][n] = (f32x4){0.f, 0.f, 0.f, 0.f};
    bf16x8 At[4][2], B0[2][2], B1[2][2];
    const char* cA = (const char*)g.A + (size_t)cur.pm * tstep; const char* cB = (const char*)g.Bt + (size_t)cur.pn * tstep;
    S.a_ready(cur);
    if constexpr (SP2) {
        PG8_STAGE(PG8_SB(0, 0), cB, voffB); PG8_STAGE(PG8_SB(0, 1), cB + hstep, voffB); PG8_STAGE(PG8_SA(0, 0), cA, voffA); PG8_STAGE(PG8_SA(0, 1), cA + hstep, voffA);
        if (wr == 1) PG8_BAR;
        PG8_WAIT_V(2); PG8_BAR;
        PG8_STAGE(PG8_SB(1, 0), cB + kstep, voffB); PG8_STAGE(PG8_SA(1, 0), cA + kstep, voffA); PG8_STAGE(PG8_SB(1, 1), cB + hstep + kstep, voffB);
        PG8_WAIT_V(6); PG8_BAR;
    } else {
        PG8_STAGE(PG8_SB(0, 0), cB, voffB); PG8_STAGE(PG8_SA(0, 0), cA, voffA); PG8_STAGE(PG8_SB(0, 1), cB + hstep, voffB); PG8_STAGE(PG8_SA(0, 1), cA + hstep, voffA);
        if (wr == 1) PG8_BAR;
        PG8_WAIT_V(4); PG8_BAR;
        PG8_STAGE(PG8_SB(1, 0), cB + kstep, voffB); PG8_STAGE(PG8_SA(1, 0), cA + kstep, voffA); PG8_STAGE(PG8_SB(1, 1), cB + hstep + kstep, voffB);
        PG8_WAIT_V(6); PG8_BAR;
    }
    for (;;) {
        const bool has_next = S.next(ui + 1, nxt);
        const char* nA = has_next ? (const char*)g.A + (size_t)nxt.pm * tstep : cA; const char* nB = has_next ? (const char*)g.Bt + (size_t)nxt.pn * tstep : cB;
        for (int t = 0; t < nt; t += 2) {
            const bool last = (t == nt - 2);
            const char* a1 = cA + (size_t)(t + 1) * kstep;
            const char* a2 = last ? nA : cA + (size_t)(t + 2) * kstep; const char* b2 = last ? nB : cB + (size_t)(t + 2) * kstep;
            const char* a3 = a2 + kstep; const char* b3 = b2 + kstep;
            if (last && has_next) S.a_ready(nxt);
            if constexpr (SP2) {
            PG8_LDB(B0, 0, 0); PG8_LDB(B1, 0, 1); PG8_SCHED; PG8_LDA(At, 0, 0); PG8_STAGE(PG8_SA(1, 1), a1 + hstep, voffA);
            PG8_WAIT_V(8); PG8_WAIT_L(0); PG8_BAR; PG8_MMA(0, 0, At, B0); PG8_MMA(0, 1, At, B1); PG8_BAR; PG8_SCHED;
            PG8_LDA(At, 0, 1); PG8_STAGE(PG8_SB(0, 0), b2, voffB); PG8_STAGE(PG8_SB(0, 1), b2 + hstep, voffB); PG8_STAGE(PG8_SA(0, 0), a2, voffA);
            PG8_WAIT_V(8); PG8_WAIT_L(0); PG8_BAR; PG8_MMA(1, 0, At, B0); PG8_MMA(1, 1, At, B1); PG8_BAR; PG8_SCHED;
            PG8_LDB(B0, 1, 0); PG8_LDB(B1, 1, 1); PG8_SCHED; PG8_LDA(At, 1, 0); PG8_STAGE(PG8_SA(0, 1), a2 + hstep, voffA);
            PG8_WAIT_V(8); PG8_WAIT_L(0); PG8_BAR; PG8_MMA(0, 0, At, B0); PG8_MMA(0, 1, At, B1); PG8_BAR; PG8_SCHED;
            PG8_LDA(At, 1, 1); PG8_STAGE(PG8_SB(1, 0), b3, voffB); PG8_STAGE(PG8_SB(1, 1), b3 + hstep, voffB); PG8_STAGE(PG8_SA(1, 0), a3, voffA);
            PG8_WAIT_V(8); PG8_WAIT_L(0); PG8_BAR; PG8_MMA(1, 0, At, B0); PG8_MMA(1, 1, At, B1); PG8_BAR; PG8_SCHED;
            } else {
            PG8_LDB(B0, 0, 0); PG8_SCHED; PG8_LDA(At, 0, 0); PG8_STAGE(PG8_SA(1, 1), a1 + hstep, voffA);
            PG8_WAIT_L(8); PG8_BAR; PG8_WAIT_L(0); PG8_MMA(0, 0, At, B0); PG8_BAR; PG8_SCHED;
            PG8_LDB(B1, 0, 1); PG8_STAGE(PG8_SB(0, 0), b2, voffB);
            PG8_BAR; PG8_WAIT_L(0); PG8_MMA(0, 1, At, B1); PG8_BAR;
            PG8_LDA(At, 0, 1); PG8_STAGE(PG8_SA(0, 0), a2, voffA);
            PG8_BAR; PG8_WAIT_L(0); PG8_MMA(1, 0, At, B0); PG8_BAR; PG8_SCHED;
            PG8_STAGE(PG8_SB(0, 1), b2 + hstep, voffB);
            PG8_WAIT_V(6); PG8_BAR; PG8_MMA(1, 1, At, B1); PG8_BAR;
            PG8_LDB(B0, 1, 0); PG8_SCHED; PG8_LDA(At, 1, 0); PG8_STAGE(PG8_SA(0, 1), a2 + hstep, voffA);
            PG8_WAIT_L(8); PG8_BAR; PG8_WAIT_L(0); PG8_MMA(0, 0, At, B0); PG8_BAR; PG8_SCHED;
            PG8_LDB(B1, 1, 1); PG8_STAGE(PG8_SB(1, 0), b3, voffB);
            PG8_BAR; PG8_WAIT_L(0); PG8_MMA(0, 1, At, B1); PG8_BAR;
            PG8_LDA(At, 1, 1); PG8_STAGE(PG8_SA(1, 0), a3, voffA);
            PG8_BAR; PG8_WAIT_L(0); PG8_MMA(1, 0, At, B0); PG8_BAR; PG8_SCHED;
            PG8_STAGE(PG8_SB(1, 1), b3 + hstep, voffB);
            PG8_WAIT_V(6); PG8_BAR; PG8_MMA(1, 1, At, B1); PG8_BAR;
            }
        }
        if constexpr (ALIGN_EPI) { if (wr == 0) PG8_BAR; }
        if constexpr (!Epi::AFTER_DRAIN) { E(acc, cur, wr, wc, fr, fq); S.done(cur); }
        if (!has_next) break;
#pragma unroll
        for (int a = 0; a < 2; ++a)
#pragma unroll
            for (int b = 0; b < 2; ++b)
#pragma unroll
                for (int m = 0; m < 4; ++m)
#pragma unroll
                    for (int n = 0; n < 2; ++n) acc[a][b][m][n] = (f32x4){0.f, 0.f, 0.f, 0.f};
        cur = nxt; cA = nA; cB = nB; ++ui;
        if constexpr (ALIGN_EPI) { if (wr == 1) PG8_BAR; }
    }
    PG8_WAIT_V(0);
    if constexpr (!ALIGN_EPI) { if (wr == 0) PG8_BAR; }
    PG8_BAR;
    if constexpr (Epi::AFTER_DRAIN) { E.fused(acc, cur, wr, wc, fr, fq, lds, wid, lane); S.done(cur); }
#undef PG8_SA
#undef PG8_SB
#undef PG8_STAGE
#undef PG8_LDA
#undef PG8_LDB
#undef PG8_MMA
#undef PG8_WAIT_V
#undef PG8_WAIT_L
#undef PG8_BAR
#undef PG8_SCHED
}
}

#define LAS __attribute__((address_space(3)))
#define XB_TMO      128
#define XB_XCNT(j)  (256  + 64 * (j))
#define XB_XSUB(j)  (1280 + 64 * (j))
#define XB_XGEN(j)  (2304 + 64 * (j))
#define XB_TOP      3328
#define XB_TOPGEN   3392
#define XCD_BAR_WORDS 3456
#define XB_SPIN_CAP (1u << 18)

__device__ __forceinline__ unsigned xb_ld(unsigned* p)              { return __hip_atomic_load(p, __ATOMIC_RELAXED, __HIP_MEMORY_SCOPE_AGENT); }
__device__ __forceinline__ unsigned xb_add(unsigned* p, unsigned v) { return __hip_atomic_fetch_add(p, v, __ATOMIC_RELAXED, __HIP_MEMORY_SCOPE_AGENT); }
__device__ __forceinline__ unsigned xb_xcc_id() { return (unsigned)__builtin_amdgcn_s_getreg((3 << 11) | 20) & 0xFu; }
#define XB_SPIN(cond, bar) do { unsigned _sp = 0; while (cond) { __builtin_amdgcn_s_sleep(1); \
    if ((++_sp & 255u) == 0u) { if (xb_ld(&(bar)[XB_TMO])) break; if (_sp > XB_SPIN_CAP) { atomicAdd(&(bar)[XB_TMO], 1u); break; } } } } while (0)

struct XcdBarrier {
    unsigned* bar; unsigned x;
    volatile LAS unsigned* st;
};

__device__ __forceinline__ XcdBarrier xcd_barrier_post(unsigned* bar, volatile LAS unsigned* st) {
    XcdBarrier b; b.bar = bar; b.x = xb_xcc_id(); b.st = st;
    if (threadIdx.x == 0) (void)xb_add(&bar[XB_XCNT(b.x)], 1u);
    return b;
}
__device__ __forceinline__ void xcd_barrier_complete(unsigned* bar, unsigned x, unsigned& nloc, unsigned& nx) {
    const unsigned G = gridDim.x * gridDim.y * gridDim.z;
    unsigned sum, cnt, mine, sp = 0u;
    for (;;) {
        sum = 0u; cnt = 0u; mine = 0u;
#pragma unroll
        for (unsigned j = 0; j < 16; ++j) { const unsigned c = xb_ld(&bar[XB_XCNT(j)]); sum += c; cnt += (c > 0u) ? 1u : 0u; mine = (j == x) ? c : mine; }
        if (sum == G) break;
        __builtin_amdgcn_s_sleep(1);
        if ((++sp & 255u) == 0u) { if (xb_ld(&bar[XB_TMO])) break; if (sp > XB_SPIN_CAP) { atomicAdd(&bar[XB_TMO], 1u); break; } }
    }
    nloc = mine > 0u ? mine : 1u; nx = cnt > 0u ? cnt : 1u;
}

__device__ __forceinline__ void xcd_barrier(const XcdBarrier& b) {
    asm volatile("s_waitcnt vmcnt(0)" ::: "memory");
    __syncthreads();
    if (threadIdx.x == 0) {
        unsigned* bar = b.bar;
        __builtin_amdgcn_s_waitcnt(0);
        unsigned nloc = b.st[0], nx = b.st[1];
        if (nloc == 0u) { xcd_barrier_complete(bar, b.x, nloc, nx); b.st[0] = nloc; b.st[1] = nx; }
        const unsigned old = xb_add(&bar[XB_XSUB(b.x)], 1u);
        const unsigned gen = old / nloc;
        if (old + 1u == (gen + 1u) * nloc) {
            __builtin_amdgcn_fence(__ATOMIC_RELEASE, "agent");
            asm volatile("s_waitcnt vmcnt(0)" ::: "memory");
            const unsigned og = xb_add(&bar[XB_TOP], 1u);
            const unsigned tg = og / nx;
            if (og + 1u == (tg + 1u) * nx) xb_add(&bar[XB_TOPGEN], 1u);
            else XB_SPIN(xb_ld(&bar[XB_TOPGEN]) == tg, bar);
            __builtin_amdgcn_fence(__ATOMIC_ACQUIRE, "agent");
            xb_add(&bar[XB_XGEN(b.x)], 1u);
            asm volatile("s_waitcnt vmcnt(0)" ::: "memory");
        } else {
            XB_SPIN(xb_ld(&bar[XB_XGEN(b.x)]) == gen, bar);
            __builtin_amdgcn_fence(__ATOMIC_ACQUIRE, "agent");
            asm volatile("s_waitcnt vmcnt(0)" ::: "memory");
        }
    }
    __syncthreads();
}

constexpr int D_MODEL = 2048, TP = 2064  , MPR = 4 * TP  , MSA = 1024, MROWS = MPR + MSA  , MPAD = 9472;
constexpr int NA = 4224, NAP = 4352, NB = 4096, NPAD = NAP + NB  , YROWS = 9216;
constexpr float ALPHA = 1.189207115002721f;
constexpr float LN_EPS = 1e-5f, GN_EPS_A = 64e-5f, GN_EPS_B = 1e-5f;
constexpr size_t O_YP = 0, O_YS = 16777216, O_RWKVP = 18874368, O_SHIFTP = 19136512, O_RETP = 19153408, O_RWKVS = 19677696, O_SHIFTS = 28066304, O_RETS = 28606976, O_END = 45384192;
constexpr size_t WS_CTL = 0, CTL_ZERO_BYTES = 1u << 20;
constexpr size_t WS_ZB = 1u << 20;
constexpr size_t WS_ZA = WS_ZB + (size_t)MPAD * NB * 2;
constexpr size_t WS_WOUT = WS_ZA + (size_t)MPAD * NAP * 2;
constexpr size_t WS_ROPE = WS_WOUT + (size_t)2048 * 2048 * 2;
constexpr size_t WS_W = WS_ROPE + (size_t)2072 * 64 * 8;
constexpr size_t WS_A = WS_W + (size_t)MROWS * 1024 * 4;
constexpr size_t WS_GATE = WS_A + (size_t)MROWS * 1024 * 2;
constexpr size_t WS_BONUS = WS_GATE + (size_t)MROWS * 1024 * 2;
constexpr size_t WS_END = WS_BONUS + (size_t)MROWS * 1024 * 2;
constexpr size_t OB_XB = 0;
constexpr size_t OB_WIN = O_RETS * 4;

constexpr int LDS_BYTES = 147456, MISC_OFF = 131072 + 320;
constexpr int CW_BAR = 4096;


typedef unsigned short bf16;
typedef unsigned v4u __attribute__((ext_vector_type(4)));
typedef unsigned v2u __attribute__((ext_vector_type(2)));
typedef float f32x4 __attribute__((ext_vector_type(4)));
typedef float f32x2 __attribute__((ext_vector_type(2)));
#define LDS_WAIT() asm volatile("s_waitcnt lgkmcnt(0)" ::: "memory")
__device__ __forceinline__ float bf2f(unsigned b) { return __uint_as_float(b << 16); }
__device__ __forceinline__ unsigned f2bf(float f) { unsigned u = __float_as_uint(f); return (u + 0x7fffu + ((u >> 16) & 1u)) >> 16; }
__device__ __forceinline__ unsigned pk2(float lo, float hi) { return f2bf(lo) | (f2bf(hi) << 16); }
__device__ __forceinline__ float sigmoidf_(float x) { return 1.0f / (1.0f + __expf(-x)); }
__device__ __forceinline__ float tanh_(float x) { return 1.0f - 2.0f / (1.0f + __expf(2.0f * x)); }

template <int CTRL> __device__ __forceinline__ float dpp_f(float x) { return __builtin_bit_cast(float, __builtin_amdgcn_update_dpp(0, __builtin_bit_cast(int, x), CTRL, 0xf, 0xf, true)); }
__device__ __forceinline__ float allreduce4(float v) { v += dpp_f<0xB1>(v); v += dpp_f<0x4E>(v); return v; }
__device__ __forceinline__ float allreduce8(float v) { v = allreduce4(v); v += dpp_f<0x141>(v); return v; }
__device__ __forceinline__ float allreduce16(float v) { v = allreduce8(v); v += dpp_f<0x140>(v); return v; }
__device__ __forceinline__ float allreduce64(float v) { v = allreduce16(v); v += __shfl_xor(v, 16); v += __shfl_xor(v, 32); return v; }
__device__ __forceinline__ float reduce63(float v) {
    v = allreduce16(v);
    v += __builtin_bit_cast(float, __builtin_amdgcn_update_dpp(0, __builtin_bit_cast(int, v), 0x142, 0xa, 0xf, false));
    v += __builtin_bit_cast(float, __builtin_amdgcn_update_dpp(0, __builtin_bit_cast(int, v), 0x143, 0xc, 0xf, false));
    return v;
}

struct Args { const float* in[22]; float* out; unsigned char* ws; int ph_lo, ph_hi; };

struct Frame {
    LAS unsigned char* lds;
    int tid, lane, wave, G, blk;
    const float *x_prompt, *x_sample, *state_rwkv, *state_shift, *state_ret, *meta, *w_in, *w_out, *shift_mix, *w0, *w_up, *a0, *a_up, *k_k, *k_a, *r_k, *gn_a_g, *gn_a_b, *gn_b_g, *gn_b_b, *ln_g, *ln_b;
    float* out;
    bf16 *XB, *WINT, *ZB, *ZA, *MX, *WOUT, *AA, *GATE, *BONUS;
    float *WW; f32x2* ROPE;
};

__device__ __forceinline__ void p0_transpose_item(const float* W, int ldw, int k0, int srccol0, bf16* WT, int K, int dstrow0, LAS float* scr, int lane) {
#pragma unroll 8
    for (int i = 0; i < 32; ++i) { const int kk = 2 * i + (lane >> 5); scr[kk * 33 + (lane & 31)] = W[(size_t)(k0 + kk) * ldw + srccol0 + (lane & 31)]; }
    LDS_WAIT(); asm volatile("" ::: "memory");
    const int c = lane & 7;
#pragma unroll
    for (int j = 0; j < 4; ++j) { const int n = (lane >> 3) + 8 * j; const LAS float* s = scr + (8 * c) * 33 + n;
        v4u o; o.x = pk2(s[0 * 33], s[1 * 33]); o.y = pk2(s[2 * 33], s[3 * 33]); o.z = pk2(s[4 * 33], s[5 * 33]); o.w = pk2(s[6 * 33], s[7 * 33]);
        *(v4u*)(WT + (size_t)(dstrow0 + n) * K + k0 + 8 * c) = o; }
    LDS_WAIT(); asm volatile("" ::: "memory");
}
__device__ __forceinline__ void p0_prologue(const Frame& F) {
    LAS float* scr = (LAS float*)(F.lds + F.wave * 16384);
    const int gw = F.blk * 8 + F.wave, NGW = F.G * 8;
    constexpr int I_IN = 32 * 260, I_OUT = 32 * 64;
    for (int it = gw; it < I_IN + I_OUT; it += NGW) {
        if (it < I_IN) { const int kb = it / 260, nb = it % 260, d0 = 32 * nb, s0 = d0 < 4096 ? 4224 + d0 : d0 - 4096;
            p0_transpose_item(F.w_in, 8320, 64 * kb, s0, F.WINT, 2048, d0, scr, F.lane); }
        else { const int r = it - I_IN, kb = r / 64, nb = r % 64;
            p0_transpose_item(F.w_out, 2048, 64 * kb, 32 * nb, F.WOUT, 2048, 32 * nb, scr, F.lane); }
    }
    { v4u z = {0u, 0u, 0u, 0u}; v4u* p = (v4u*)(F.WINT + (size_t)8320 * 2048);
      for (int i = F.blk * 512 + F.tid; i < 128 * 2048 * 2 / 16; i += F.G * 512) p[i] = z; }
    for (int m = gw; m < MPAD; m += NGW) {
        const float* src = nullptr;
        if (m < MPR) { const int b = m / TP, t = m - b * TP; src = t < 16 ? F.meta + (size_t)t * 2048 : F.x_prompt + ((size_t)b * 2048 + (t - 16)) * 2048; }
        else if (m < MROWS) src = F.x_sample + (size_t)(m - MPR) * 2048;
        v2u* dst = (v2u*)(F.XB + (size_t)m * 2048);
#pragma unroll
        for (int j = 0; j < 8; ++j) { f32x4 v = {0.f, 0.f, 0.f, 0.f}; if (src) v = ((const f32x4*)src)[F.lane + 64 * j];
            v2u o; o.x = pk2(v.x, v.y); o.y = pk2(v.z, v.w); dst[F.lane + 64 * j] = o; }
    }
    for (int i = F.blk * 512 + F.tid; i < 2072 * 64; i += F.G * 512) {
        const int p = i >> 6, f = i & 63; const int pos = p < 2064 ? p : 16384 + (p - 2064);
        const double x = (double)pos * ROPE_INV[f];
        const double n = __builtin_rint(x * 0.15915494309189535);
        double r = __builtin_fma(-n, 6.283185307179586, x); r = __builtin_fma(-n, 2.4492935982947064e-16, r);
        const double r2 = r * r; double s = 1.0, c = 1.0;
#pragma unroll
        for (int k = 12; k >= 1; --k) { s = 1.0 - s * r2 * (1.0 / (double)((2 * k) * (2 * k + 1))); c = 1.0 - c * r2 * (1.0 / (double)((2 * k - 1) * (2 * k))); }
        f32x2 o; o.x = (float)c; o.y = (float)(r * s); F.ROPE[i] = o;
    }
}

__device__ __forceinline__ void p2_pre(const Frame& F) {
    LAS float* tw = (LAS float*)F.lds;
    const int lane = F.lane, tid = F.tid;
    for (int u = F.blk; u < 145 * 16; u += F.G) {
        const int h = u & 15, rowbase = (u >> 4) * 64;
        {
            const int r = tid >> 3, cg = tid & 7, row = rowbase + r, col = 4096 + cg * 16;
            int kind = 0, bs = 0;
            if (row < MPR) { if (row % TP == 0) kind = 1; } else { const int s = row - MPR; if ((s & 7) == 0) { kind = 2; bs = s >> 3; } }
            const v4u* zp = (const v4u*)(F.ZA + (size_t)row * NAP + col); const v4u za0 = zp[0], za1 = zp[1];
            float cur[16], prv[16];
            const unsigned zw_[8] = {za0.x, za0.y, za0.z, za0.w, za1.x, za1.y, za1.z, za1.w};
#pragma unroll
            for (int i = 0; i < 8; ++i) { cur[2 * i] = bf2f(zw_[i] & 0xffffu); cur[2 * i + 1] = bf2f(zw_[i] >> 16); }
            if (kind == 0) { const v4u* pp = (const v4u*)(F.ZA + (size_t)(row - 1) * NAP + col); const v4u p0 = pp[0], p1 = pp[1];
                const unsigned pw_[8] = {p0.x, p0.y, p0.z, p0.w, p1.x, p1.y, p1.z, p1.w};
#pragma unroll
                for (int i = 0; i < 8; ++i) { prv[2 * i] = bf2f(pw_[i] & 0xffffu); prv[2 * i + 1] = bf2f(pw_[i] >> 16); } }
            else if (kind == 1) {
#pragma unroll
                for (int i = 0; i < 16; ++i) prv[i] = 0.f; }
            else { const f32x4* sp = (const f32x4*)(F.state_shift + (size_t)bs * NA + col);
#pragma unroll
                for (int i = 0; i < 4; ++i) { const f32x4 t = sp[i]; prv[4 * i] = t.x; prv[4 * i + 1] = t.y; prv[4 * i + 2] = t.z; prv[4 * i + 3] = t.w; } }
            const f32x4* mp = (const f32x4*)(F.shift_mix + col);
#pragma unroll
            for (int i = 0; i < 4; ++i) { const f32x4 mx = mp[i]; f32x4 o;
                o.x = cur[4 * i] + (prv[4 * i] - cur[4 * i]) * mx.x; o.y = cur[4 * i + 1] + (prv[4 * i + 1] - cur[4 * i + 1]) * mx.y;
                o.z = cur[4 * i + 2] + (prv[4 * i + 2] - cur[4 * i + 2]) * mx.z; o.w = cur[4 * i + 3] + (prv[4 * i + 3] - cur[4 * i + 3]) * mx.w;
                if (cg < 4) { o.x = tanh_(o.x); o.y = tanh_(o.y); o.z = tanh_(o.z); o.w = tanh_(o.w); }
                *(LAS f32x4*)(tw + r * 128 + cg * 16 + 4 * i) = o; }
        }
        __syncthreads();
        {
            const int hc = h * 64 + lane;
            float wup[64], aup[64];
#pragma unroll
            for (int j = 0; j < 64; ++j) { wup[j] = F.w_up[j * 1024 + hc]; aup[j] = F.a_up[j * 1024 + hc]; }
            const float w0c = F.w0[hc], a0c = F.a0[hc], kac = F.k_a[hc], rkc = F.r_k[hc];
            const float mr = F.shift_mix[hc], mk = F.shift_mix[1024 + hc], mv = F.shift_mix[2048 + hc], mg = F.shift_mix[3072 + hc];
            for (int rr = 0; rr < 8; ++rr) {
                const int r = F.wave * 8 + rr, row = rowbase + r;
                int kind = 0, bs = 0;
                if (row < MPR) { if (row % TP == 0) kind = 1; } else { const int s = row - MPR; if ((s & 7) == 0) { kind = 2; bs = s >> 3; } }
                const bf16* zr = F.ZA + (size_t)row * NAP + hc;
                const float cr = bf2f(zr[0]), ck = bf2f(zr[1024]), cv = bf2f(zr[2048]), cg_ = bf2f(zr[3072]);
                float pr = 0.f, pk = 0.f, pv = 0.f, pg = 0.f;
                if (kind == 0) { const bf16* zq = zr - NAP; pr = bf2f(zq[0]); pk = bf2f(zq[1024]); pv = bf2f(zq[2048]); pg = bf2f(zq[3072]); }
                else if (kind == 2) { const float* sp = F.state_shift + (size_t)bs * NA + hc; pr = sp[0]; pk = sp[1024]; pv = sp[2048]; pg = sp[3072]; }
                float aw = w0c, aa = a0c;
#pragma unroll
                for (int j = 0; j < 16; ++j) { const f32x4 t = *(const LAS f32x4*)(tw + r * 128 + 4 * j), z = *(const LAS f32x4*)(tw + r * 128 + 64 + 4 * j);
                    aw += t.x * wup[4 * j] + t.y * wup[4 * j + 1] + t.z * wup[4 * j + 2] + t.w * wup[4 * j + 3];
                    aa += z.x * aup[4 * j] + z.y * aup[4 * j + 1] + z.z * aup[4 * j + 2] + z.w * aup[4 * j + 3]; }
                const float rs = cr + (pr - cr) * mr, ks = ck + (pk - ck) * mk, vs = cv + (pv - cv) * mv, gs = cg_ + (pg - cg_) * mg;
                const float w = __expf(-sigmoidf_(aw) * 0.6065306597126334f);
                const float a = sigmoidf_(aa);
                const float kp = ks * (1.0f + (a - 1.0f) * kac);
                const float coef = allreduce64(rs * kp * rkc);
                const float gate = gs * sigmoidf_(gs);
                const size_t o = (size_t)row * 1024 + hc;
                F.WW[o] = w; F.AA[o] = (bf16)f2bf(a); F.GATE[o] = (bf16)f2bf(gate); F.BONUS[o] = (bf16)f2bf(coef * vs * gate);
            }
        }
        __syncthreads();
    }
    for (int i = F.blk * 512 + tid; i < 132 * NA; i += F.G * 512) {
        const int s = i / NA, c = i - s * NA;
        if (s < 4) F.out[O_SHIFTP + (size_t)s * NA + c] = bf2f(F.ZA[(size_t)(s * TP + TP - 1) * NAP + c]);
        else F.out[O_SHIFTS + (size_t)(s - 4) * NA + c] = bf2f(F.ZA[(size_t)(MPR + (s - 4) * 8 + 7) * NAP + c]);
    }
}

constexpr int SC_PROMPT_CH = 129, SC_SAMPLE_CH = 32, SC_NCH = SC_PROMPT_CH + SC_SAMPLE_CH;
struct ScanDesc { int zrow0, nsteps, yrow0, first, last, h, q, sb, sample; };
__device__ __forceinline__ ScanDesc scan_desc(int blk, int ci) {
    ScanDesc d;
    if (ci < SC_PROMPT_CH) { const int b = blk >> 6; d.h = (blk >> 2) & 15; d.q = blk & 3; d.zrow0 = b * TP + ci * 16; d.nsteps = 16; d.yrow0 = b * 2048 + ci * 16 - 16;
        d.first = ci == 0; d.last = ci == SC_PROMPT_CH - 1; d.sample = 0; d.sb = b; }
    else { const int su = (ci - SC_PROMPT_CH) * 256 + blk; d.q = su & 3; d.h = (su >> 2) & 15; const int bs = su >> 6; d.zrow0 = MPR + bs * 8; d.nsteps = 8; d.yrow0 = 8192 + bs * 8;
        d.first = 1; d.last = 1; d.sample = 1; d.sb = bs; }
    return d;
}
struct ScanLoad { unsigned short zr[5], zk[5], zv[5], av[4]; float wv[4]; float sr, sk, sv; float kkc, kac, mr, mk, mv; };
__device__ __forceinline__ void scan_issue(const Frame& F, const ScanDesc& d, int lw, ScanLoad& L) {
    const int spw = d.nsteps >> 2, hc = d.h * 64 + F.lane, r0 = d.zrow0 + lw * spw;
    const bool ext = d.first && lw == 0;
    L.kkc = F.k_k[hc]; L.kac = F.k_a[hc]; L.mr = F.shift_mix[hc]; L.mk = F.shift_mix[1024 + hc]; L.mv = F.shift_mix[2048 + hc];
    L.sr = 0.f; L.sk = 0.f; L.sv = 0.f;
    if (ext) { L.zr[0] = 0; L.zk[0] = 0; L.zv[0] = 0;
        if (d.sample) { const float* sp = F.state_shift + (size_t)d.sb * NA + hc; L.sr = sp[0]; L.sk = sp[1024]; L.sv = sp[2048]; } }
    else { const bf16* z = F.ZA + (size_t)(r0 - 1) * NAP + hc; L.zr[0] = z[0]; L.zk[0] = z[1024]; L.zv[0] = z[2048]; }
#pragma unroll
    for (int j = 0; j < 4; ++j) if (j < spw) { const bf16* z = F.ZA + (size_t)(r0 + j) * NAP + hc; L.zr[j + 1] = z[0]; L.zk[j + 1] = z[1024]; L.zv[j + 1] = z[2048];
        L.av[j] = F.AA[(size_t)(r0 + j) * 1024 + hc]; L.wv[j] = F.WW[(size_t)(r0 + j) * 1024 + hc]; }
}
__device__ __forceinline__ void scan_finish(const Frame& F, const ScanDesc& d, int lw, const ScanLoad& L, LAS float* sbuf) {
    const int spw = d.nsteps >> 2; const bool ext = d.first && lw == 0;
    float pr = ext ? L.sr : bf2f(L.zr[0]), pk = ext ? L.sk : bf2f(L.zk[0]), pv = ext ? L.sv : bf2f(L.zv[0]);
#pragma unroll
    for (int j = 0; j < 4; ++j) if (j < spw) {
        const float cr = bf2f(L.zr[j + 1]), ck = bf2f(L.zk[j + 1]), cv = bf2f(L.zv[j + 1]);
        const float r = cr + (pr - cr) * L.mr, k = ck + (pk - ck) * L.mk, v = cv + (pv - cv) * L.mv;
        pr = cr; pk = ck; pv = cv;
        const float a = bf2f(L.av[j]);
        float kk = k * L.kkc; const float n2 = allreduce64(kk * kk); kk = kk / fmaxf(sqrtf(n2), 1e-12f);
        const float kp = k * (1.0f + (a - 1.0f) * L.kac);
        LAS float* s = sbuf + (lw * spw + j) * 384 + F.lane;
        s[0] = r; s[64] = L.wv[j]; s[128] = kp; s[192] = kk; s[256] = kk * a; s[320] = v;
    }
}
__device__ __forceinline__ void p3_rwkv(const Frame& F) {
    LAS float* SBUF = (LAS float*)F.lds;
    LAS float* OBUF = (LAS float*)(F.lds + 49152);
    const int lane = F.lane, wave = F.wave; const bool scanner = wave < 4;
    const int rs = lane >> 4, ks = lane & 15;
    ScanLoad L; f32x4 S = {0.f, 0.f, 0.f, 0.f}, Sn = {0.f, 0.f, 0.f, 0.f};
    if (!scanner) { const ScanDesc d0 = scan_desc(F.blk, 0); scan_issue(F, d0, wave - 4, L); scan_finish(F, d0, wave - 4, L, SBUF); }
    __syncthreads();
    for (int ci = 0; ci < SC_NCH; ++ci) {
        const ScanDesc d = scan_desc(F.blk, ci); const int buf = ci & 1;
        if (scanner) {
            const int rw = d.q * 16 + wave * 4 + rs;
            if (d.first) S = d.sample ? Sn : (f32x4){0.f, 0.f, 0.f, 0.f};
            if (ci + 1 < SC_NCH && ci + 1 >= SC_PROMPT_CH) { const ScanDesc dn = scan_desc(F.blk, ci + 1);
                Sn = *(const f32x4*)(F.state_rwkv + ((size_t)(dn.sb * 16 + dn.h) * 64 + dn.q * 16 + wave * 4 + rs) * 64 + 4 * ks); }
            const LAS float* sb0 = SBUF + buf * (16 * 384); LAS float* ob = OBUF + buf * 256 + wave * 4 + rs;
            for (int s0 = 0; s0 < d.nsteps; s0 += 8) {
#pragma unroll
                for (int j = 0; j < 8; ++j) { const LAS float* sb = sb0 + (s0 + j) * 384;
                    const f32x4 r4 = *(const LAS f32x4*)(sb + 4 * ks), w4 = *(const LAS f32x4*)(sb + 64 + 4 * ks), k4 = *(const LAS f32x4*)(sb + 128 + 4 * ks),
                                kk4 = *(const LAS f32x4*)(sb + 192 + 4 * ks), b4 = *(const LAS f32x4*)(sb + 256 + 4 * ks); const float v = sb[320 + rw];
                    float sa = S.x * kk4.x + S.y * kk4.y + S.z * kk4.z + S.w * kk4.w; sa = -allreduce16(sa);
                    S.x = S.x * w4.x + (v * k4.x + sa * b4.x); S.y = S.y * w4.y + (v * k4.y + sa * b4.y); S.z = S.z * w4.z + (v * k4.z + sa * b4.z); S.w = S.w * w4.w + (v * k4.w + sa * b4.w);
                    float o = S.x * r4.x + S.y * r4.y + S.z * r4.z + S.w * r4.w; o = allreduce16(o);
                    if (ks == 0) ob[(s0 + j) * 16] = o; }
            }
            if (d.last) { float* dst = d.sample ? F.out + O_RWKVS : F.out + O_RWKVP; *(f32x4*)(dst + ((size_t)(d.sb * 16 + d.h) * 64 + rw) * 64 + 4 * ks) = S; }
        } else {
            const int lw = wave - 4; ScanDesc dn = d; const bool more = ci + 1 < SC_NCH;
            if (more) { dn = scan_desc(F.blk, ci + 1); scan_issue(F, dn, lw, L); }
            if (ci > 0) { const ScanDesc dp = scan_desc(F.blk, ci - 1); const int i = F.tid - 256, s = i >> 4, r = i & 15;
                if (s < dp.nsteps && dp.yrow0 + s >= 0 && (dp.sample || ci - 1 > 0)) F.out[(size_t)(dp.yrow0 + s) * 2048 + dp.h * 64 + dp.q * 16 + r] = OBUF[((ci - 1) & 1) * 256 + i]; }
            if (more) scan_finish(F, dn, lw, L, SBUF + ((ci + 1) & 1) * (16 * 384));
        }
        __syncthreads();
    }
    if (!scanner) { const ScanDesc dp = scan_desc(F.blk, SC_NCH - 1); const int i = F.tid - 256, s = i >> 4, r = i & 15;
        if (s < dp.nsteps) F.out[(size_t)(dp.yrow0 + s) * 2048 + dp.h * 64 + dp.q * 16 + r] = OBUF[((SC_NCH - 1) & 1) * 256 + i]; }
    __syncthreads();
}

constexpr int RT_PROMPT_CH = 86, RT_SAMPLE_CH = 32, RT_NCH = RT_PROMPT_CH + RT_SAMPLE_CH;
struct RetDesc { int zrow0, nsteps, yrow0, first, last, h, es, sb, sample, p0; };
__device__ __forceinline__ RetDesc ret_desc(int blk, int ci) {
    RetDesc d;
    if (ci < RT_PROMPT_CH) { const int b = blk >> 6; d.h = (blk >> 3) & 7; d.es = blk & 7; d.zrow0 = b * TP + ci * 24; d.nsteps = 24; d.yrow0 = b * 2048 + ci * 24 - 16; d.p0 = ci * 24;
        d.first = ci == 0; d.last = ci == RT_PROMPT_CH - 1; d.sample = 0; d.sb = b; }
    else { const int su = (ci - RT_PROMPT_CH) * 256 + blk; d.es = su & 7; d.h = (su >> 3) & 7; const int bs = su >> 6; d.zrow0 = MPR + bs * 8; d.nsteps = 8; d.yrow0 = 8192 + bs * 8; d.p0 = 2064;
        d.first = 1; d.last = 1; d.sample = 1; d.sb = bs; }
    return d;
}
struct RetLoad { unsigned short q1[3], q2[3], k1[3], k2[3]; f32x2 cs[3]; unsigned short v; };
__device__ __forceinline__ void ret_issue(const Frame& F, const RetDesc& d, RetLoad& L) {
#pragma unroll
    for (int j = 0; j < 3; ++j) { const int id = F.tid + 512 * j, s = id >> 6, i = id & 63;
        if (s < d.nsteps) { const bf16* z = F.ZB + (size_t)(d.zrow0 + s) * NB + d.h * 128 + i; L.q1[j] = z[0]; L.q2[j] = z[64]; L.k1[j] = z[1024]; L.k2[j] = z[1088]; L.cs[j] = F.ROPE[(d.p0 + s) * 64 + i]; } }
    { const int s = F.tid >> 4, e = F.tid & 15; if (s < d.nsteps) L.v = F.ZB[(size_t)(d.zrow0 + s) * NB + 2048 + d.h * 128 + d.es * 16 + e]; }
}
__device__ __forceinline__ void ret_finish(const Frame& F, const RetDesc& d, const RetLoad& L, LAS float* qk, LAS float* vb) {
#pragma unroll
    for (int j = 0; j < 3; ++j) { const int id = F.tid + 512 * j, s = id >> 6, i = id & 63;
        if (s < d.nsteps) { const float c = L.cs[j].x, sn = L.cs[j].y, q1 = bf2f(L.q1[j]), q2 = bf2f(L.q2[j]), k1 = bf2f(L.k1[j]) * 0.08838834764831845f, k2 = bf2f(L.k2[j]) * 0.08838834764831845f;
            LAS float* o = qk + s * 256 + i; o[0] = q1 * c - q2 * sn; o[64] = q1 * sn + q2 * c; o[128] = k1 * c - k2 * sn; o[192] = k1 * sn + k2 * c; } }
    { const int s = F.tid >> 4; if (s < d.nsteps) vb[F.tid] = bf2f(L.v); }
}
__device__ __forceinline__ void ret_store_o(const Frame& F, const RetDesc& d, const LAS float* ob) {
    const int s = F.tid >> 4, e = F.tid & 15;
    if (s < d.nsteps && d.yrow0 + s >= 0 && (d.sample || d.p0 + s >= 16)) F.out[(size_t)(d.yrow0 + s) * 2048 + 1024 + d.h * 128 + d.es * 16 + e] = ob[F.tid];
}
__device__ __forceinline__ void p3_ret(const Frame& F) {
    LAS float* QK = (LAS float*)F.lds;
    LAS float* VB = (LAS float*)(F.lds + 49152);
    LAS float* OB = (LAS float*)(F.lds + 49152 + 3072);
    const int lane = F.lane, wave = F.wave;
    RetLoad L; float S00 = 0.f, S01 = 0.f, S10 = 0.f, S11 = 0.f; f32x2 Sn0 = {0.f, 0.f}, Sn1 = {0.f, 0.f};
    { const RetDesc d0 = ret_desc(F.blk, 0); ret_issue(F, d0, L); ret_finish(F, d0, L, QK, VB); }
    __syncthreads();
    for (int ci = 0; ci < RT_NCH; ++ci) {
        const RetDesc d = ret_desc(F.blk, ci); const int buf = ci & 1; const bool more = ci + 1 < RT_NCH;
        RetDesc dn = d; if (more) { dn = ret_desc(F.blk, ci + 1); ret_issue(F, dn, L); }
        if (ci > 0) ret_store_o(F, ret_desc(F.blk, ci - 1), OB + ((ci - 1) & 1) * 384);
        if (d.first) { if (d.sample) { S00 = Sn0.x; S01 = Sn0.y; S10 = Sn1.x; S11 = Sn1.y; } else { S00 = 0.f; S01 = 0.f; S10 = 0.f; S11 = 0.f; } }
        if (more && ci + 1 >= RT_PROMPT_CH) { const float* sp = F.state_ret + ((size_t)(dn.sb * 8 + dn.h) * 128) * 128 + dn.es * 16 + 2 * wave;
            Sn0 = *(const f32x2*)(sp + (size_t)lane * 128); Sn1 = *(const f32x2*)(sp + (size_t)(lane + 64) * 128); }
        const float gam = 1.0f - __builtin_ldexpf(1.0f, -5 - d.h);
        const LAS float* qk = QK + buf * (24 * 256); const LAS float* vb = VB + buf * 384 + 2 * wave; LAS float* ob = OB + buf * 384 + 2 * wave;
        for (int s0 = 0; s0 < d.nsteps; s0 += 8) {
#pragma unroll
            for (int j = 0; j < 8; ++j) { const int s = s0 + j; const LAS float* p = qk + s * 256 + lane;
                const float q1 = p[0], q2 = p[64], k1 = p[128], k2 = p[192]; const f32x2 v = *(const LAS f32x2*)(vb + s * 16);
                S00 = S00 * gam + k1 * v.x; S01 = S01 * gam + k1 * v.y; S10 = S10 * gam + k2 * v.x; S11 = S11 * gam + k2 * v.y;
                const float o0 = reduce63(q1 * S00 + q2 * S10), o1 = reduce63(q1 * S01 + q2 * S11);
                if (lane == 63) { f32x2 o = {o0, o1}; *(LAS f32x2*)(ob + s * 16) = o; } }
        }
        if (d.last) { float* dst = (d.sample ? F.out + O_RETS : F.out + O_RETP) + ((size_t)(d.sb * 8 + d.h) * 128) * 128 + d.es * 16 + 2 * wave;
            f32x2 a = {S00, S01}, b = {S10, S11}; *(f32x2*)(dst + (size_t)lane * 128) = a; *(f32x2*)(dst + (size_t)(lane + 64) * 128) = b; }
        if (more) ret_finish(F, dn, L, QK + ((ci + 1) & 1) * (24 * 256), VB + ((ci + 1) & 1) * 384);
        __syncthreads();
    }
    ret_store_o(F, ret_desc(F.blk, RT_NCH - 1), OB + ((RT_NCH - 1) & 1) * 384);
    __syncthreads();
}

__device__ __forceinline__ void p4_post(const Frame& F) {
    const int gw = F.blk * 8 + F.wave, NGW = F.G * 8, lane = F.lane;
    for (int yrow = gw; yrow < YROWS; yrow += NGW) {
        const int zrow = yrow < 8192 ? (yrow >> 11) * TP + (yrow & 2047) + 16 : MPR + (yrow - 8192);
        const float* orow = F.out + (size_t)yrow * 2048;
        {
            const int c0 = 16 * lane; f32x4 v[4]; float s = 0.f;
#pragma unroll
            for (int i = 0; i < 4; ++i) { v[i] = *(const f32x4*)(orow + c0 + 4 * i); s += (v[i].x + v[i].y) + (v[i].z + v[i].w); }
            const float mean = allreduce4(s) * (1.0f / 64.0f); float q = 0.f;
#pragma unroll
            for (int i = 0; i < 4; ++i) { v[i] = v[i] - mean; q += (v[i].x * v[i].x + v[i].y * v[i].y) + (v[i].z * v[i].z + v[i].w * v[i].w); }
            const float rstd = 1.0f / sqrtf(allreduce4(q) * (1.0f / 64.0f) + GN_EPS_A);
            const v4u* gp = (const v4u*)(F.GATE + (size_t)zrow * 1024 + c0); const v4u* bp = (const v4u*)(F.BONUS + (size_t)zrow * 1024 + c0);
            const v4u g0 = gp[0], g1 = gp[1], b0 = bp[0], b1 = bp[1];
            const unsigned gw_[8] = {g0.x, g0.y, g0.z, g0.w, g1.x, g1.y, g1.z, g1.w}, bw_[8] = {b0.x, b0.y, b0.z, b0.w, b1.x, b1.y, b1.z, b1.w};
            unsigned ow[8];
#pragma unroll
            for (int i = 0; i < 4; ++i) { const f32x4 gg = *(const f32x4*)(F.gn_a_g + c0 + 4 * i), gb = *(const f32x4*)(F.gn_a_b + c0 + 4 * i);
                const float y0 = (v[i].x * rstd * gg.x + gb.x) * bf2f(gw_[2 * i] & 0xffffu) + bf2f(bw_[2 * i] & 0xffffu);
                const float y1 = (v[i].y * rstd * gg.y + gb.y) * bf2f(gw_[2 * i] >> 16) + bf2f(bw_[2 * i] >> 16);
                const float y2 = (v[i].z * rstd * gg.z + gb.z) * bf2f(gw_[2 * i + 1] & 0xffffu) + bf2f(bw_[2 * i + 1] & 0xffffu);
                const float y3 = (v[i].w * rstd * gg.w + gb.w) * bf2f(gw_[2 * i + 1] >> 16) + bf2f(bw_[2 * i + 1] >> 16);
                ow[2 * i] = pk2(y0, y1); ow[2 * i + 1] = pk2(y2, y3); }
            v4u* mp = (v4u*)(F.MX + (size_t)zrow * 2048 + c0); v4u o0 = {ow[0], ow[1], ow[2], ow[3]}, o1 = {ow[4], ow[5], ow[6], ow[7]}; mp[0] = o0; mp[1] = o1;
        }
        {
            const int c0 = 16 * lane; f32x4 v[4]; float s = 0.f;
#pragma unroll
            for (int i = 0; i < 4; ++i) { v[i] = *(const f32x4*)(orow + 1024 + c0 + 4 * i); s += (v[i].x + v[i].y) + (v[i].z + v[i].w); }
            const float mean = allreduce8(s) * (1.0f / 128.0f); float q = 0.f;
#pragma unroll
            for (int i = 0; i < 4; ++i) { v[i] = v[i] - mean; q += (v[i].x * v[i].x + v[i].y * v[i].y) + (v[i].z * v[i].z + v[i].w * v[i].w); }
            const float rstd = 1.0f / sqrtf(allreduce8(q) * (1.0f / 128.0f) + GN_EPS_B);
            const v4u* gp = (const v4u*)(F.ZB + (size_t)zrow * NB + 3072 + c0); const v4u g0 = gp[0], g1 = gp[1];
            const unsigned gw_[8] = {g0.x, g0.y, g0.z, g0.w, g1.x, g1.y, g1.z, g1.w};
            unsigned ow[8];
#pragma unroll
            for (int i = 0; i < 4; ++i) { const f32x4 gg = *(const f32x4*)(F.gn_b_g + c0 + 4 * i), gb = *(const f32x4*)(F.gn_b_b + c0 + 4 * i);
                const float z0 = bf2f(gw_[2 * i] & 0xffffu), z1 = bf2f(gw_[2 * i] >> 16), z2 = bf2f(gw_[2 * i + 1] & 0xffffu), z3 = bf2f(gw_[2 * i + 1] >> 16);
                const float y0 = (v[i].x * rstd * gg.x + gb.x) * (z0 * sigmoidf_(z0)), y1 = (v[i].y * rstd * gg.y + gb.y) * (z1 * sigmoidf_(z1));
                const float y2 = (v[i].z * rstd * gg.z + gb.z) * (z2 * sigmoidf_(z2)), y3 = (v[i].w * rstd * gg.w + gb.w) * (z3 * sigmoidf_(z3));
                ow[2 * i] = pk2(y0, y1); ow[2 * i + 1] = pk2(y2, y3); }
            v4u* mp = (v4u*)(F.MX + (size_t)zrow * 2048 + 1024 + c0); v4u o0 = {ow[0], ow[1], ow[2], ow[3]}, o1 = {ow[4], ow[5], ow[6], ow[7]}; mp[0] = o0; mp[1] = o1;
        }
    }
}
__device__ __forceinline__ void p6_ln(const Frame& F) {
    const int gw = F.blk * 8 + F.wave, NGW = F.G * 8, lane = F.lane;
    for (int yrow = gw; yrow < YROWS; yrow += NGW) {
        f32x4* p = (f32x4*)(F.out + (size_t)yrow * 2048) + lane; f32x4 v[8]; float s = 0.f;
#pragma unroll
        for (int j = 0; j < 8; ++j) { v[j] = p[64 * j]; s += (v[j].x + v[j].y) + (v[j].z + v[j].w); }
        const float mean = allreduce64(s) * (1.0f / 2048.0f); float q = 0.f;
#pragma unroll
        for (int j = 0; j < 8; ++j) { v[j] = v[j] - mean; q += (v[j].x * v[j].x + v[j].y * v[j].y) + (v[j].z * v[j].z + v[j].w * v[j].w); }
        const float rstd = 1.0f / sqrtf(allreduce64(q) * (1.0f / 2048.0f) + LN_EPS);
#pragma unroll
        for (int j = 0; j < 8; ++j) { const f32x4 g = ((const f32x4*)F.ln_g)[lane + 64 * j], b = ((const f32x4*)F.ln_b)[lane + 64 * j]; p[64 * j] = v[j] * rstd * g + b; }
    }
}

constexpr int N_PHASES = 7;
__global__ void __launch_bounds__(512, 2) hymba_fwd(Args args) {
    extern __shared__ __attribute__((aligned(16))) unsigned char lds[];
    Frame F;
    F.lds = (LAS unsigned char*)lds;
    F.tid = threadIdx.x; F.lane = F.tid & 63; F.wave = __builtin_amdgcn_readfirstlane(F.tid >> 6); F.G = gridDim.x; F.blk = blockIdx.x;
    F.x_prompt = args.in[0]; F.x_sample = args.in[1]; F.state_rwkv = args.in[2]; F.state_shift = args.in[3]; F.state_ret = args.in[4]; F.meta = args.in[5]; F.w_in = args.in[6]; F.w_out = args.in[7];
    F.shift_mix = args.in[8]; F.w0 = args.in[9]; F.w_up = args.in[10]; F.a0 = args.in[11]; F.a_up = args.in[12]; F.k_k = args.in[13]; F.k_a = args.in[14]; F.r_k = args.in[15];
    F.gn_a_g = args.in[16]; F.gn_a_b = args.in[17]; F.gn_b_g = args.in[18]; F.gn_b_b = args.in[19]; F.ln_g = args.in[20]; F.ln_b = args.in[21];
    F.out = args.out; unsigned char* ws = args.ws;
    F.XB = (bf16*)((unsigned char*)args.out + OB_XB); F.WINT = (bf16*)((unsigned char*)args.out + OB_WIN);
    F.ZB = (bf16*)(ws + WS_ZB); F.ZA = (bf16*)(ws + WS_ZA); F.MX = (bf16*)(ws + WS_ZA); F.WOUT = (bf16*)(ws + WS_WOUT); F.ROPE = (f32x2*)(ws + WS_ROPE);
    F.WW = (float*)(ws + WS_W); F.AA = (bf16*)(ws + WS_A); F.GATE = (bf16*)(ws + WS_GATE); F.BONUS = (bf16*)(ws + WS_BONUS);
    volatile LAS unsigned* MISC = (volatile LAS unsigned*)(F.lds + MISC_OFF);
    if (F.tid < 32) MISC[F.tid] = 0u;
    __syncthreads();
    unsigned* ctl = (unsigned*)(ws + WS_CTL);
    XcdBarrier bar = xcd_barrier_post(ctl + CW_BAR, MISC + 8);
    const int lo = args.ph_lo, hi = args.ph_hi;
#define IN(k) (lo <= (k) && (k) < hi)
#define SEAM(k) do { if (IN(k) && IN((k) + 1)) xcd_barrier(bar); } while (0)
    if (IN(0)) p0_prologue(F);
    SEAM(0);
    if (IN(1)) { pg8::Gemm g{F.XB, F.WINT, MPAD, NPAD, D_MODEL}; pg8::StaticOrder S; S.init(MPAD, NPAD, F.G, F.blk); pg8::EpiZ E{F.ZB, F.ZA};
        pg8::gemm_phase<pg8::EpiZ, pg8::StaticOrder, true, true>(F.lds, g, S, E); }
    SEAM(1);
    if (IN(2)) p2_pre(F);
    SEAM(2);
    if (IN(3)) { p3_rwkv(F); p3_ret(F); }
    SEAM(3);
    if (IN(4)) p4_post(F);
    SEAM(4);
    if (IN(5)) { pg8::Gemm g{F.MX, F.WOUT, MPAD, D_MODEL, D_MODEL}; pg8::StaticOrder S; S.init(MPAD, D_MODEL, F.G, F.blk); pg8::EpiY E{F.x_prompt, F.x_sample, F.out, ALPHA};
        pg8::gemm_phase<pg8::EpiY, pg8::StaticOrder, true, true>(F.lds, g, S, E); }
    SEAM(5);
    if (IN(6)) p6_ln(F);
#undef IN
#undef SEAM
}

extern "C" void kernel_launch(void* const* d_in, const int* in_sizes, int n_in, void* d_out, int out_size, void* d_ws, size_t ws_size, hipStream_t stream) {
    static int grid = 0;
    if (grid == 0) {
        if (n_in != 22 || (size_t)out_size != O_END || ws_size < WS_END) { fprintf(stderr, "kernel_launch: unexpected shapes (n_in %d, out %d, ws %zu, need %zu); nothing launched\n", n_in, out_size, ws_size, (size_t)WS_END); grid = -1; return; }
        int dev = 0, cus = 0, per_cu = 0;
        if (hipGetDevice(&dev) != hipSuccess || hipDeviceGetAttribute(&cus, hipDeviceAttributeMultiprocessorCount, dev) != hipSuccess) { grid = -1; return; }
        if (hipFuncSetAttribute((const void*)hymba_fwd, hipFuncAttributeMaxDynamicSharedMemorySize, LDS_BYTES) != hipSuccess) { fprintf(stderr, "kernel_launch: hipFuncSetAttribute failed\n"); grid = -1; return; }
        if (hipOccupancyMaxActiveBlocksPerMultiprocessor(&per_cu, (const void*)hymba_fwd, 512, LDS_BYTES) != hipSuccess || per_cu < 1) fprintf(stderr, "kernel_launch: occupancy query reports %d\n", per_cu);
        (void)hipGetLastError();
        grid = cus;
        if (grid != 256) fprintf(stderr, "kernel_launch: %d CUs; this kernel is laid out for 256\n", grid);
    }
    if (grid != 256) return;
    (void)hipMemsetAsync((char*)d_ws + WS_CTL, 0, CTL_ZERO_BYTES, stream);
    Args a{};
    for (int i = 0; i < 22; ++i) a.in[i] = (const float*)d_in[i];
    a.out = (float*)d_out; a.ws = (unsigned char*)d_ws;
#if MK_LAUNCHES == 1
    a.ph_lo = 0; a.ph_hi = N_PHASES;
    hipLaunchKernelGGL(hymba_fwd, dim3(grid), dim3(512), LDS_BYTES, stream, a);
#else
    for (int p = 0; p < N_PHASES; ++p) { a.ph_lo = p; a.ph_hi = p + 1; hipLaunchKernelGGL(hymba_fwd, dim3(grid), dim3(512), LDS_BYTES, stream, a); }
#endif
}
```

```cpp
#include <hip/hip_runtime.h>
#include <cstdio>
#include <cstdint>
#ifndef MK_LAUNCHES
#define MK_LAUNCHES 1
#endif
#define REP_P0 1
#define REP_P1 1
#define REP_P2 1
#define REP_P3A 1
#define REP_P3B 1
#define REP_P4 1
#define REP_P5 1
__device__ const double ROPE_INV[64] = { 1, 0.86596432336006535, 0.74989420933245587, 0.64938163157621132, 0.56234132519034907, 0.48696752516586311, 0.42169650342858223, 0.36517412725483772, 0.31622776601683794, 0.27384196342643613, 0.23713737056616552, 0.20535250264571461, 0.17782794100389229, 0.15399265260594919, 0.1333521432163324, 0.11547819846894582, 0.10000000000000001, 0.086596432336006529, 0.074989420933245579, 0.064938163157621132, 0.056234132519034911, 0.048696752516586311, 0.042169650342858224, 0.036517412725483769, 0.031622776601683791, 0.027384196342643614, 0.023713737056616554, 0.02053525026457146, 0.017782794100389229, 0.015399265260594919, 0.013335214321633241, 0.011547819846894581, 0.01, 0.0086596432336006543, 0.0074989420933245579, 0.006493816315762113, 0.005623413251903491, 0.004869675251658631, 0.0042169650342858229, 0.0036517412725483771, 0.0031622776601683794, 0.0027384196342643613, 0.0023713737056616554, 0.002053525026457146, 0.0017782794100389228, 0.001539926526059492, 0.0013335214321633241, 0.0011547819846894581, 0.001, 0.00086596432336006539, 0.00074989420933245586, 0.00064938163157621134, 0.0005623413251903491, 0.0004869675251658631, 0.00042169650342858224, 0.0003651741272548377, 0.00031622776601683794, 0.00027384196342643611, 0.00023713737056616554, 0.00020535250264571461, 0.00017782794100389227, 0.00015399265260594919, 0.0001333521432163324, 0.00011547819846894582 };
namespace pg8 {
#define PG8_LAS __attribute__((address_space(3)))
typedef unsigned short bf16_t;
typedef short bf16x8 __attribute__((ext_vector_type(8)));
typedef float f32x4 __attribute__((ext_vector_type(4)));
typedef unsigned u32x4 __attribute__((ext_vector_type(4)));
constexpr int BM = 256, BK = 64, HALF = 128, HTB = HALF * BK * 2  , STAGE_BYTES = 8 * HTB, NXCD = 8, WGM = 8;

__host__ __device__ __forceinline__ int lds_byte(int r, int c) { const int st = (r >> 4) * 2 + (c >> 5), rr = r & 15, cc = c & 31, ob = rr * 64 + cc * 2; return st * 1024 + (ob ^ (((ob >> 9) & 1) << 5)); }
__host__ __device__ __forceinline__ void stage_rc(int b, int& R, int& C) { const int st = b / 1024, sb = b % 1024, swz = sb ^ (((sb >> 9) & 1) << 5); R = (st >> 1) * 16 + swz / 64; C = (st & 1) * 32 + (swz % 64) / 2; }
__host__ __device__ __forceinline__ int perm32(int rho) { const int n = rho >> 4, i = rho & 15; return 8 * (i >> 2) + 4 * n + (i & 3); }

struct Unit { int pm, pn; };
struct Gemm { const bf16_t* A; const bf16_t* Bt; int M, N, K; };

struct StaticOrder {
    int nM, nN, nwg, G, c;
    __host__ __device__ void init(int M, int N, int G_, int c_) { nM = M / BM; nN = N / BM; nwg = nM * nN; G = G_; c = c_; }
    __host__ __device__ bool next(int i, Unit& u) const {
        const long L = (long)i * G + c; if (L >= nwg) return false;
        int wgid = (int)L; { const int q = nwg / NXCD, r = nwg % NXCD, xcd = wgid % NXCD, off = wgid / NXCD; wgid = (xcd < r ? xcd * (q + 1) : r * (q + 1) + (xcd - r) * q) + off; }
        const int nig = WGM * nN, gid = wgid / nig, fm = gid * WGM, gsz = (nM - fm) < WGM ? (nM - fm) : WGM;
        u.pm = fm + ((wgid % nig) % gsz); u.pn = (wgid % nig) / gsz; return true;
    }
    __device__ __forceinline__ void a_ready(const Unit&) const {}
    __device__ __forceinline__ void done(const Unit&) const {}
};

__device__ __forceinline__ unsigned cvt_pk_bf16(float lo, float hi) { unsigned r; asm volatile("v_cvt_pk_bf16_f32 %0, %1, %2" : "=v"(r) : "v"(lo), "v"(hi)); return r; }
typedef float f32x2 __attribute__((ext_vector_type(2)));

struct EpiZ {
    static constexpr bool PERM = true, AFTER_DRAIN = false;
    bf16_t* ZB; bf16_t* ZA;
    __device__ __forceinline__ void operator()(const f32x4 (&acc)[2][2][4][2], const Unit& u, int wr, int wc, int fr, int fq) const {
        const int row0 = u.pm * BM + wr * 64 + fr;
        bf16_t* base; int ldc, colt;
        if (u.pn < 16) { base = ZB; ldc = 4096; colt = u.pn * BM; } else { base = ZA; ldc = 4352; colt = (u.pn - 16) * BM; }
        const int col0 = colt + wc * 32 + 8 * fq;
#pragma unroll
        for (int ai = 0; ai < 2; ++ai)
#pragma unroll
            for (int m = 0; m < 4; ++m) { bf16_t* rowp = base + (size_t)(row0 + ai * HALF + m * 16) * ldc + col0;
#pragma unroll
                for (int bj = 0; bj < 2; ++bj) { const f32x4 v0 = acc[ai][bj][m][0], v1 = acc[ai][bj][m][1];
                    u32x4 w; w.x = cvt_pk_bf16(v0[0], v0[1]); w.y = cvt_pk_bf16(v0[2], v0[3]); w.z = cvt_pk_bf16(v1[0], v1[1]); w.w = cvt_pk_bf16(v1[2], v1[3]);
                    *(u32x4*)(rowp + bj * HALF) = w; } }
    }
};
struct EpiY {
    static constexpr bool PERM = false, AFTER_DRAIN = false;
    const float* xp; const float* xs; float* out; float alpha;
    __device__ __forceinline__ void operator()(const f32x4 (&acc)[2][2][4][2], const Unit& u, int wr, int wc, int fr, int fq) const {
#pragma unroll
        for (int ai = 0; ai < 2; ++ai)
#pragma unroll
            for (int m = 0; m < 4; ++m) {
                const int zrow = u.pm * BM + ai * HALF + wr * 64 + m * 16 + fr; int yrow = -1;
                if (zrow < 8256) { const int b = zrow / 2064, t = zrow - b * 2064; if (t >= 16) yrow = b * 2048 + t - 16; }
                else if (zrow < 9280) yrow = zrow - 64;
                if (yrow >= 0) {
                    const float* xsrc = yrow < 8192 ? xp + (size_t)yrow * 2048 : xs + (size_t)(yrow - 8192) * 2048; float* o = out + (size_t)yrow * 2048;
#pragma unroll
                    for (int bj = 0; bj < 2; ++bj)
#pragma unroll
                        for (int n = 0; n < 2; ++n) { const int col = u.pn * BM + bj * HALF + wc * 32 + n * 16 + 4 * fq;
                            const f32x4 xv = *(const f32x4*)(xsrc + col); *(f32x4*)(o + col) = xv * alpha + acc[ai][bj][m][n]; }
                }
            }
    }
};
template <class Epi, class Sched, bool ALIGN_EPI = false, bool SP2 = false>
__device__ __forceinline__ void gemm_phase(PG8_LAS unsigned char* lds, const Gemm g, const Sched& S, const Epi& E) {
    const int tid = threadIdx.x, wid = __builtin_amdgcn_readfirstlane(tid >> 6), lane = tid & 63, wr = wid >> 2, wc = wid & 3, fr = lane & 15, fq = lane >> 4;
    const int K = g.K, nt = K / BK;
    unsigned voffA[2], voffB[2];
#pragma unroll
    for (int i = 0; i < 2; ++i) { int R, C; stage_rc(tid * 16 + i * 8192, R, C); const int Rb = Epi::PERM ? ((R & ~31) + perm32(R & 31)) : R;
        voffA[i] = (unsigned)(R * K + C) * 2u; voffB[i] = (unsigned)(Rb * K + C) * 2u; }
    const size_t kstep = (size_t)(BK * 2);
    const size_t hstep = (size_t)HALF * K * 2;
    const size_t tstep = 2 * hstep;
    const unsigned ldsw = (unsigned)wid * 1024u;
    const int aoff = lds_byte(wr * 64 + fr, fq * 8), boff = lds_byte(wc * 32 + fr, fq * 8);
#define PG8_SA(b, h) (((b) * 2 + (h)) * HTB)
#define PG8_SB(b, h) ((4 + (b) * 2 + (h)) * HTB)
#define PG8_STAGE(bufoff, gbase, voff) do { _Pragma("unroll") for (int _i = 0; _i < 2; ++_i) \
        __builtin_amdgcn_global_load_lds((const unsigned*)((const char*)(gbase) + (voff)[_i]), (PG8_LAS unsigned*)(lds + (bufoff) + ldsw + _i * 8192), 16, 0, 0); } while (0)
#define PG8_LDA(dst, b, h) do { _Pragma("unroll") for (int m = 0; m < 4; ++m) _Pragma("unroll") for (int k = 0; k < 2; ++k) dst[m][k] = *(const PG8_LAS bf16x8*)(lds + PG8_SA(b, h) + aoff + m * 2048 + k * 1024); } while (0)
#define PG8_LDB(dst, b, h) do { _Pragma("unroll") for (int n = 0; n < 2; ++n) _Pragma("unroll") for (int k = 0; k < 2; ++k) dst[n][k] = *(const PG8_LAS bf16x8*)(lds + PG8_SB(b, h) + boff + n * 2048 + k * 1024); } while (0)
#define PG8_MMA(ai, bj, At, Bt) do { __builtin_amdgcn_s_setprio(1); _Pragma("unroll") for (int m = 0; m < 4; ++m) _Pragma("unroll") for (int n = 0; n < 2; ++n) _Pragma("unroll") for (int k = 0; k < 2; ++k) \
        acc[ai][bj][m][n] = __builtin_amdgcn_mfma_f32_16x16x32_bf16(Bt[n][k], At[m][k], acc[ai][bj][m][n], 0, 0, 0); __builtin_amdgcn_s_setprio(0); } while (0)
#define PG8_WAIT_V(n) asm volatile("s_waitcnt vmcnt(" #n ")" ::: "memory")
#define PG8_WAIT_L(n) asm volatile("s_waitcnt lgkmcnt(" #n ")" ::: "memory")
#define PG8_BAR __builtin_amdgcn_s_barrier()
#define PG8_SCHED __builtin_amdgcn_sched_barrier(0)
    Unit cur, nxt; int ui = 0;
    if (!S.next(0, cur)) return;
    f32x4 acc[2][2][4][2];
#pragma unroll
    for (int a = 0; a < 2; ++a)
#pragma unroll
        for (int b = 0; b < 2; ++b)
#pragma unroll
            for (int m = 0; m < 4; ++m)
#pragma unroll
                for (int n = 0; n < 2; ++n) acc[a][b][m][n] = (f32x4){0.f, 0.f, 0.f, 0.f};
    bf16x8 At[4][2], B0[2][2], B1[2][2];
    const char* cA = (const char*)g.A + (size_t)cur.pm * tstep; const char* cB = (const char*)g.Bt + (size_t)cur.pn * tstep;
    S.a_ready(cur);
    if constexpr (SP2) {
        PG8_STAGE(PG8_SB(0, 0), cB, voffB); PG8_STAGE(PG8_SB(0, 1), cB + hstep, voffB); PG8_STAGE(PG8_SA(0, 0), cA, voffA); PG8_STAGE(PG8_SA(0, 1), cA + hstep, voffA);
        if (wr == 1) PG8_BAR;
        PG8_WAIT_V(2); PG8_BAR;
        PG8_STAGE(PG8_SB(1, 0), cB + kstep, voffB); PG8_STAGE(PG8_SA(1, 0), cA + kstep, voffA); PG8_STAGE(PG8_SB(1, 1), cB + hstep + kstep, voffB);
        PG8_WAIT_V(6); PG8_BAR;
    } else {
        PG8_STAGE(PG8_SB(0, 0), cB, voffB); PG8_STAGE(PG8_SA(0, 0), cA, voffA); PG8_STAGE(PG8_SB(0, 1), cB + hstep, voffB); PG8_STAGE(PG8_SA(0, 1), cA + hstep, voffA);
        if (wr == 1) PG8_BAR;
        PG8_WAIT_V(4); PG8_BAR;
        PG8_STAGE(PG8_SB(1, 0), cB + kstep, voffB); PG8_STAGE(PG8_SA(1, 0), cA + kstep, voffA); PG8_STAGE(PG8_SB(1, 1), cB + hstep + kstep, voffB);
        PG8_WAIT_V(6); PG8_BAR;
    }
    for (;;) {
        const bool has_next = S.next(ui + 1, nxt);
        const char* nA = has_next ? (const char*)g.A + (size_t)nxt.pm * tstep : cA; const char* nB = has_next ? (const char*)g.Bt + (size_t)nxt.pn * tstep : cB;
        for (int t = 0; t < nt; t += 2) {
            const bool last = (t == nt - 2);
            const char* a1 = cA + (size_t)(t + 1) * kstep;
            const char* a2 = last ? nA : cA + (size_t)(t + 2) * kstep; const char* b2 = last ? nB : cB + (size_t)(t + 2) * kstep;
            const char* a3 = a2 + kstep; const char* b3 = b2 + kstep;
            if (last && has_next) S.a_ready(nxt);
            if constexpr (SP2) {
            PG8_LDB(B0, 0, 0); PG8_LDB(B1, 0, 1); PG8_SCHED; PG8_LDA(At, 0, 0); PG8_STAGE(PG8_SA(1, 1), a1 + hstep, voffA);
            PG8_WAIT_V(8); PG8_WAIT_L(0); PG8_BAR; PG8_MMA(0, 0, At, B0); PG8_MMA(0, 1, At, B1); PG8_BAR; PG8_SCHED;
            PG8_LDA(At, 0, 1); PG8_STAGE(PG8_SB(0, 0), b2, voffB); PG8_STAGE(PG8_SB(0, 1), b2 + hstep, voffB); PG8_STAGE(PG8_SA(0, 0), a2, voffA);
            PG8_WAIT_V(8); PG8_WAIT_L(0); PG8_BAR; PG8_MMA(1, 0, At, B0); PG8_MMA(1, 1, At, B1); PG8_BAR; PG8_SCHED;
            PG8_LDB(B0, 1, 0); PG8_LDB(B1, 1, 1); PG8_SCHED; PG8_LDA(At, 1, 0); PG8_STAGE(PG8_SA(0, 1), a2 + hstep, voffA);
            PG8_WAIT_V(8); PG8_WAIT_L(0); PG8_BAR; PG8_MMA(0, 0, At, B0); PG8_MMA(0, 1, At, B1); PG8_BAR; PG8_SCHED;
            PG8_LDA(At, 1, 1); PG8_STAGE(PG8_SB(1, 0), b3, voffB); PG8_STAGE(PG8_SB(1, 1), b3 + hstep, voffB); PG8_STAGE(PG8_SA(1, 0), a3, voffA);
            PG8_WAIT_V(8); PG8_WAIT_L(0); PG8_BAR; PG8_MMA(1, 0, At, B0); PG8_MMA(1, 1, At, B1); PG8_BAR; PG8_SCHED;
            } else {
            PG8_LDB(B0, 0, 0); PG8_SCHED; PG8_LDA(At, 0, 0); PG8_STAGE(PG8_SA(1, 1), a1 + hstep, voffA);
            PG8_WAIT_L(8); PG8_BAR; PG8_WAIT_L(0); PG8_MMA(0, 0, At, B0); PG8_BAR; PG8_SCHED;
            PG8_LDB(B1, 0, 1); PG8_STAGE(PG8_SB(0, 0), b2, voffB);
            PG8_BAR; PG8_WAIT_L(0); PG8_MMA(0, 1, At, B1); PG8_BAR;
            PG8_LDA(At, 0, 1); PG8_STAGE(PG8_SA(0, 0), a2, voffA);
            PG8_BAR; PG8_WAIT_L(0); PG8_MMA(1, 0, At, B0); PG8_BAR; PG8_SCHED;
            PG8_STAGE(PG8_SB(0, 1), b2 + hstep, voffB);
            PG8_WAIT_V(6); PG8_BAR; PG8_MMA(1, 1, At, B1); PG8_BAR;
            PG8_LDB(B0, 1, 0); PG8_SCHED; PG8_LDA(At, 1, 0); PG8_STAGE(PG8_SA(0, 1), a2 + hstep, voffA);
            PG8_WAIT_L(8); PG8_BAR; PG8_WAIT_L(0); PG8_MMA(0, 0, At, B0); PG8_BAR; PG8_SCHED;
            PG8_LDB(B1, 1, 1); PG8_STAGE(PG8_SB(1, 0), b3, voffB);
            PG8_BAR; PG8_WAIT_L(0); PG8_MMA(0, 1, At, B1); PG8_BAR;
            PG8_LDA(At, 1, 1); PG8_STAGE(PG8_SA(1, 0), a3, voffA);
            PG8_BAR; PG8_WAIT_L(0); PG8_MMA(1, 0, At, B0); PG8_BAR; PG8_SCHED;
            PG8_STAGE(PG8_SB(1, 1), b3 + hstep, voffB);
            PG8_WAIT_V(6); PG8_BAR; PG8_MMA(1, 1, At, B1); PG8_BAR;
            }
        }
        if constexpr (ALIGN_EPI) { if (wr == 0) PG8_BAR; }
        if constexpr (!Epi::AFTER_DRAIN) { E(acc, cur, wr, wc, fr, fq); S.done(cur); }
        if (!has_next) break;
#pragma unroll
        for (int a = 0; a < 2; ++a)
#pragma unroll
            for (int b = 0; b < 2; ++b)
#pragma unroll
                for (int m = 0; m < 4; ++m)
#pragma unroll
                    for (int n = 0; n < 2; ++n) acc[a][b][m][n] = (f32x4){0.f, 0.f, 0.f, 0.f};
        cur = nxt; cA = nA; cB = nB; ++ui;
        if constexpr (ALIGN_EPI) { if (wr == 1) PG8_BAR; }
    }
    PG8_WAIT_V(0);
    if constexpr (!ALIGN_EPI) { if (wr == 0) PG8_BAR; }
    PG8_BAR;
    if constexpr (Epi::AFTER_DRAIN) { E.fused(acc, cur, wr, wc, fr, fq, lds, wid, lane); S.done(cur); }
#undef PG8_SA
#undef PG8_SB
#undef PG8_STAGE
#undef PG8_LDA
#undef PG8_LDB
#undef PG8_MMA
#undef PG8_WAIT_V
#undef PG8_WAIT_L
#undef PG8_BAR
#undef PG8_SCHED
}
}

#define LAS __attribute__((address_space(3)))
#define XB_TMO      128
#define XB_XCNT(j)  (256  + 64 * (j))
#define XB_XSUB(j)  (1280 + 64 * (j))
#define XB_XGEN(j)  (2304 + 64 * (j))
#define XB_TOP      3328
#define XB_TOPGEN   3392
#define XCD_BAR_WORDS 3456
#define XB_SPIN_CAP (1u << 18)

__device__ __forceinline__ unsigned xb_ld(unsigned* p)              { return __hip_atomic_load(p, __ATOMIC_RELAXED, __HIP_MEMORY_SCOPE_AGENT); }
__device__ __forceinline__ unsigned xb_add(unsigned* p, unsigned v) { return __hip_atomic_fetch_add(p, v, __ATOMIC_RELAXED, __HIP_MEMORY_SCOPE_AGENT); }
__device__ __forceinline__ unsigned xb_xcc_id() { return (unsigned)__builtin_amdgcn_s_getreg((3 << 11) | 20) & 0xFu; }
#define XB_SPIN(cond, bar) do { unsigned _sp = 0; while (cond) { __builtin_amdgcn_s_sleep(1); \
    if ((++_sp & 255u) == 0u) { if (xb_ld(&(bar)[XB_TMO])) break; if (_sp > XB_SPIN_CAP) { atomicAdd(&(bar)[XB_TMO], 1u); break; } } } } while (0)

struct XcdBarrier {
    unsigned* bar; unsigned x;
    volatile LAS unsigned* st;
};

__device__ __forceinline__ XcdBarrier xcd_barrier_post(unsigned* bar, volatile LAS unsigned* st) {
    XcdBarrier b; b.bar = bar; b.x = xb_xcc_id(); b.st = st;
    if (threadIdx.x == 0) (void)xb_add(&bar[XB_XCNT(b.x)], 1u);
    return b;
}
__device__ __forceinline__ void xcd_barrier_complete(unsigned* bar, unsigned x, unsigned& nloc, unsigned& nx) {
    const unsigned G = gridDim.x * gridDim.y * gridDim.z;
    unsigned sum, cnt, mine, sp = 0u;
    for (;;) {
        sum = 0u; cnt = 0u; mine = 0u;
#pragma unroll
        for (unsigned j = 0; j < 16; ++j) { const unsigned c = xb_ld(&bar[XB_XCNT(j)]); sum += c; cnt += (c > 0u) ? 1u : 0u; mine = (j == x) ? c : mine; }
        if (sum == G) break;
        __builtin_amdgcn_s_sleep(1);
        if ((++sp & 255u) == 0u) { if (xb_ld(&bar[XB_TMO])) break; if (sp > XB_SPIN_CAP) { atomicAdd(&bar[XB_TMO], 1u); break; } }
    }
    nloc = mine > 0u ? mine : 1u; nx = cnt > 0u ? cnt : 1u;
}

__device__ __forceinline__ void xcd_barrier(const XcdBarrier& b) {
    asm volatile("s_waitcnt vmcnt(0)" ::: "memory");
    __syncthreads();
    if (threadIdx.x == 0) {
        unsigned* bar = b.bar;
        __builtin_amdgcn_s_waitcnt(0);
        unsigned nloc = b.st[0], nx = b.st[1];
        if (nloc == 0u) { xcd_barrier_complete(bar, b.x, nloc, nx); b.st[0] = nloc; b.st[1] = nx; }
        const unsigned old = xb_add(&bar[XB_XSUB(b.x)], 1u);
        const unsigned gen = old / nloc;
        if (old + 1u == (gen + 1u) * nloc) {
            __builtin_amdgcn_fence(__ATOMIC_RELEASE, "agent");
            asm volatile("s_waitcnt vmcnt(0)" ::: "memory");
            const unsigned og = xb_add(&bar[XB_TOP], 1u);
            const unsigned tg = og / nx;
            if (og + 1u == (tg + 1u) * nx) xb_add(&bar[XB_TOPGEN], 1u);
            else XB_SPIN(xb_ld(&bar[XB_TOPGEN]) == tg, bar);
            __builtin_amdgcn_fence(__ATOMIC_ACQUIRE, "agent");
            xb_add(&bar[XB_XGEN(b.x)], 1u);
            asm volatile("s_waitcnt vmcnt(0)" ::: "memory");
        } else {
            XB_SPIN(xb_ld(&bar[XB_XGEN(b.x)]) == gen, bar);
            __builtin_amdgcn_fence(__ATOMIC_ACQUIRE, "agent");
            asm volatile("s_waitcnt vmcnt(0)" ::: "memory");
        }
    }
    __syncthreads();
}

constexpr int D_MODEL = 2048, TP = 2064  , MPR = 4 * TP  , MSA = 1024, MROWS = MPR + MSA  , MPAD = 9472;
constexpr int NA = 4224, NAP = 4352, NB = 4096, NPAD = NAP + NB  , YROWS = 9216;
constexpr float ALPHA = 1.189207115002721f;
constexpr float LN_EPS = 1e-5f, GN_EPS_A = 64e-5f, GN_EPS_B = 1e-5f;
constexpr size_t O_YP = 0, O_YS = 16777216, O_RWKVP = 18874368, O_SHIFTP = 19136512, O_RETP = 19153408, O_RWKVS = 19677696, O_SHIFTS = 28066304, O_RETS = 28606976, O_END = 45384192;
constexpr size_t WS_CTL = 0, CTL_ZERO_BYTES = 1u << 20;
constexpr size_t WS_ZB = 1u << 20;
constexpr size_t WS_ZA = WS_ZB + (size_t)MPAD * NB * 2;
constexpr size_t WS_WOUT = WS_ZA + (size_t)MPAD * NAP * 2;
constexpr size_t WS_ROPE = WS_WOUT + (size_t)2048 * 2048 * 2;
constexpr size_t WS_W = WS_ROPE + (size_t)2072 * 64 * 8;
constexpr size_t WS_A = WS_W + (size_t)MROWS * 1024 * 2;
constexpr size_t WS_GATE = WS_A + (size_t)MROWS * 1024 * 2;
constexpr size_t WS_BONUS = WS_GATE + (size_t)MROWS * 1024 * 2;
constexpr size_t WS_U = WS_BONUS + (size_t)MROWS * 1024 * 2;
constexpr size_t WS_END = WS_U + (size_t)256 * 16384 * 4;
constexpr size_t OB_XB = 0;
constexpr size_t OB_WIN = O_RETS * 4;

constexpr int LDS_BYTES = 147456, MISC_OFF = 131072 + 320;
constexpr int CW_BAR = 4096;


typedef unsigned short bf16;
typedef unsigned v4u __attribute__((ext_vector_type(4)));
typedef unsigned v2u __attribute__((ext_vector_type(2)));
typedef float f32x4 __attribute__((ext_vector_type(4)));
typedef float f32x2 __attribute__((ext_vector_type(2)));
#define LDS_WAIT() asm volatile("s_waitcnt lgkmcnt(0)" ::: "memory")
__device__ __forceinline__ float bf2f(unsigned b) { return __uint_as_float(b << 16); }
__device__ __forceinline__ unsigned f2bf(float f) { unsigned u = __float_as_uint(f); return (u + 0x7fffu + ((u >> 16) & 1u)) >> 16; }
__device__ __forceinline__ unsigned pk2(float lo, float hi) { return f2bf(lo) | (f2bf(hi) << 16); }
__device__ __forceinline__ float sigmoidf_(float x) { return 1.0f / (1.0f + __expf(-x)); }
__device__ __forceinline__ float tanh_(float x) { return 1.0f - 2.0f / (1.0f + __expf(2.0f * x)); }

template <int CTRL> __device__ __forceinline__ float dpp_f(float x) { return __builtin_bit_cast(float, __builtin_amdgcn_update_dpp(0, __builtin_bit_cast(int, x), CTRL, 0xf, 0xf, true)); }
__device__ __forceinline__ float allreduce4(float v) { v += dpp_f<0xB1>(v); v += dpp_f<0x4E>(v); return v; }
__device__ __forceinline__ float allreduce8(float v) { v = allreduce4(v); v += dpp_f<0x141>(v); return v; }
__device__ __forceinline__ float allreduce16(float v) { v = allreduce8(v); v += dpp_f<0x140>(v); return v; }
__device__ __forceinline__ float allreduce64(float v) { v = allreduce16(v); v += __shfl_xor(v, 16); v += __shfl_xor(v, 32); return v; }
__device__ __forceinline__ float reduce63(float v) {
    v = allreduce16(v);
    v += __builtin_bit_cast(float, __builtin_amdgcn_update_dpp(0, __builtin_bit_cast(int, v), 0x142, 0xa, 0xf, false));
    v += __builtin_bit_cast(float, __builtin_amdgcn_update_dpp(0, __builtin_bit_cast(int, v), 0x143, 0xc, 0xf, false));
    return v;
}

struct Args { const float* in[22]; float* out; unsigned char* ws; int ph_lo, ph_hi; };

struct Frame {
    LAS unsigned char* lds;
    int tid, lane, wave, G, blk;
    const float *x_prompt, *x_sample, *state_rwkv, *state_shift, *state_ret, *meta, *w_in, *w_out, *shift_mix, *w0, *w_up, *a0, *a_up, *k_k, *k_a, *r_k, *gn_a_g, *gn_a_b, *gn_b_g, *gn_b_b, *ln_g, *ln_b;
    float* out;
    bf16 *XB, *WINT, *ZB, *ZA, *MX, *WOUT, *DW, *AA, *GATE, *BONUS;
    float *UB; f32x2* ROPE;
};

__device__ __forceinline__ void p0_transpose_item(const float* W, int ldw, int k0, int srccol0, bf16* WT, int K, int dstrow0, LAS float* scr, int lane) {
#pragma unroll 8
    for (int i = 0; i < 32; ++i) { const int kk = 2 * i + (lane >> 5); scr[kk * 33 + (lane & 31)] = W[(size_t)(k0 + kk) * ldw + srccol0 + (lane & 31)]; }
    LDS_WAIT(); asm volatile("" ::: "memory");
    const int c = lane & 7;
#pragma unroll
    for (int j = 0; j < 4; ++j) { const int n = (lane >> 3) + 8 * j; const LAS float* s = scr + (8 * c) * 33 + n;
        v4u o; o.x = pk2(s[0 * 33], s[1 * 33]); o.y = pk2(s[2 * 33], s[3 * 33]); o.z = pk2(s[4 * 33], s[5 * 33]); o.w = pk2(s[6 * 33], s[7 * 33]);
        *(v4u*)(WT + (size_t)(dstrow0 + n) * K + k0 + 8 * c) = o; }
    LDS_WAIT(); asm volatile("" ::: "memory");
}
__device__ __forceinline__ void p0_prologue(const Frame& F) {
    LAS float* scr = (LAS float*)(F.lds + F.wave * 16384);
    const int gw = F.blk * 8 + F.wave, NGW = F.G * 8;
    constexpr int I_IN = 32 * 260, I_OUT = 32 * 64;
    for (int it = gw; it < I_IN + I_OUT; it += NGW) {
        if (it < I_IN) { const int kb = it / 260, nb = it % 260, d0 = 32 * nb, s0 = d0 < 4096 ? 4224 + d0 : d0 - 4096;
            p0_transpose_item(F.w_in, 8320, 64 * kb, s0, F.WINT, 2048, d0, scr, F.lane); }
        else { const int r = it - I_IN, kb = r / 64, nb = r % 64;
            p0_transpose_item(F.w_out, 2048, 64 * kb, 32 * nb, F.WOUT, 2048, 32 * nb, scr, F.lane); }
    }
    { v4u z = {0u, 0u, 0u, 0u}; v4u* p = (v4u*)(F.WINT + (size_t)8320 * 2048);
      for (int i = F.blk * 512 + F.tid; i < 128 * 2048 * 2 / 16; i += F.G * 512) p[i] = z; }
    for (int m = gw; m < MPAD; m += NGW) {
        const float* src = nullptr;
        if (m < MPR) { const int b = m / TP, t = m - b * TP; src = t < 16 ? F.meta + (size_t)t * 2048 : F.x_prompt + ((size_t)b * 2048 + (t - 16)) * 2048; }
        else if (m < MROWS) src = F.x_sample + (size_t)(m - MPR) * 2048;
        v2u* dst = (v2u*)(F.XB + (size_t)m * 2048);
#pragma unroll
        for (int j = 0; j < 8; ++j) { f32x4 v = {0.f, 0.f, 0.f, 0.f}; if (src) v = ((const f32x4*)src)[F.lane + 64 * j];
            v2u o; o.x = pk2(v.x, v.y); o.y = pk2(v.z, v.w); dst[F.lane + 64 * j] = o; }
    }
    for (int i = F.blk * 512 + F.tid; i < 2072 * 64; i += F.G * 512) {
        const int p = i >> 6, f = i & 63; const int pos = p < 2064 ? p : 16384 + (p - 2064);
        const double x = (double)pos * ROPE_INV[f];
        const double n = __builtin_rint(x * 0.15915494309189535);
        double r = __builtin_fma(-n, 6.283185307179586, x); r = __builtin_fma(-n, 2.4492935982947064e-16, r);
        const double r2 = r * r; double s = 1.0, c = 1.0;
#pragma unroll
        for (int k = 12; k >= 1; --k) { s = 1.0 - s * r2 * (1.0 / (double)((2 * k) * (2 * k + 1))); c = 1.0 - c * r2 * (1.0 / (double)((2 * k - 1) * (2 * k))); }
        f32x2 o; o.x = (float)c; o.y = (float)(r * s); F.ROPE[i] = o;
    }
}

__device__ __forceinline__ void p2_pre(const Frame& F) {
    LAS float* tw = (LAS float*)F.lds;
    const int lane = F.lane, tid = F.tid;
    for (int u = F.blk; u < 145 * 16; u += F.G) {
        const int h = u & 15, rowbase = (u >> 4) * 64;
        {
            const int r = tid >> 3, cg = tid & 7, row = rowbase + r, col = 4096 + cg * 16;
            int kind = 0, bs = 0;
            if (row < MPR) { if (row % TP == 0) kind = 1; } else { const int s = row - MPR; if ((s & 7) == 0) { kind = 2; bs = s >> 3; } }
            const v4u* zp = (const v4u*)(F.ZA + (size_t)row * NAP + col); const v4u za0 = zp[0], za1 = zp[1];
            float cur[16], prv[16];
            const unsigned zw_[8] = {za0.x, za0.y, za0.z, za0.w, za1.x, za1.y, za1.z, za1.w};
#pragma unroll
            for (int i = 0; i < 8; ++i) { cur[2 * i] = bf2f(zw_[i] & 0xffffu); cur[2 * i + 1] = bf2f(zw_[i] >> 16); }
            if (kind == 0) { const v4u* pp = (const v4u*)(F.ZA + (size_t)(row - 1) * NAP + col); const v4u p0 = pp[0], p1 = pp[1];
                const unsigned pw_[8] = {p0.x, p0.y, p0.z, p0.w, p1.x, p1.y, p1.z, p1.w};
#pragma unroll
                for (int i = 0; i < 8; ++i) { prv[2 * i] = bf2f(pw_[i] & 0xffffu); prv[2 * i + 1] = bf2f(pw_[i] >> 16); } }
            else if (kind == 1) {
#pragma unroll
                for (int i = 0; i < 16; ++i) prv[i] = 0.f; }
            else { const f32x4* sp = (const f32x4*)(F.state_shift + (size_t)bs * NA + col);
#pragma unroll
                for (int i = 0; i < 4; ++i) { const f32x4 t = sp[i]; prv[4 * i] = t.x; prv[4 * i + 1] = t.y; prv[4 * i + 2] = t.z; prv[4 * i + 3] = t.w; } }
            const f32x4* mp = (const f32x4*)(F.shift_mix + col);
#pragma unroll
            for (int i = 0; i < 4; ++i) { const f32x4 mx = mp[i]; f32x4 o;
                o.x = cur[4 * i] + (prv[4 * i] - cur[4 * i]) * mx.x; o.y = cur[4 * i + 1] + (prv[4 * i + 1] - cur[4 * i + 1]) * mx.y;
                o.z = cur[4 * i + 2] + (prv[4 * i + 2] - cur[4 * i + 2]) * mx.z; o.w = cur[4 * i + 3] + (prv[4 * i + 3] - cur[4 * i + 3]) * mx.w;
                if (cg < 4) { o.x = tanh_(o.x); o.y = tanh_(o.y); o.z = tanh_(o.z); o.w = tanh_(o.w); }
                *(LAS f32x4*)(tw + r * 128 + cg * 16 + 4 * i) = o; }
        }
        __syncthreads();
        {
            const int hc = h * 64 + lane;
            float wup[64], aup[64];
#pragma unroll
            for (int j = 0; j < 64; ++j) { wup[j] = F.w_up[j * 1024 + hc]; aup[j] = F.a_up[j * 1024 + hc]; }
            const float w0c = F.w0[hc], a0c = F.a0[hc], kac = F.k_a[hc], rkc = F.r_k[hc];
            const float mr = F.shift_mix[hc], mk = F.shift_mix[1024 + hc], mv = F.shift_mix[2048 + hc], mg = F.shift_mix[3072 + hc];
            for (int rr = 0; rr < 8; ++rr) {
                const int r = F.wave * 8 + rr, row = rowbase + r;
                int kind = 0, bs = 0;
                if (row < MPR) { if (row % TP == 0) kind = 1; } else { const int s = row - MPR; if ((s & 7) == 0) { kind = 2; bs = s >> 3; } }
                const bf16* zr = F.ZA + (size_t)row * NAP + hc;
                const float cr = bf2f(zr[0]), ck = bf2f(zr[1024]), cv = bf2f(zr[2048]), cg_ = bf2f(zr[3072]);
                float pr = 0.f, pk = 0.f, pv = 0.f, pg = 0.f;
                if (kind == 0) { const bf16* zq = zr - NAP; pr = bf2f(zq[0]); pk = bf2f(zq[1024]); pv = bf2f(zq[2048]); pg = bf2f(zq[3072]); }
                else if (kind == 2) { const float* sp = F.state_shift + (size_t)bs * NA + hc; pr = sp[0]; pk = sp[1024]; pv = sp[2048]; pg = sp[3072]; }
                float aw = w0c, aa = a0c;
#pragma unroll
                for (int j = 0; j < 16; ++j) { const f32x4 t = *(const LAS f32x4*)(tw + r * 128 + 4 * j), z = *(const LAS f32x4*)(tw + r * 128 + 64 + 4 * j);
                    aw += t.x * wup[4 * j] + t.y * wup[4 * j + 1] + t.z * wup[4 * j + 2] + t.w * wup[4 * j + 3];
                    aa += z.x * aup[4 * j] + z.y * aup[4 * j + 1] + z.z * aup[4 * j + 2] + z.w * aup[4 * j + 3]; }
                const float rs = cr + (pr - cr) * mr, ks = ck + (pk - ck) * mk, vs = cv + (pv - cv) * mv, gs = cg_ + (pg - cg_) * mg;
                const float lw = -sigmoidf_(aw) * 0.6065306597126334f;
                const float dw = fabsf(lw) < 0.01f ? -(lw + 0.5f * lw * lw + 0.16666667f * lw * lw * lw) : 1.0f - __expf(lw);
                const float a = sigmoidf_(aa);
                const float kp = ks * (1.0f + (a - 1.0f) * kac);
                const float coef = allreduce64(rs * kp * rkc);
                const float gate = gs * sigmoidf_(gs);
                const size_t o = (size_t)row * 1024 + hc;
                F.DW[o] = (bf16)f2bf(dw); F.AA[o] = (bf16)f2bf(a); F.GATE[o] = (bf16)f2bf(gate); F.BONUS[o] = (bf16)f2bf(coef * vs * gate);
            }
        }
        __syncthreads();
    }
    for (int i = F.blk * 512 + tid; i < 132 * NA; i += F.G * 512) {
        const int s = i / NA, c = i - s * NA;
        if (s < 4) F.out[O_SHIFTP + (size_t)s * NA + c] = bf2f(F.ZA[(size_t)(s * TP + TP - 1) * NAP + c]);
        else F.out[O_SHIFTS + (size_t)(s - 4) * NA + c] = bf2f(F.ZA[(size_t)(MPR + (s - 4) * 8 + 7) * NAP + c]);
    }
}

constexpr int SC_PROMPT_CH = 129, SC_SAMPLE_CH = 32, SC_NCH = SC_PROMPT_CH + SC_SAMPLE_CH;
struct ScanDesc { int zrow0, nsteps, yrow0, first, last, h, q, sb, sample; };
__device__ __forceinline__ ScanDesc scan_desc(int blk, int ci) {
    ScanDesc d;
    if (ci < SC_PROMPT_CH) { const int b = blk >> 6; d.h = (blk >> 2) & 15; d.q = blk & 3; d.zrow0 = b * TP + ci * 16; d.nsteps = 16; d.yrow0 = b * 2048 + ci * 16 - 16;
        d.first = ci == 0; d.last = ci == SC_PROMPT_CH - 1; d.sample = 0; d.sb = b; }
    else { const int su = (ci - SC_PROMPT_CH) * 256 + blk; d.q = su & 3; d.h = (su >> 2) & 15; const int bs = su >> 6; d.zrow0 = MPR + bs * 8; d.nsteps = 8; d.yrow0 = 8192 + bs * 8;
        d.first = 1; d.last = 1; d.sample = 1; d.sb = bs; }
    return d;
}
struct ScanLoad { unsigned short zr[5], zk[5], zv[5], av[4], wv[4]; float sr, sk, sv; float kkc, kac, mr, mk, mv; };
__device__ __forceinline__ void scan_issue(const Frame& F, const ScanDesc& d, int lw, ScanLoad& L) {
    const int spw = d.nsteps >> 2, hc = d.h * 64 + F.lane, r0 = d.zrow0 + lw * spw;
    const bool ext = d.first && lw == 0;
    L.kkc = F.k_k[hc]; L.kac = F.k_a[hc]; L.mr = F.shift_mix[hc]; L.mk = F.shift_mix[1024 + hc]; L.mv = F.shift_mix[2048 + hc];
    L.sr = 0.f; L.sk = 0.f; L.sv = 0.f;
    if (ext) { L.zr[0] = 0; L.zk[0] = 0; L.zv[0] = 0;
        if (d.sample) { const float* sp = F.state_shift + (size_t)d.sb * NA + hc; L.sr = sp[0]; L.sk = sp[1024]; L.sv = sp[2048]; } }
    else { const bf16* z = F.ZA + (size_t)(r0 - 1) * NAP + hc; L.zr[0] = z[0]; L.zk[0] = z[1024]; L.zv[0] = z[2048]; }
#pragma unroll
    for (int j = 0; j < 4; ++j) if (j < spw) { const bf16* z = F.ZA + (size_t)(r0 + j) * NAP + hc; L.zr[j + 1] = z[0]; L.zk[j + 1] = z[1024]; L.zv[j + 1] = z[2048];
        L.av[j] = F.AA[(size_t)(r0 + j) * 1024 + hc]; L.wv[j] = F.DW[(size_t)(r0 + j) * 1024 + hc]; }
}
__device__ __forceinline__ void scan_finish(const Frame& F, const ScanDesc& d, int lw, const ScanLoad& L, LAS float* sbuf) {
    const int spw = d.nsteps >> 2; const bool ext = d.first && lw == 0;
    float pr = ext ? L.sr : bf2f(L.zr[0]), pk = ext ? L.sk : bf2f(L.zk[0]), pv = ext ? L.sv : bf2f(L.zv[0]);
#pragma unroll
    for (int j = 0; j < 4; ++j) if (j < spw) {
        const float cr = bf2f(L.zr[j + 1]), ck = bf2f(L.zk[j + 1]), cv = bf2f(L.zv[j + 1]);
        const float r = cr + (pr - cr) * L.mr, k = ck + (pk - ck) * L.mk, v = cv + (pv - cv) * L.mv;
        pr = cr; pk = ck; pv = cv;
        const float a = bf2f(L.av[j]);
        float kk = k * L.kkc; const float n2 = allreduce64(kk * kk); kk = kk / fmaxf(sqrtf(n2), 1e-12f);
        const float kp = k * (1.0f + (a - 1.0f) * L.kac);
        LAS float* s = sbuf + (lw * spw + j) * 384 + F.lane;
        s[0] = r; s[64] = 1.0f - bf2f(L.wv[j]); s[128] = kp; s[192] = kk; s[256] = kk * a; s[320] = v;
    }
}
__device__ __forceinline__ void p3_rwkv(const Frame& F) {
    LAS float* SBUF = (LAS float*)F.lds;
    LAS float* OBUF = (LAS float*)(F.lds + 49152);
    const int lane = F.lane, wave = F.wave; const bool scanner = wave < 4;
    const int rs = lane >> 4, ks = lane & 15;
    ScanLoad L; f32x4 S = {0.f, 0.f, 0.f, 0.f}, Sn = {0.f, 0.f, 0.f, 0.f};
    if (!scanner) { const ScanDesc d0 = scan_desc(F.blk, 0); scan_issue(F, d0, wave - 4, L); scan_finish(F, d0, wave - 4, L, SBUF); }
    __syncthreads();
    for (int ci = 0; ci < SC_NCH; ++ci) {
        const ScanDesc d = scan_desc(F.blk, ci); const int buf = ci & 1;
        if (scanner) {
            const int rw = d.q * 16 + wave * 4 + rs;
            if (d.first) S = d.sample ? Sn : (f32x4){0.f, 0.f, 0.f, 0.f};
            if (ci + 1 < SC_NCH && ci + 1 >= SC_PROMPT_CH) { const ScanDesc dn = scan_desc(F.blk, ci + 1);
                Sn = *(const f32x4*)(F.state_rwkv + ((size_t)(dn.sb * 16 + dn.h) * 64 + dn.q * 16 + wave * 4 + rs) * 64 + 4 * ks); }
            const LAS float* sb0 = SBUF + buf * (16 * 384); LAS float* ob = OBUF + buf * 256 + wave * 4 + rs;
            for (int s0 = 0; s0 < d.nsteps; s0 += 8) {
#pragma unroll
                for (int j = 0; j < 8; ++j) { const LAS float* sb = sb0 + (s0 + j) * 384;
                    const f32x4 r4 = *(const LAS f32x4*)(sb + 4 * ks), w4 = *(const LAS f32x4*)(sb + 64 + 4 * ks), k4 = *(const LAS f32x4*)(sb + 128 + 4 * ks),
                                kk4 = *(const LAS f32x4*)(sb + 192 + 4 * ks), b4 = *(const LAS f32x4*)(sb + 256 + 4 * ks); const float v = sb[320 + rw];
                    float sa = S.x * kk4.x + S.y * kk4.y + S.z * kk4.z + S.w * kk4.w; sa = -allreduce16(sa);
                    S.x = S.x * w4.x + (v * k4.x + sa * b4.x); S.y = S.y * w4.y + (v * k4.y + sa * b4.y); S.z = S.z * w4.z + (v * k4.z + sa * b4.z); S.w = S.w * w4.w + (v * k4.w + sa * b4.w);
                    float o = S.x * r4.x + S.y * r4.y + S.z * r4.z + S.w * r4.w; o = allreduce16(o);
                    if (ks == 0) ob[(s0 + j) * 16] = o; }
            }
            if (d.last) { float* dst = d.sample ? F.out + O_RWKVS : F.out + O_RWKVP; *(f32x4*)(dst + ((size_t)(d.sb * 16 + d.h) * 64 + rw) * 64 + 4 * ks) = S; }
        } else {
            const int lw = wave - 4; ScanDesc dn = d; const bool more = ci + 1 < SC_NCH;
            if (more) { dn = scan_desc(F.blk, ci + 1); scan_issue(F, dn, lw, L); }
            if (ci > 0) { const ScanDesc dp = scan_desc(F.blk, ci - 1); const int i = F.tid - 256, s = i >> 4, r = i & 15;
                if (s < dp.nsteps && dp.yrow0 + s >= 0 && (dp.sample || ci - 1 > 0)) F.out[(size_t)(dp.yrow0 + s) * 2048 + dp.h * 64 + dp.q * 16 + r] = OBUF[((ci - 1) & 1) * 256 + i]; }
            if (more) scan_finish(F, dn, lw, L, SBUF + ((ci + 1) & 1) * (16 * 384));
        }
        __syncthreads();
    }
    if (!scanner) { const ScanDesc dp = scan_desc(F.blk, SC_NCH - 1); const int i = F.tid - 256, s = i >> 4, r = i & 15;
        if (s < dp.nsteps) F.out[(size_t)(dp.yrow0 + s) * 2048 + dp.h * 64 + dp.q * 16 + r] = OBUF[((SC_NCH - 1) & 1) * 256 + i]; }
    __syncthreads();
}

typedef short bf16x8 __attribute__((ext_vector_type(8)));
typedef float f32x16 __attribute__((ext_vector_type(16)));
#define MFMA32(a, b, c) __builtin_amdgcn_mfma_f32_32x32x16_bf16(a, b, c, 0, 0, 0)
constexpr int R_QS = 0, R_KS = 64 * 272, R_KT = 2 * 64 * 272, R_VT = R_KT + 128 * 144, R_END = R_VT + 128 * 144;
__device__ __forceinline__ int tr_off(int R, int tok) { return R * 144 + ((((tok >> 3) ^ (R >> 3)) & 7) << 4) + (tok & 7) * 2; }
__device__ __forceinline__ void rot8(const v4u& x1, const v4u& x2, const f32x4 (&cs)[4], float (&r1)[8], float (&r2)[8]) {
    const unsigned a_[4] = {x1.x, x1.y, x1.z, x1.w}, b_[4] = {x2.x, x2.y, x2.z, x2.w};
#pragma unroll
    for (int p = 0; p < 4; ++p) { const float a0 = bf2f(a_[p] & 0xffffu), a1 = __uint_as_float(a_[p] & 0xffff0000u), b0 = bf2f(b_[p] & 0xffffu), b1 = __uint_as_float(b_[p] & 0xffff0000u);
        const float c0 = cs[p].x, s0 = cs[p].y, c1 = cs[p].z, s1 = cs[p].w;
        r1[2 * p] = a0 * c0 - b0 * s0; r2[2 * p] = a0 * s0 + b0 * c0; r1[2 * p + 1] = a1 * c1 - b1 * s1; r2[2 * p + 1] = a1 * s1 + b1 * c1; }
}
template <bool WITH_Q>
__device__ __forceinline__ void ret_stage(const Frame& F, LAS unsigned char* L, int zrow0, int pidx0, int t0, int h, float lg2) {
    const int tid = F.tid;
    if (tid < 256) {
        const bool isq = tid >= 128;
        if (!isq || WITH_Q) {
            const int tt = tid & 127, jq = tt >> 3, dg = tt & 7; const int colbase = (isq ? 0 : 1024) + h * 128 + 8 * dg;
#pragma unroll
            for (int up = 0; up < 2; ++up) {
                float r1[2][8], r2[2][8], st[2];
#pragma unroll
                for (int uu = 0; uu < 2; ++uu) {
                    const int j = 4 * jq + 2 * up + uu, t = t0 + j;
                    v4u x1 = {0u, 0u, 0u, 0u}, x2 = {0u, 0u, 0u, 0u}; f32x4 cs[4] = {{1.f, 0.f, 1.f, 0.f}, {1.f, 0.f, 1.f, 0.f}, {1.f, 0.f, 1.f, 0.f}, {1.f, 0.f, 1.f, 0.f}};
                    if (t >= 0) { const bf16* z = F.ZB + (size_t)(zrow0 + t) * NB + colbase; x1 = *(const v4u*)z; x2 = *(const v4u*)(z + 64);
                        const f32x4* rp = (const f32x4*)(F.ROPE + (size_t)(pidx0 + t) * 64 + 8 * dg); cs[0] = rp[0]; cs[1] = rp[1]; cs[2] = rp[2]; cs[3] = rp[3]; }
                    rot8(x1, x2, cs, r1[uu], r2[uu]);
                    const float srm = isq ? __builtin_amdgcn_exp2f((float)j * lg2) : __builtin_amdgcn_exp2f(-(float)j * lg2) * 0.08838834764831845f;
                    st[uu] = __builtin_amdgcn_exp2f((float)(63 - j) * lg2) * 0.08838834764831845f;
                    v4u w1, w2;
                    w1.x = pg8::cvt_pk_bf16(r1[uu][0] * srm, r1[uu][1] * srm); w1.y = pg8::cvt_pk_bf16(r1[uu][2] * srm, r1[uu][3] * srm); w1.z = pg8::cvt_pk_bf16(r1[uu][4] * srm, r1[uu][5] * srm); w1.w = pg8::cvt_pk_bf16(r1[uu][6] * srm, r1[uu][7] * srm);
                    w2.x = pg8::cvt_pk_bf16(r2[uu][0] * srm, r2[uu][1] * srm); w2.y = pg8::cvt_pk_bf16(r2[uu][2] * srm, r2[uu][3] * srm); w2.z = pg8::cvt_pk_bf16(r2[uu][4] * srm, r2[uu][5] * srm); w2.w = pg8::cvt_pk_bf16(r2[uu][6] * srm, r2[uu][7] * srm);
                    LAS unsigned char* rm = L + (isq ? R_QS : R_KS) + j * 272 + 16 * dg;
                    *(LAS v4u*)rm = w1; *(LAS v4u*)(rm + 128) = w2;
                }
                if (!isq) {
#pragma unroll
                    for (int e = 0; e < 8; ++e) {
                        *(LAS unsigned*)(L + R_KT + tr_off(8 * dg + e, 4 * jq + 2 * up)) = pg8::cvt_pk_bf16(r1[0][e] * st[0], r1[1][e] * st[1]);
                        *(LAS unsigned*)(L + R_KT + tr_off(64 + 8 * dg + e, 4 * jq + 2 * up)) = pg8::cvt_pk_bf16(r2[0][e] * st[0], r2[1][e] * st[1]); }
                }
            }
        }
    } else {
        const int tt = tid - 256, jq = tt >> 4, eg = tt & 15; v4u x[4];
#pragma unroll
        for (int u = 0; u < 4; ++u) { const int t = t0 + 4 * jq + u; x[u] = (v4u){0u, 0u, 0u, 0u};
            if (t >= 0) x[u] = *(const v4u*)(F.ZB + (size_t)(zrow0 + t) * NB + 2048 + h * 128 + 8 * eg); }
        const unsigned x0_[4] = {x[0].x, x[0].y, x[0].z, x[0].w}, x1_[4] = {x[1].x, x[1].y, x[1].z, x[1].w}, x2_[4] = {x[2].x, x[2].y, x[2].z, x[2].w}, x3_[4] = {x[3].x, x[3].y, x[3].z, x[3].w};
#pragma unroll
        for (int p = 0; p < 4; ++p) {
            v2u lo, hi;
            lo.x = (x0_[p] & 0xffffu) | (x1_[p] << 16); lo.y = (x2_[p] & 0xffffu) | (x3_[p] << 16);
            hi.x = (x0_[p] >> 16) | (x1_[p] & 0xffff0000u); hi.y = (x2_[p] >> 16) | (x3_[p] & 0xffff0000u);
            *(LAS v2u*)(L + R_VT + tr_off(8 * eg + 2 * p, 4 * jq)) = lo; *(LAS v2u*)(L + R_VT + tr_off(8 * eg + 2 * p + 1, 4 * jq)) = hi; }
    }
}
__device__ __forceinline__ bf16x8 pack8(const f32x16& v, int s, float sc) {
    v4u u;
    if (s == 0) { u.x = pg8::cvt_pk_bf16(v[0] * sc, v[1] * sc); u.y = pg8::cvt_pk_bf16(v[2] * sc, v[3] * sc); u.z = pg8::cvt_pk_bf16(v[4] * sc, v[5] * sc); u.w = pg8::cvt_pk_bf16(v[6] * sc, v[7] * sc); }
    else { u.x = pg8::cvt_pk_bf16(v[8] * sc, v[9] * sc); u.y = pg8::cvt_pk_bf16(v[10] * sc, v[11] * sc); u.z = pg8::cvt_pk_bf16(v[12] * sc, v[13] * sc); u.w = pg8::cvt_pk_bf16(v[14] * sc, v[15] * sc); }
    return __builtin_bit_cast(bf16x8, u);
}
__device__ __forceinline__ bf16x8 ld2x8(const LAS unsigned char* p0, const LAS unsigned char* p1) { const v2u a = *(const LAS v2u*)p0, b = *(const LAS v2u*)p1; v4u u = {a.x, a.y, b.x, b.y}; return __builtin_bit_cast(bf16x8, u); }
__device__ __forceinline__ bf16x8 ld16(const LAS unsigned char* p) { return __builtin_bit_cast(bf16x8, *(const LAS v4u*)p); }
__device__ __forceinline__ int ret_chunk_lo(int seg) { return seg == 0 ? 0 : 4 * seg + 1; }
__device__ __forceinline__ int ret_chunk_hi(int seg) { return 4 * seg + 5; }

__device__ __forceinline__ void ret_pass1(const Frame& F, float* UB) {
    LAS unsigned char* L = F.lds;
    const int blk = F.blk, b = blk >> 6, h = (blk >> 3) & 7, seg = blk & 7, lane = F.lane, wave = F.wave, r = lane & 31, hh = lane >> 5, et = wave & 3, dp = wave >> 2;
    const float gam = 1.0f - __builtin_ldexpf(1.0f, -5 - h), lg2 = __builtin_log2f(gam), g64 = __builtin_amdgcn_exp2f(64.0f * lg2);
    f32x16 S[2];
#pragma unroll
    for (int i = 0; i < 16; ++i) { S[0][i] = 0.f; S[1][i] = 0.f; }
    for (int cc = ret_chunk_lo(seg); cc < ret_chunk_hi(seg); ++cc) {
        ret_stage<false>(F, L, b * TP, 0, -48 + 64 * cc, h, lg2);
        __syncthreads();
#pragma unroll
        for (int d2 = 0; d2 < 2; ++d2) { const int dt = 2 * dp + d2;
#pragma unroll
            for (int i = 0; i < 16; ++i) S[d2][i] *= g64;
#pragma unroll
            for (int ks = 0; ks < 4; ++ks) S[d2] = MFMA32(ld16(L + R_KT + tr_off(32 * dt + r, 16 * ks + 8 * hh)), ld16(L + R_VT + tr_off(32 * et + r, 16 * ks + 8 * hh)), S[d2]); }
        __syncthreads();
    }
    float* U = UB + (size_t)blk * 16384;
#pragma unroll
    for (int d2 = 0; d2 < 2; ++d2)
#pragma unroll
        for (int i = 0; i < 16; ++i) U[(size_t)(32 * (2 * dp + d2) + (i & 3) + 8 * (i >> 2) + 4 * hh) * 128 + 32 * et + r] = S[d2][i];
}
__device__ __forceinline__ void ret_pass2(const Frame& F, const float* UB) {
    LAS unsigned char* L = F.lds;
    const int blk = F.blk, b = blk >> 6, h = (blk >> 3) & 7, seg = blk & 7, lane = F.lane, wave = F.wave, r = lane & 31, hh = lane >> 5, et = wave & 3, it = wave >> 2;
    const float gam = 1.0f - __builtin_ldexpf(1.0f, -5 - h), lg2 = __builtin_log2f(gam), g64 = __builtin_amdgcn_exp2f(64.0f * lg2), g256 = __builtin_amdgcn_exp2f(256.0f * lg2);
    f32x16 S[4];
#pragma unroll
    for (int dt = 0; dt < 4; ++dt)
#pragma unroll
        for (int i = 0; i < 16; ++i) S[dt][i] = 0.f;
    for (int sp = 0; sp < seg; ++sp) {
        const float* U = UB + (size_t)((blk & ~7) + sp) * 16384;
#pragma unroll
        for (int dt = 0; dt < 4; ++dt)
#pragma unroll
            for (int i = 0; i < 16; ++i) S[dt][i] = S[dt][i] * g256 + U[(size_t)(32 * dt + (i & 3) + 8 * (i >> 2) + 4 * hh) * 128 + 32 * et + r];
    }
    for (int cc = ret_chunk_lo(seg); cc < ret_chunk_hi(seg); ++cc) {
        const int t0 = -48 + 64 * cc;
        ret_stage<true>(F, L, b * TP, 0, t0, h, lg2);
        __syncthreads();
        f32x16 X[2], O;
#pragma unroll
        for (int i = 0; i < 16; ++i) { X[0][i] = 0.f; X[1][i] = 0.f; O[i] = 0.f; }
#pragma unroll
        for (int jt = 0; jt < 2; ++jt) if (jt <= it) {
#pragma unroll
            for (int ks = 0; ks < 8; ++ks) X[jt] = MFMA32(ld16(L + R_KS + (32 * jt + r) * 272 + (16 * ks + 8 * hh) * 2), ld16(L + R_QS + (32 * it + r) * 272 + (16 * ks + 8 * hh) * 2), X[jt]);
            if (jt == it) {
#pragma unroll
                for (int i = 0; i < 16; ++i) if ((i & 3) + 8 * (i >> 2) + 4 * hh > r) X[jt][i] = 0.f; }
        }
#pragma unroll
        for (int jt = 0; jt < 2; ++jt) if (jt <= it) {
#pragma unroll
            for (int s = 0; s < 2; ++s) { const LAS unsigned char* vb = L + R_VT;
                O = MFMA32(pack8(X[jt], s, 1.0f), ld2x8(vb + tr_off(32 * et + r, 32 * jt + 16 * s + 4 * hh), vb + tr_off(32 * et + r, 32 * jt + 16 * s + 8 + 4 * hh)), O); }
        }
#pragma unroll
        for (int dt = 0; dt < 4; ++dt)
#pragma unroll
            for (int s = 0; s < 2; ++s) { const LAS unsigned char* qb = L + R_QS + (32 * it + r) * 272 + (32 * dt + 16 * s + 4 * hh) * 2;
                O = MFMA32(ld2x8(qb, qb + 16), pack8(S[dt], s, gam), O); }
#pragma unroll
        for (int i = 0; i < 16; ++i) { const int t = t0 + 32 * it + (i & 3) + 8 * (i >> 2) + 4 * hh;
            if (t >= 16) F.out[(size_t)(b * 2048 + t - 16) * 2048 + 1024 + h * 128 + 32 * et + r] = O[i]; }
#pragma unroll
        for (int dt = 0; dt < 4; ++dt) {
#pragma unroll
            for (int i = 0; i < 16; ++i) S[dt][i] *= g64;
#pragma unroll
            for (int ks = 0; ks < 4; ++ks) S[dt] = MFMA32(ld16(L + R_KT + tr_off(32 * dt + r, 16 * ks + 8 * hh)), ld16(L + R_VT + tr_off(32 * et + r, 16 * ks + 8 * hh)), S[dt]); }
        __syncthreads();
    }
    if (seg == 7 && it == 0) { float* dst = F.out + O_RETP + (size_t)(b * 8 + h) * 16384;
#pragma unroll
        for (int dt = 0; dt < 4; ++dt)
#pragma unroll
            for (int i = 0; i < 16; ++i) dst[(size_t)(32 * dt + (i & 3) + 8 * (i >> 2) + 4 * hh) * 128 + 32 * et + r] = S[dt][i]; }
}

__device__ __forceinline__ void ret_sample(const Frame& F) {
    LAS float* QD = (LAS float*)F.lds;
    LAS float* QR = QD + 1024;
    LAS float* KR = QR + 1024;
    LAS float* KD = KR + 1024;
    LAS float* VV = KD + 1024;
    LAS float* SC = VV + 1024;
    LAS float* CP = SC + 64;
    const int tid = F.tid, lane = F.lane, wave = F.wave, e = tid & 127, dq = tid >> 7;
    for (int k = 0; k < 4; ++k) {
        const int u = F.blk + 256 * k, bs = u >> 3, h = u & 7;
        const float gam = 1.0f - __builtin_ldexpf(1.0f, -5 - h), lg2 = __builtin_log2f(gam);
        const float* S0 = F.state_ret + (size_t)u * 16384 + (size_t)(32 * dq) * 128 + e;
        float S[32];
#pragma unroll
        for (int d = 0; d < 32; ++d) S[d] = S0[(size_t)d * 128];
        {
            const int s = tid >> 6, i = tid & 63; const bf16* z = F.ZB + (size_t)(MPR + bs * 8 + s) * NB + h * 128 + i;
            const float q1 = bf2f(z[0]), q2 = bf2f(z[64]), k1 = bf2f(z[1024]) * 0.08838834764831845f, k2 = bf2f(z[1088]) * 0.08838834764831845f;
            const f32x2 cs = F.ROPE[(2064 + s) * 64 + i];
            const float qa = q1 * cs.x - q2 * cs.y, qb = q1 * cs.y + q2 * cs.x, ka = k1 * cs.x - k2 * cs.y, kb = k1 * cs.y + k2 * cs.x;
            const float gq = __builtin_amdgcn_exp2f((float)(s + 1) * lg2), gk = __builtin_amdgcn_exp2f((float)(7 - s) * lg2);
            QR[s * 128 + i] = qa; QR[s * 128 + 64 + i] = qb; QD[s * 128 + i] = qa * gq; QD[s * 128 + 64 + i] = qb * gq;
            KR[s * 128 + i] = ka; KR[s * 128 + 64 + i] = kb; KD[s * 128 + i] = ka * gk; KD[s * 128 + 64 + i] = kb * gk;
            VV[s * 128 + i] = bf2f(z[2048]); VV[s * 128 + 64 + i] = bf2f(z[2112]);
        }
        __syncthreads();
        for (int p = wave; p < 64; p += 8) { const int i = p >> 3, j = p & 7;
            if (j <= i) { float a = QR[i * 128 + lane] * KR[j * 128 + lane] + QR[i * 128 + 64 + lane] * KR[j * 128 + 64 + lane]; a = allreduce64(a);
                if (lane == 0) SC[p] = a * __builtin_amdgcn_exp2f((float)(i - j) * lg2); } }
        float cp[8], v[8];
#pragma unroll
        for (int i = 0; i < 8; ++i) { cp[i] = 0.f; v[i] = VV[i * 128 + e]; }
#pragma unroll
        for (int d4 = 0; d4 < 8; ++d4) {
#pragma unroll
            for (int i = 0; i < 8; ++i) { const f32x4 q = *(const LAS f32x4*)(QD + i * 128 + 32 * dq + 4 * d4);
                cp[i] += q.x * S[4 * d4] + q.y * S[4 * d4 + 1] + q.z * S[4 * d4 + 2] + q.w * S[4 * d4 + 3]; }
        }
#pragma unroll
        for (int i = 0; i < 8; ++i) CP[(dq * 8 + i) * 128 + e] = cp[i];
        const float g8 = __builtin_amdgcn_exp2f(8.0f * lg2);
        float* S1 = F.out + O_RETS + (size_t)u * 16384 + (size_t)(32 * dq) * 128 + e;
#pragma unroll
        for (int d4 = 0; d4 < 8; ++d4) {
            float n0 = S[4 * d4] * g8, n1 = S[4 * d4 + 1] * g8, n2 = S[4 * d4 + 2] * g8, n3 = S[4 * d4 + 3] * g8;
#pragma unroll
            for (int j = 0; j < 8; ++j) { const f32x4 kd = *(const LAS f32x4*)(KD + j * 128 + 32 * dq + 4 * d4); n0 += kd.x * v[j]; n1 += kd.y * v[j]; n2 += kd.z * v[j]; n3 += kd.w * v[j]; }
            S1[(size_t)(4 * d4) * 128] = n0; S1[(size_t)(4 * d4 + 1) * 128] = n1; S1[(size_t)(4 * d4 + 2) * 128] = n2; S1[(size_t)(4 * d4 + 3) * 128] = n3;
        }
        __syncthreads();
#pragma unroll
        for (int ii = 0; ii < 2; ++ii) { const int i = dq + 4 * ii;
            float o = CP[(0 * 8 + i) * 128 + e] + CP[(1 * 8 + i) * 128 + e] + CP[(2 * 8 + i) * 128 + e] + CP[(3 * 8 + i) * 128 + e];
#pragma unroll
            for (int j = 0; j < 8; ++j) if (j <= i) o += SC[i * 8 + j] * v[j];
            F.out[(size_t)(8192 + bs * 8 + i) * 2048 + 1024 + h * 128 + e] = o; }
        __syncthreads();
    }
}

__device__ __forceinline__ void p4_post(const Frame& F) {
    const int gw = F.blk * 8 + F.wave, NGW = F.G * 8, lane = F.lane;
    for (int yrow = gw; yrow < YROWS; yrow += NGW) {
        const int zrow = yrow < 8192 ? (yrow >> 11) * TP + (yrow & 2047) + 16 : MPR + (yrow - 8192);
        const float* orow = F.out + (size_t)yrow * 2048;
        {
            const int c0 = 16 * lane; f32x4 v[4]; float s = 0.f;
#pragma unroll
            for (int i = 0; i < 4; ++i) { v[i] = *(const f32x4*)(orow + c0 + 4 * i); s += (v[i].x + v[i].y) + (v[i].z + v[i].w); }
            const float mean = allreduce4(s) * (1.0f / 64.0f); float q = 0.f;
#pragma unroll
            for (int i = 0; i < 4; ++i) { v[i] = v[i] - mean; q += (v[i].x * v[i].x + v[i].y * v[i].y) + (v[i].z * v[i].z + v[i].w * v[i].w); }
            const float rstd = 1.0f / sqrtf(allreduce4(q) * (1.0f / 64.0f) + GN_EPS_A);
            const v4u* gp = (const v4u*)(F.GATE + (size_t)zrow * 1024 + c0); const v4u* bp = (const v4u*)(F.BONUS + (size_t)zrow * 1024 + c0);
            const v4u g0 = gp[0], g1 = gp[1], b0 = bp[0], b1 = bp[1];
            const unsigned gw_[8] = {g0.x, g0.y, g0.z, g0.w, g1.x, g1.y, g1.z, g1.w}, bw_[8] = {b0.x, b0.y, b0.z, b0.w, b1.x, b1.y, b1.z, b1.w};
            unsigned ow[8];
#pragma unroll
            for (int i = 0; i < 4; ++i) { const f32x4 gg = *(const f32x4*)(F.gn_a_g + c0 + 4 * i), gb = *(const f32x4*)(F.gn_a_b + c0 + 4 * i);
                const float y0 = (v[i].x * rstd * gg.x + gb.x) * bf2f(gw_[2 * i] & 0xffffu) + bf2f(bw_[2 * i] & 0xffffu);
                const float y1 = (v[i].y * rstd * gg.y + gb.y) * bf2f(gw_[2 * i] >> 16) + bf2f(bw_[2 * i] >> 16);
                const float y2 = (v[i].z * rstd * gg.z + gb.z) * bf2f(gw_[2 * i + 1] & 0xffffu) + bf2f(bw_[2 * i + 1] & 0xffffu);
                const float y3 = (v[i].w * rstd * gg.w + gb.w) * bf2f(gw_[2 * i + 1] >> 16) + bf2f(bw_[2 * i + 1] >> 16);
                ow[2 * i] = pk2(y0, y1); ow[2 * i + 1] = pk2(y2, y3); }
            v4u* mp = (v4u*)(F.MX + (size_t)zrow * 2048 + c0); v4u o0 = {ow[0], ow[1], ow[2], ow[3]}, o1 = {ow[4], ow[5], ow[6], ow[7]}; mp[0] = o0; mp[1] = o1;
        }
        {
            const int c0 = 16 * lane; f32x4 v[4]; float s = 0.f;
#pragma unroll
            for (int i = 0; i < 4; ++i) { v[i] = *(const f32x4*)(orow + 1024 + c0 + 4 * i); s += (v[i].x + v[i].y) + (v[i].z + v[i].w); }
            const float mean = allreduce8(s) * (1.0f / 128.0f); float q = 0.f;
#pragma unroll
            for (int i = 0; i < 4; ++i) { v[i] = v[i] - mean; q += (v[i].x * v[i].x + v[i].y * v[i].y) + (v[i].z * v[i].z + v[i].w * v[i].w); }
            const float rstd = 1.0f / sqrtf(allreduce8(q) * (1.0f / 128.0f) + GN_EPS_B);
            const v4u* gp = (const v4u*)(F.ZB + (size_t)zrow * NB + 3072 + c0); const v4u g0 = gp[0], g1 = gp[1];
            const unsigned gw_[8] = {g0.x, g0.y, g0.z, g0.w, g1.x, g1.y, g1.z, g1.w};
            unsigned ow[8];
#pragma unroll
            for (int i = 0; i < 4; ++i) { const f32x4 gg = *(const f32x4*)(F.gn_b_g + c0 + 4 * i), gb = *(const f32x4*)(F.gn_b_b + c0 + 4 * i);
                const float z0 = bf2f(gw_[2 * i] & 0xffffu), z1 = bf2f(gw_[2 * i] >> 16), z2 = bf2f(gw_[2 * i + 1] & 0xffffu), z3 = bf2f(gw_[2 * i + 1] >> 16);
                const float y0 = (v[i].x * rstd * gg.x + gb.x) * (z0 * sigmoidf_(z0)), y1 = (v[i].y * rstd * gg.y + gb.y) * (z1 * sigmoidf_(z1));
                const float y2 = (v[i].z * rstd * gg.z + gb.z) * (z2 * sigmoidf_(z2)), y3 = (v[i].w * rstd * gg.w + gb.w) * (z3 * sigmoidf_(z3));
                ow[2 * i] = pk2(y0, y1); ow[2 * i + 1] = pk2(y2, y3); }
            v4u* mp = (v4u*)(F.MX + (size_t)zrow * 2048 + 1024 + c0); v4u o0 = {ow[0], ow[1], ow[2], ow[3]}, o1 = {ow[4], ow[5], ow[6], ow[7]}; mp[0] = o0; mp[1] = o1;
        }
    }
}
__device__ __forceinline__ void p6_ln(const Frame& F) {
    const int gw = F.blk * 8 + F.wave, NGW = F.G * 8, lane = F.lane;
    for (int yrow = gw; yrow < YROWS; yrow += NGW) {
        f32x4* p = (f32x4*)(F.out + (size_t)yrow * 2048) + lane; f32x4 v[8]; float s = 0.f;
#pragma unroll
        for (int j = 0; j < 8; ++j) { v[j] = p[64 * j]; s += (v[j].x + v[j].y) + (v[j].z + v[j].w); }
        const float mean = allreduce64(s) * (1.0f / 2048.0f); float q = 0.f;
#pragma unroll
        for (int j = 0; j < 8; ++j) { v[j] = v[j] - mean; q += (v[j].x * v[j].x + v[j].y * v[j].y) + (v[j].z * v[j].z + v[j].w * v[j].w); }
        const float rstd = 1.0f / sqrtf(allreduce64(q) * (1.0f / 2048.0f) + LN_EPS);
#pragma unroll
        for (int j = 0; j < 8; ++j) { const f32x4 g = ((const f32x4*)F.ln_g)[lane + 64 * j], b = ((const f32x4*)F.ln_b)[lane + 64 * j]; p[64 * j] = v[j] * rstd * g + b; }
    }
}

constexpr int N_PHASES = 7;
__global__ void __launch_bounds__(512, 2) hymba_fwd(Args args) {
    extern __shared__ __attribute__((aligned(16))) unsigned char lds[];
    Frame F;
    F.lds = (LAS unsigned char*)lds;
    F.tid = threadIdx.x; F.lane = F.tid & 63; F.wave = __builtin_amdgcn_readfirstlane(F.tid >> 6); F.G = gridDim.x; F.blk = blockIdx.x;
    F.x_prompt = args.in[0]; F.x_sample = args.in[1]; F.state_rwkv = args.in[2]; F.state_shift = args.in[3]; F.state_ret = args.in[4]; F.meta = args.in[5]; F.w_in = args.in[6]; F.w_out = args.in[7];
    F.shift_mix = args.in[8]; F.w0 = args.in[9]; F.w_up = args.in[10]; F.a0 = args.in[11]; F.a_up = args.in[12]; F.k_k = args.in[13]; F.k_a = args.in[14]; F.r_k = args.in[15];
    F.gn_a_g = args.in[16]; F.gn_a_b = args.in[17]; F.gn_b_g = args.in[18]; F.gn_b_b = args.in[19]; F.ln_g = args.in[20]; F.ln_b = args.in[21];
    F.out = args.out; unsigned char* ws = args.ws;
    F.XB = (bf16*)((unsigned char*)args.out + OB_XB); F.WINT = (bf16*)((unsigned char*)args.out + OB_WIN);
    F.ZB = (bf16*)(ws + WS_ZB); F.ZA = (bf16*)(ws + WS_ZA); F.MX = (bf16*)(ws + WS_ZA); F.WOUT = (bf16*)(ws + WS_WOUT); F.ROPE = (f32x2*)(ws + WS_ROPE);
    F.DW = (bf16*)(ws + WS_W); F.UB = (float*)(ws + WS_U); F.AA = (bf16*)(ws + WS_A); F.GATE = (bf16*)(ws + WS_GATE); F.BONUS = (bf16*)(ws + WS_BONUS);
    volatile LAS unsigned* MISC = (volatile LAS unsigned*)(F.lds + MISC_OFF);
    if (F.tid < 32) MISC[F.tid] = 0u;
    __syncthreads();
    unsigned* ctl = (unsigned*)(ws + WS_CTL);
    XcdBarrier bar = xcd_barrier_post(ctl + CW_BAR, MISC + 8);
    const int lo = args.ph_lo, hi = args.ph_hi;
#define IN(k) (lo <= (k) && (k) < hi)
#define SEAM(k) do { if (IN(k) && IN((k) + 1)) xcd_barrier(bar); } while (0)
    if (IN(0)) for (int rep = 0; rep < REP_P0; ++rep) p0_prologue(F);
    SEAM(0);
    if (IN(1)) for (int rep = 0; rep < REP_P1; ++rep) { pg8::Gemm g{F.XB, F.WINT, MPAD, NPAD, D_MODEL}; pg8::StaticOrder S; S.init(MPAD, NPAD, F.G, F.blk); pg8::EpiZ E{F.ZB, F.ZA};
        pg8::gemm_phase<pg8::EpiZ, pg8::StaticOrder, true, true>(F.lds, g, S, E); }
    SEAM(1);
    if (IN(2)) { for (int rep = 0; rep < REP_P2; ++rep) p2_pre(F); ret_pass1(F, F.UB); }
    SEAM(2);
    if (IN(3)) { for (int rep = 0; rep < REP_P3A; ++rep) p3_rwkv(F); for (int rep = 0; rep < REP_P3B; ++rep) { ret_pass2(F, F.UB); ret_sample(F); } }
    SEAM(3);
    if (IN(4)) for (int rep = 0; rep < REP_P4; ++rep) p4_post(F);
    SEAM(4);
    if (IN(5)) for (int rep = 0; rep < REP_P5; ++rep) { pg8::Gemm g{F.MX, F.WOUT, MPAD, D_MODEL, D_MODEL}; pg8::StaticOrder S; S.init(MPAD, D_MODEL, F.G, F.blk); pg8::EpiY E{F.x_prompt, F.x_sample, F.out, ALPHA};
        pg8::gemm_phase<pg8::EpiY, pg8::StaticOrder, true, true>(F.lds, g, S, E); }
    SEAM(5);
    if (IN(6)) p6_ln(F);
#undef IN
#undef SEAM
}

extern "C" void kernel_launch(void* const* d_in, const int* in_sizes, int n_in, void* d_out, int out_size, void* d_ws, size_t ws_size, hipStream_t stream) {
    static int grid = 0;
    if (grid == 0) {
        if (n_in != 22 || (size_t)out_size != O_END || ws_size < WS_END) { fprintf(stderr, "kernel_launch: unexpected shapes (n_in %d, out %d, ws %zu, need %zu); nothing launched\n", n_in, out_size, ws_size, (size_t)WS_END); grid = -1; return; }
        int dev = 0, cus = 0, per_cu = 0;
        if (hipGetDevice(&dev) != hipSuccess || hipDeviceGetAttribute(&cus, hipDeviceAttributeMultiprocessorCount, dev) != hipSuccess) { grid = -1; return; }
        if (hipFuncSetAttribute((const void*)hymba_fwd, hipFuncAttributeMaxDynamicSharedMemorySize, LDS_BYTES) != hipSuccess) { fprintf(stderr, "kernel_launch: hipFuncSetAttribute failed\n"); grid = -1; return; }
        if (hipOccupancyMaxActiveBlocksPerMultiprocessor(&per_cu, (const void*)hymba_fwd, 512, LDS_BYTES) != hipSuccess || per_cu < 1) fprintf(stderr, "kernel_launch: occupancy query reports %d\n", per_cu);
        (void)hipGetLastError();
        grid = cus;
        if (grid != 256) fprintf(stderr, "kernel_launch: %d CUs; this kernel is laid out for 256\n", grid);
    }
    if (grid != 256) return;
    (void)hipMemsetAsync((char*)d_ws + WS_CTL, 0, CTL_ZERO_BYTES, stream);
    Args a{};
    for (int i = 0; i < 22; ++i) a.in[i] = (const float*)d_in[i];
    a.out = (float*)d_out; a.ws = (unsigned char*)d_ws;
#if MK_LAUNCHES == 1
    a.ph_lo = 0; a.ph_hi = N_PHASES;
    hipLaunchKernelGGL(hymba_fwd, dim3(grid), dim3(512), LDS_BYTES, stream, a);
#else
    for (int p = 0; p < N_PHASES; ++p) { a.ph_lo = p; a.ph_hi = p + 1; hipLaunchKernelGGL(hymba_fwd, dim3(grid), dim3(512), LDS_BYTES, stream, a); }
#endif
}
```

```cpp
#include <hip/hip_runtime.h>
#include <cstdio>
#include <cstdint>
#ifndef MK_LAUNCHES
#define MK_LAUNCHES 1
#endif
#define REP_P0 1
#define REP_P1 1
#define REP_P2 1
#define REP_P3A 1
#define REP_P3B 1
#define REP_P4 1
#define REP_P5 1
#define REP_LOADER 1
#define REP_SCANNER 1
#define PROBE_SEL 0
#define PROBE_WAVE 0
#if PROBE_SEL
#define PROBE_VMWAIT() asm volatile("s_waitcnt vmcnt(0)" ::: "memory")
#define PROBE_DECL() unsigned long long pt_[6] = {0, 0, 0, 0, 0, 0}, pacc_[6] = {0, 0, 0, 0, 0, 0}; const unsigned long long pt0_ = __builtin_readcyclecounter(); pt_[5] = pt0_
#define PROBE_T(k) do { const unsigned long long n_ = __builtin_readcyclecounter(); pacc_[k] += n_ - pt_[5]; pt_[5] = n_; } while (0)
#define PROBE_END(w) do { if (F.blk == 37 && wave == (w) && (w) == PROBE_WAVE && lane == 0) { const unsigned long long tot_ = __builtin_readcyclecounter() - pt0_; \
    const float fr_ = PROBE_SEL == 9 ? (float)tot_ * 1e-6f : (float)pacc_[PROBE_SEL] / (float)tot_; __hip_atomic_store((float*)(F.ctl + 32), fr_, __ATOMIC_RELAXED, __HIP_MEMORY_SCOPE_AGENT); } } while (0)
#else
#define PROBE_VMWAIT() do {} while (0)
#define PROBE_DECL() do {} while (0)
#define PROBE_T(k) do {} while (0)
#define PROBE_END(w) do {} while (0)
#endif
__device__ const double ROPE_INV[64] = { 1, 0.86596432336006535, 0.74989420933245587, 0.64938163157621132, 0.56234132519034907, 0.48696752516586311, 0.42169650342858223, 0.36517412725483772, 0.31622776601683794, 0.27384196342643613, 0.23713737056616552, 0.20535250264571461, 0.17782794100389229, 0.15399265260594919, 0.1333521432163324, 0.11547819846894582, 0.10000000000000001, 0.086596432336006529, 0.074989420933245579, 0.064938163157621132, 0.056234132519034911, 0.048696752516586311, 0.042169650342858224, 0.036517412725483769, 0.031622776601683791, 0.027384196342643614, 0.023713737056616554, 0.02053525026457146, 0.017782794100389229, 0.015399265260594919, 0.013335214321633241, 0.011547819846894581, 0.01, 0.0086596432336006543, 0.0074989420933245579, 0.006493816315762113, 0.005623413251903491, 0.004869675251658631, 0.0042169650342858229, 0.0036517412725483771, 0.0031622776601683794, 0.0027384196342643613, 0.0023713737056616554, 0.002053525026457146, 0.0017782794100389228, 0.001539926526059492, 0.0013335214321633241, 0.0011547819846894581, 0.001, 0.00086596432336006539, 0.00074989420933245586, 0.00064938163157621134, 0.0005623413251903491, 0.0004869675251658631, 0.00042169650342858224, 0.0003651741272548377, 0.00031622776601683794, 0.00027384196342643611, 0.00023713737056616554, 0.00020535250264571461, 0.00017782794100389227, 0.00015399265260594919, 0.0001333521432163324, 0.00011547819846894582 };
namespace pg8 {
#define PG8_LAS __attribute__((address_space(3)))
typedef unsigned short bf16_t;
typedef short bf16x8 __attribute__((ext_vector_type(8)));
typedef float f32x4 __attribute__((ext_vector_type(4)));
typedef unsigned u32x4 __attribute__((ext_vector_type(4)));
constexpr int BM = 256, BK = 64, HALF = 128, HTB = HALF * BK * 2  , STAGE_BYTES = 8 * HTB, NXCD = 8, WGM = 8;

__host__ __device__ __forceinline__ int lds_byte(int r, int c) { const int st = (r >> 4) * 2 + (c >> 5), rr = r & 15, cc = c & 31, ob = rr * 64 + cc * 2; return st * 1024 + (ob ^ (((ob >> 9) & 1) << 5)); }
__host__ __device__ __forceinline__ void stage_rc(int b, int& R, int& C) { const int st = b / 1024, sb = b % 1024, swz = sb ^ (((sb >> 9) & 1) << 5); R = (st >> 1) * 16 + swz / 64; C = (st & 1) * 32 + (swz % 64) / 2; }
__host__ __device__ __forceinline__ int perm32(int rho) { const int n = rho >> 4, i = rho & 15; return 8 * (i >> 2) + 4 * n + (i & 3); }

struct Unit { int pm, pn; };
struct Gemm { const bf16_t* A; const bf16_t* Bt; int M, N, K; };

struct StaticOrder {
    int nM, nN, nwg, G, c;
    __host__ __device__ void init(int M, int N, int G_, int c_) { nM = M / BM; nN = N / BM; nwg = nM * nN; G = G_; c = c_; }
    __host__ __device__ bool next(int i, Unit& u) const {
        const long L = (long)i * G + c; if (L >= nwg) return false;
        int wgid = (int)L; { const int q = nwg / NXCD, r = nwg % NXCD, xcd = wgid % NXCD, off = wgid / NXCD; wgid = (xcd < r ? xcd * (q + 1) : r * (q + 1) + (xcd - r) * q) + off; }
        const int nig = WGM * nN, gid = wgid / nig, fm = gid * WGM, gsz = (nM - fm) < WGM ? (nM - fm) : WGM;
        u.pm = fm + ((wgid % nig) % gsz); u.pn = (wgid % nig) / gsz; return true;
    }
    __device__ __forceinline__ void a_ready(const Unit&) const {}
    __device__ __forceinline__ void done(const Unit&) const {}
};

__device__ __forceinline__ unsigned cvt_pk_bf16(float lo, float hi) { unsigned r; asm volatile("v_cvt_pk_bf16_f32 %0, %1, %2" : "=v"(r) : "v"(lo), "v"(hi)); return r; }
typedef float f32x2 __attribute__((ext_vector_type(2)));

struct EpiZ {
    static constexpr bool PERM = true, AFTER_DRAIN = false;
    bf16_t* ZB; bf16_t* ZA;
    __device__ __forceinline__ void operator()(const f32x4 (&acc)[2][2][4][2], const Unit& u, int wr, int wc, int fr, int fq) const {
        const int row0 = u.pm * BM + wr * 64 + fr;
        bf16_t* base; int ldc, colt;
        if (u.pn < 16) { base = ZB; ldc = 4096; colt = u.pn * BM; } else { base = ZA; ldc = 4352; colt = (u.pn - 16) * BM; }
        const int col0 = colt + wc * 32 + 8 * fq;
#pragma unroll
        for (int ai = 0; ai < 2; ++ai)
#pragma unroll
            for (int m = 0; m < 4; ++m) { bf16_t* rowp = base + (size_t)(row0 + ai * HALF + m * 16) * ldc + col0;
#pragma unroll
                for (int bj = 0; bj < 2; ++bj) { const f32x4 v0 = acc[ai][bj][m][0], v1 = acc[ai][bj][m][1];
                    u32x4 w; w.x = cvt_pk_bf16(v0[0], v0[1]); w.y = cvt_pk_bf16(v0[2], v0[3]); w.z = cvt_pk_bf16(v1[0], v1[1]); w.w = cvt_pk_bf16(v1[2], v1[3]);
                    *(u32x4*)(rowp + bj * HALF) = w; } }
    }
};
struct EpiY {
    static constexpr bool PERM = false, AFTER_DRAIN = false;
    const float* xp; const float* xs; float* out; float alpha;
    __device__ __forceinline__ void operator()(const f32x4 (&acc)[2][2][4][2], const Unit& u, int wr, int wc, int fr, int fq) const {
#pragma unroll
        for (int ai = 0; ai < 2; ++ai)
#pragma unroll
            for (int m = 0; m < 4; ++m) {
                const int zrow = u.pm * BM + ai * HALF + wr * 64 + m * 16 + fr; int yrow = -1;
                if (zrow < 8256) { const int b = zrow / 2064, t = zrow - b * 2064; if (t >= 16) yrow = b * 2048 + t - 16; }
                else if (zrow < 9280) yrow = zrow - 64;
                if (yrow >= 0) {
                    const float* xsrc = yrow < 8192 ? xp + (size_t)yrow * 2048 : xs + (size_t)(yrow - 8192) * 2048; float* o = out + (size_t)yrow * 2048;
#pragma unroll
                    for (int bj = 0; bj < 2; ++bj)
#pragma unroll
                        for (int n = 0; n < 2; ++n) { const int col = u.pn * BM + bj * HALF + wc * 32 + n * 16 + 4 * fq;
                            const f32x4 xv = *(const f32x4*)(xsrc + col); *(f32x4*)(o + col) = xv * alpha + acc[ai][bj][m][n]; }
                }
            }
    }
};
template <class Epi, class Sched, bool ALIGN_EPI = false, bool SP2 = false>
__device__ __forceinline__ void gemm_phase(PG8_LAS unsigned char* lds, const Gemm g, const Sched& S, const Epi& E) {
    const int tid = threadIdx.x, wid = __builtin_amdgcn_readfirstlane(tid >> 6), lane = tid & 63, wr = wid >> 2, wc = wid & 3, fr = lane & 15, fq = lane >> 4;
    const int K = g.K, nt = K / BK;
    unsigned voffA[2], voffB[2];
#pragma unroll
    for (int i = 0; i < 2; ++i) { int R, C; stage_rc(tid * 16 + i * 8192, R, C); const int Rb = Epi::PERM ? ((R & ~31) + perm32(R & 31)) : R;
        voffA[i] = (unsigned)(R * K + C) * 2u; voffB[i] = (unsigned)(Rb * K + C) * 2u; }
    const size_t kstep = (size_t)(BK * 2);
    const size_t hstep = (size_t)HALF * K * 2;
    const size_t tstep = 2 * hstep;
    const unsigned ldsw = (unsigned)wid * 1024u;
    const int aoff = lds_byte(wr * 64 + fr, fq * 8), boff = lds_byte(wc * 32 + fr, fq * 8);
#define PG8_SA(b, h) (((b) * 2 + (h)) * HTB)
#define PG8_SB(b, h) ((4 + (b) * 2 + (h)) * HTB)
#define PG8_STAGE(bufoff, gbase, voff) do { _Pragma("unroll") for (int _i = 0; _i < 2; ++_i) \
        __builtin_amdgcn_global_load_lds((const unsigned*)((const char*)(gbase) + (voff)[_i]), (PG8_LAS unsigned*)(lds + (bufoff) + ldsw + _i * 8192), 16, 0, 0); } while (0)
#define PG8_LDA(dst, b, h) do { _Pragma("unroll") for (int m = 0; m < 4; ++m) _Pragma("unroll") for (int k = 0; k < 2; ++k) dst[m][k] = *(const PG8_LAS bf16x8*)(lds + PG8_SA(b, h) + aoff + m * 2048 + k * 1024); } while (0)
#define PG8_LDB(dst, b, h) do { _Pragma("unroll") for (int n = 0; n < 2; ++n) _Pragma("unroll") for (int k = 0; k < 2; ++k) dst[n][k] = *(const PG8_LAS bf16x8*)(lds + PG8_SB(b, h) + boff + n * 2048 + k * 1024); } while (0)
#define PG8_MMA(ai, bj, At, Bt) do { __builtin_amdgcn_s_setprio(1); _Pragma("unroll") for (int m = 0; m < 4; ++m) _Pragma("unroll") for (int n = 0; n < 2; ++n) _Pragma("unroll") for (int k = 0; k < 2; ++k) \
        acc[ai][bj][m][n] = __builtin_amdgcn_mfma_f32_16x16x32_bf16(Bt[n][k], At[m][k], acc[ai][bj][m][n], 0, 0, 0); __builtin_amdgcn_s_setprio(0); } while (0)
#define PG8_WAIT_V(n) asm volatile("s_waitcnt vmcnt(" #n ")" ::: "memory")
#define PG8_WAIT_L(n) asm volatile("s_waitcnt lgkmcnt(" #n ")" ::: "memory")
#define PG8_BAR __builtin_amdgcn_s_barrier()
#define PG8_SCHED __builtin_amdgcn_sched_barrier(0)
    Unit cur, nxt; int ui = 0;
    if (!S.next(0, cur)) return;
    f32x4 acc[2][2][4][2];
#pragma unroll
    for (int a = 0; a < 2; ++a)
#pragma unroll
        for (int b = 0; b < 2; ++b)
#pragma unroll
            for (int m = 0; m < 4; ++m)
#pragma unroll
                for (int n = 0; n < 2; ++n) acc[a][b][m][n] = (f32x4){0.f, 0.f, 0.f, 0.f};
    bf16x8 At[4][2], B0[2][2], B1[2][2];
    const char* cA = (const char*)g.A + (size_t)cur.pm * tstep; const char* cB = (const char*)g.Bt + (size_t)cur.pn * tstep;
    S.a_ready(cur);
    if constexpr (SP2) {
        PG8_STAGE(PG8_SB(0, 0), cB, voffB); PG8_STAGE(PG8_SB(0, 1), cB + hstep, voffB); PG8_STAGE(PG8_SA(0, 0), cA, voffA); PG8_STAGE(PG8_SA(0, 1), cA + hstep, voffA);
        if (wr == 1) PG8_BAR;
        PG8_WAIT_V(2); PG8_BAR;
        PG8_STAGE(PG8_SB(1, 0), cB + kstep, voffB); PG8_STAGE(PG8_SA(1, 0), cA + kstep, voffA); PG8_STAGE(PG8_SB(1, 1), cB + hstep + kstep, voffB);
        PG8_WAIT_V(6); PG8_BAR;
    } else {
        PG8_STAGE(PG8_SB(0, 0), cB, voffB); PG8_STAGE(PG8_SA(0, 0), cA, voffA); PG8_STAGE(PG8_SB(0, 1), cB + hstep, voffB); PG8_STAGE(PG8_SA(0, 1), cA + hstep, voffA);
        if (wr == 1) PG8_BAR;
        PG8_WAIT_V(4); PG8_BAR;
        PG8_STAGE(PG8_SB(1, 0), cB + kstep, voffB); PG8_STAGE(PG8_SA(1, 0), cA + kstep, voffA); PG8_STAGE(PG8_SB(1, 1), cB + hstep + kstep, voffB);
        PG8_WAIT_V(6); PG8_BAR;
    }
    for (;;) {
        const bool has_next = S.next(ui + 1, nxt);
        const char* nA = has_next ? (const char*)g.A + (size_t)nxt.pm * tstep : cA; const char* nB = has_next ? (const char*)g.Bt + (size_t)nxt.pn * tstep : cB;
        for (int t = 0; t < nt; t += 2) {
            const bool last = (t == nt - 2);
            const char* a1 = cA + (size_t)(t + 1) * kstep;
            const char* a2 = last ? nA : cA + (size_t)(t + 2) * kstep; const char* b2 = last ? nB : cB + (size_t)(t + 2) * kstep;
            const char* a3 = a2 + kstep; const char* b3 = b2 + kstep;
            if (last && has_next) S.a_ready(nxt);
            if constexpr (SP2) {
            PG8_LDB(B0, 0, 0); PG8_LDB(B1, 0, 1); PG8_SCHED; PG8_LDA(At, 0, 0); PG8_STAGE(PG8_SA(1, 1), a1 + hstep, voffA);
            PG8_WAIT_V(8); PG8_WAIT_L(0); PG8_BAR; PG8_MMA(0, 0, At, B0); PG8_MMA(0, 1, At, B1); PG8_BAR; PG8_SCHED;
            PG8_LDA(At, 0, 1); PG8_STAGE(PG8_SB(0, 0), b2, voffB); PG8_STAGE(PG8_SB(0, 1), b2 + hstep, voffB); PG8_STAGE(PG8_SA(0, 0), a2, voffA);
            PG8_WAIT_V(8); PG8_WAIT_L(0); PG8_BAR; PG8_MMA(1, 0, At, B0); PG8_MMA(1, 1, At, B1); PG8_BAR; PG8_SCHED;
            PG8_LDB(B0, 1, 0); PG8_LDB(B1, 1, 1); PG8_SCHED; PG8_LDA(At, 1, 0); PG8_STAGE(PG8_SA(0, 1), a2 + hstep, voffA);
            PG8_WAIT_V(8); PG8_WAIT_L(0); PG8_BAR; PG8_MMA(0, 0, At, B0); PG8_MMA(0, 1, At, B1); PG8_BAR; PG8_SCHED;
            PG8_LDA(At, 1, 1); PG8_STAGE(PG8_SB(1, 0), b3, voffB); PG8_STAGE(PG8_SB(1, 1), b3 + hstep, voffB); PG8_STAGE(PG8_SA(1, 0), a3, voffA);
            PG8_WAIT_V(8); PG8_WAIT_L(0); PG8_BAR; PG8_MMA(1, 0, At, B0); PG8_MMA(1, 1, At, B1); PG8_BAR; PG8_SCHED;
            } else {
            PG8_LDB(B0, 0, 0); PG8_SCHED; PG8_LDA(At, 0, 0); PG8_STAGE(PG8_SA(1, 1), a1 + hstep, voffA);
            PG8_WAIT_L(8); PG8_BAR; PG8_WAIT_L(0); PG8_MMA(0, 0, At, B0); PG8_BAR; PG8_SCHED;
            PG8_LDB(B1, 0, 1); PG8_STAGE(PG8_SB(0, 0), b2, voffB);
            PG8_BAR; PG8_WAIT_L(0); PG8_MMA(0, 1, At, B1); PG8_BAR;
            PG8_LDA(At, 0, 1); PG8_STAGE(PG8_SA(0, 0), a2, voffA);
            PG8_BAR; PG8_WAIT_L(0); PG8_MMA(1, 0, At, B0); PG8_BAR; PG8_SCHED;
            PG8_STAGE(PG8_SB(0, 1), b2 + hstep, voffB);
            PG8_WAIT_V(6); PG8_BAR; PG8_MMA(1, 1, At, B1); PG8_BAR;
            PG8_LDB(B0, 1, 0); PG8_SCHED; PG8_LDA(At, 1, 0); PG8_STAGE(PG8_SA(0, 1), a2 + hstep, voffA);
            PG8_WAIT_L(8); PG8_BAR; PG8_WAIT_L(0); PG8_MMA(0, 0, At, B0); PG8_BAR; PG8_SCHED;
            PG8_LDB(B1, 1, 1); PG8_STAGE(PG8_SB(1, 0), b3, voffB);
            PG8_BAR; PG8_WAIT_L(0); PG8_MMA(0, 1, At, B1); PG8_BAR;
            PG8_LDA(At, 1, 1); PG8_STAGE(PG8_SA(1, 0), a3, voffA);
            PG8_BAR; PG8_WAIT_L(0); PG8_MMA(1, 0, At, B0); PG8_BAR; PG8_SCHED;
            PG8_STAGE(PG8_SB(1, 1), b3 + hstep, voffB);
            PG8_WAIT_V(6); PG8_BAR; PG8_MMA(1, 1, At, B1); PG8_BAR;
            }
        }
        if constexpr (ALIGN_EPI) { if (wr == 0) PG8_BAR; }
        if constexpr (!Epi::AFTER_DRAIN) { E(acc, cur, wr, wc, fr, fq); S.done(cur); }
        if (!has_next) break;
#pragma unroll
        for (int a = 0; a < 2; ++a)
#pragma unroll
            for (int b = 0; b < 2; ++b)
#pragma unroll
                for (int m = 0; m < 4; ++m)
#pragma unroll
                    for (int n = 0; n < 2; ++n) acc[a][b][m][n] = (f32x4){0.f, 0.f, 0.f, 0.f};
        cur = nxt; cA = nA; cB = nB; ++ui;
        if constexpr (ALIGN_EPI) { if (wr == 1) PG8_BAR; }
    }
    PG8_WAIT_V(0);
    if constexpr (!ALIGN_EPI) { if (wr == 0) PG8_BAR; }
    PG8_BAR;
    if constexpr (Epi::AFTER_DRAIN) { E.fused(acc, cur, wr, wc, fr, fq, lds, wid, lane); S.done(cur); }
#undef PG8_SA
#undef PG8_SB
#undef PG8_STAGE
#undef PG8_LDA
#undef PG8_LDB
#undef PG8_MMA
#undef PG8_WAIT_V
#undef PG8_WAIT_L
#undef PG8_BAR
#undef PG8_SCHED
}
}

#define LAS __attribute__((address_space(3)))
#define XB_TMO      128
#define XB_XCNT(j)  (256  + 64 * (j))
#define XB_XSUB(j)  (1280 + 64 * (j))
#define XB_XGEN(j)  (2304 + 64 * (j))
#define XB_TOP      3328
#define XB_TOPGEN   3392
#define XCD_BAR_WORDS 3456
#define XB_SPIN_CAP (1u << 18)

__device__ __forceinline__ unsigned xb_ld(unsigned* p)              { return __hip_atomic_load(p, __ATOMIC_RELAXED, __HIP_MEMORY_SCOPE_AGENT); }
__device__ __forceinline__ unsigned xb_add(unsigned* p, unsigned v) { return __hip_atomic_fetch_add(p, v, __ATOMIC_RELAXED, __HIP_MEMORY_SCOPE_AGENT); }
__device__ __forceinline__ unsigned xb_xcc_id() { return (unsigned)__builtin_amdgcn_s_getreg((3 << 11) | 20) & 0xFu; }
#define XB_SPIN(cond, bar) do { unsigned _sp = 0; while (cond) { __builtin_amdgcn_s_sleep(1); \
    if ((++_sp & 255u) == 0u) { if (xb_ld(&(bar)[XB_TMO])) break; if (_sp > XB_SPIN_CAP) { atomicAdd(&(bar)[XB_TMO], 1u); break; } } } } while (0)

struct XcdBarrier {
    unsigned* bar; unsigned x;
    volatile LAS unsigned* st;
};

__device__ __forceinline__ XcdBarrier xcd_barrier_post(unsigned* bar, volatile LAS unsigned* st) {
    XcdBarrier b; b.bar = bar; b.x = xb_xcc_id(); b.st = st;
    if (threadIdx.x == 0) (void)xb_add(&bar[XB_XCNT(b.x)], 1u);
    return b;
}
__device__ __forceinline__ void xcd_barrier_complete(unsigned* bar, unsigned x, unsigned& nloc, unsigned& nx) {
    const unsigned G = gridDim.x * gridDim.y * gridDim.z;
    unsigned sum, cnt, mine, sp = 0u;
    for (;;) {
        sum = 0u; cnt = 0u; mine = 0u;
#pragma unroll
        for (unsigned j = 0; j < 16; ++j) { const unsigned c = xb_ld(&bar[XB_XCNT(j)]); sum += c; cnt += (c > 0u) ? 1u : 0u; mine = (j == x) ? c : mine; }
        if (sum == G) break;
        __builtin_amdgcn_s_sleep(1);
        if ((++sp & 255u) == 0u) { if (xb_ld(&bar[XB_TMO])) break; if (sp > XB_SPIN_CAP) { atomicAdd(&bar[XB_TMO], 1u); break; } }
    }
    nloc = mine > 0u ? mine : 1u; nx = cnt > 0u ? cnt : 1u;
}

__device__ __forceinline__ void xcd_barrier(const XcdBarrier& b) {
    asm volatile("s_waitcnt vmcnt(0)" ::: "memory");
    __syncthreads();
    if (threadIdx.x == 0) {
        unsigned* bar = b.bar;
        __builtin_amdgcn_s_waitcnt(0);
        unsigned nloc = b.st[0], nx = b.st[1];
        if (nloc == 0u) { xcd_barrier_complete(bar, b.x, nloc, nx); b.st[0] = nloc; b.st[1] = nx; }
        const unsigned old = xb_add(&bar[XB_XSUB(b.x)], 1u);
        const unsigned gen = old / nloc;
        if (old + 1u == (gen + 1u) * nloc) {
            __builtin_amdgcn_fence(__ATOMIC_RELEASE, "agent");
            asm volatile("s_waitcnt vmcnt(0)" ::: "memory");
            const unsigned og = xb_add(&bar[XB_TOP], 1u);
            const unsigned tg = og / nx;
            if (og + 1u == (tg + 1u) * nx) xb_add(&bar[XB_TOPGEN], 1u);
            else XB_SPIN(xb_ld(&bar[XB_TOPGEN]) == tg, bar);
            __builtin_amdgcn_fence(__ATOMIC_ACQUIRE, "agent");
            xb_add(&bar[XB_XGEN(b.x)], 1u);
            asm volatile("s_waitcnt vmcnt(0)" ::: "memory");
        } else {
            XB_SPIN(xb_ld(&bar[XB_XGEN(b.x)]) == gen, bar);
            __builtin_amdgcn_fence(__ATOMIC_ACQUIRE, "agent");
            asm volatile("s_waitcnt vmcnt(0)" ::: "memory");
        }
    }
    __syncthreads();
}

constexpr int D_MODEL = 2048, TP = 2064  , MPR = 4 * TP  , MSA = 1024, MROWS = MPR + MSA  , MPAD = 9472;
constexpr int NA = 4224, NAP = 4352, NB = 4096, NPAD = NAP + NB  , YROWS = 9216;
constexpr float ALPHA = 1.189207115002721f;
constexpr float LN_EPS = 1e-5f, GN_EPS_A = 64e-5f, GN_EPS_B = 1e-5f;
constexpr size_t O_YP = 0, O_YS = 16777216, O_RWKVP = 18874368, O_SHIFTP = 19136512, O_RETP = 19153408, O_RWKVS = 19677696, O_SHIFTS = 28066304, O_RETS = 28606976, O_END = 45384192;
constexpr size_t WS_CTL = 0, CTL_ZERO_BYTES = 1u << 20;
constexpr size_t WS_ZB = 1u << 20;
constexpr size_t WS_ZA = WS_ZB + (size_t)MPAD * NB * 2;
constexpr size_t WS_WOUT = WS_ZA + (size_t)MPAD * NAP * 2;
constexpr size_t WS_ROPE = WS_WOUT + (size_t)2048 * 2048 * 2;
constexpr size_t WS_W = WS_ROPE + (size_t)2072 * 64 * 8;
constexpr size_t WS_A = WS_W + (size_t)MROWS * 1024 * 2;
constexpr size_t WS_GATE = WS_A + (size_t)MROWS * 1024 * 2;
constexpr size_t WS_BONUS = WS_GATE + (size_t)MROWS * 1024 * 2;
constexpr size_t WS_U = WS_BONUS + (size_t)MROWS * 1024 * 2;
constexpr size_t WS_END = WS_U + (size_t)256 * 16384 * 4;
constexpr size_t OB_XB = 0;
constexpr size_t OB_WIN = O_RETS * 4;

constexpr int LDS_BYTES = 147456, MISC_OFF = 131072 + 320;
constexpr int CW_BAR = 4096;


typedef unsigned short bf16;
typedef unsigned v4u __attribute__((ext_vector_type(4)));
typedef unsigned v2u __attribute__((ext_vector_type(2)));
typedef float f32x4 __attribute__((ext_vector_type(4)));
typedef float f32x2 __attribute__((ext_vector_type(2)));
#define LDS_WAIT() asm volatile("s_waitcnt lgkmcnt(0)" ::: "memory")
__device__ __forceinline__ float bf2f(unsigned b) { return __uint_as_float(b << 16); }
__device__ __forceinline__ unsigned f2bf(float f) { unsigned u = __float_as_uint(f); return (u + 0x7fffu + ((u >> 16) & 1u)) >> 16; }
__device__ __forceinline__ unsigned pk2(float lo, float hi) { return f2bf(lo) | (f2bf(hi) << 16); }
__device__ __forceinline__ float sigmoidf_(float x) { return 1.0f / (1.0f + __expf(-x)); }
__device__ __forceinline__ float tanh_(float x) { return 1.0f - 2.0f / (1.0f + __expf(2.0f * x)); }

template <int CTRL> __device__ __forceinline__ float dpp_f(float x) { return __builtin_bit_cast(float, __builtin_amdgcn_update_dpp(0, __builtin_bit_cast(int, x), CTRL, 0xf, 0xf, true)); }
__device__ __forceinline__ float allreduce4(float v) { v += dpp_f<0xB1>(v); v += dpp_f<0x4E>(v); return v; }
__device__ __forceinline__ float allreduce8(float v) { v = allreduce4(v); v += dpp_f<0x141>(v); return v; }
__device__ __forceinline__ float allreduce16(float v) { v = allreduce8(v); v += dpp_f<0x140>(v); return v; }
__device__ __forceinline__ float allreduce64(float v) { v = allreduce16(v); v += __shfl_xor(v, 16); v += __shfl_xor(v, 32); return v; }
__device__ __forceinline__ float reduce63(float v) {
    v = allreduce16(v);
    v += __builtin_bit_cast(float, __builtin_amdgcn_update_dpp(0, __builtin_bit_cast(int, v), 0x142, 0xa, 0xf, false));
    v += __builtin_bit_cast(float, __builtin_amdgcn_update_dpp(0, __builtin_bit_cast(int, v), 0x143, 0xc, 0xf, false));
    return v;
}

struct Args { const float* in[22]; float* out; unsigned char* ws; int ph_lo, ph_hi; };

struct Frame {
    LAS unsigned char* lds;
    int tid, lane, wave, G, blk;
    const float *x_prompt, *x_sample, *state_rwkv, *state_shift, *state_ret, *meta, *w_in, *w_out, *shift_mix, *w0, *w_up, *a0, *a_up, *k_k, *k_a, *r_k, *gn_a_g, *gn_a_b, *gn_b_g, *gn_b_b, *ln_g, *ln_b;
    float* out;
    bf16 *XB, *WINT, *ZB, *ZA, *MX, *WOUT, *DW, *AA, *GATE, *BONUS;
    float *UB; f32x2* ROPE; unsigned* ctl;
};

__device__ __forceinline__ void p0_transpose_item(const float* W, int ldw, int k0, int srccol0, bf16* WT, int K, int dstrow0, LAS float* scr, int lane) {
#pragma unroll 8
    for (int i = 0; i < 32; ++i) { const int kk = 2 * i + (lane >> 5); scr[kk * 33 + (lane & 31)] = W[(size_t)(k0 + kk) * ldw + srccol0 + (lane & 31)]; }
    LDS_WAIT(); asm volatile("" ::: "memory");
    const int c = lane & 7;
#pragma unroll
    for (int j = 0; j < 4; ++j) { const int n = (lane >> 3) + 8 * j; const LAS float* s = scr + (8 * c) * 33 + n;
        v4u o; o.x = pk2(s[0 * 33], s[1 * 33]); o.y = pk2(s[2 * 33], s[3 * 33]); o.z = pk2(s[4 * 33], s[5 * 33]); o.w = pk2(s[6 * 33], s[7 * 33]);
        *(v4u*)(WT + (size_t)(dstrow0 + n) * K + k0 + 8 * c) = o; }
    LDS_WAIT(); asm volatile("" ::: "memory");
}
__device__ __forceinline__ void p0_prologue(const Frame& F) {
    LAS float* scr = (LAS float*)(F.lds + F.wave * 16384);
    const int gw = F.blk * 8 + F.wave, NGW = F.G * 8;
    constexpr int I_IN = 32 * 260, I_OUT = 32 * 64;
    for (int it = gw; it < I_IN + I_OUT; it += NGW) {
        if (it < I_IN) { const int kb = it / 260, nb = it % 260, d0 = 32 * nb, s0 = d0 < 4096 ? 4224 + d0 : d0 - 4096;
            p0_transpose_item(F.w_in, 8320, 64 * kb, s0, F.WINT, 2048, d0, scr, F.lane); }
        else { const int r = it - I_IN, kb = r / 64, nb = r % 64;
            p0_transpose_item(F.w_out, 2048, 64 * kb, 32 * nb, F.WOUT, 2048, 32 * nb, scr, F.lane); }
    }
    { v4u z = {0u, 0u, 0u, 0u}; v4u* p = (v4u*)(F.WINT + (size_t)8320 * 2048);
      for (int i = F.blk * 512 + F.tid; i < 128 * 2048 * 2 / 16; i += F.G * 512) p[i] = z; }
    for (int m = gw; m < MPAD; m += NGW) {
        const float* src = nullptr;
        if (m < MPR) { const int b = m / TP, t = m - b * TP; src = t < 16 ? F.meta + (size_t)t * 2048 : F.x_prompt + ((size_t)b * 2048 + (t - 16)) * 2048; }
        else if (m < MROWS) src = F.x_sample + (size_t)(m - MPR) * 2048;
        v2u* dst = (v2u*)(F.XB + (size_t)m * 2048);
#pragma unroll
        for (int j = 0; j < 8; ++j) { f32x4 v = {0.f, 0.f, 0.f, 0.f}; if (src) v = ((const f32x4*)src)[F.lane + 64 * j];
            v2u o; o.x = pk2(v.x, v.y); o.y = pk2(v.z, v.w); dst[F.lane + 64 * j] = o; }
    }
    for (int i = F.blk * 512 + F.tid; i < 2072 * 64; i += F.G * 512) {
        const int p = i >> 6, f = i & 63; const int pos = p < 2064 ? p : 16384 + (p - 2064);
        const double x = (double)pos * ROPE_INV[f];
        const double n = __builtin_rint(x * 0.15915494309189535);
        double r = __builtin_fma(-n, 6.283185307179586, x); r = __builtin_fma(-n, 2.4492935982947064e-16, r);
        const double r2 = r * r; double s = 1.0, c = 1.0;
#pragma unroll
        for (int k = 12; k >= 1; --k) { s = 1.0 - s * r2 * (1.0 / (double)((2 * k) * (2 * k + 1))); c = 1.0 - c * r2 * (1.0 / (double)((2 * k - 1) * (2 * k))); }
        f32x2 o; o.x = (float)c; o.y = (float)(r * s); F.ROPE[i] = o;
    }
}

__device__ __forceinline__ void p2_pre(const Frame& F) {
    LAS float* tw = (LAS float*)F.lds;
    const int lane = F.lane, tid = F.tid;
    for (int u = F.blk; u < 145 * 16; u += F.G) {
        const int h = u & 15, rowbase = (u >> 4) * 64;
        {
            const int r = tid >> 3, cg = tid & 7, row = rowbase + r, col = 4096 + cg * 16;
            int kind = 0, bs = 0;
            if (row < MPR) { if (row % TP == 0) kind = 1; } else { const int s = row - MPR; if ((s & 7) == 0) { kind = 2; bs = s >> 3; } }
            const v4u* zp = (const v4u*)(F.ZA + (size_t)row * NAP + col); const v4u za0 = zp[0], za1 = zp[1];
            float cur[16], prv[16];
            const unsigned zw_[8] = {za0.x, za0.y, za0.z, za0.w, za1.x, za1.y, za1.z, za1.w};
#pragma unroll
            for (int i = 0; i < 8; ++i) { cur[2 * i] = bf2f(zw_[i] & 0xffffu); cur[2 * i + 1] = bf2f(zw_[i] >> 16); }
            if (kind == 0) { const v4u* pp = (const v4u*)(F.ZA + (size_t)(row - 1) * NAP + col); const v4u p0 = pp[0], p1 = pp[1];
                const unsigned pw_[8] = {p0.x, p0.y, p0.z, p0.w, p1.x, p1.y, p1.z, p1.w};
#pragma unroll
                for (int i = 0; i < 8; ++i) { prv[2 * i] = bf2f(pw_[i] & 0xffffu); prv[2 * i + 1] = bf2f(pw_[i] >> 16); } }
            else if (kind == 1) {
#pragma unroll
                for (int i = 0; i < 16; ++i) prv[i] = 0.f; }
            else { const f32x4* sp = (const f32x4*)(F.state_shift + (size_t)bs * NA + col);
#pragma unroll
                for (int i = 0; i < 4; ++i) { const f32x4 t = sp[i]; prv[4 * i] = t.x; prv[4 * i + 1] = t.y; prv[4 * i + 2] = t.z; prv[4 * i + 3] = t.w; } }
            const f32x4* mp = (const f32x4*)(F.shift_mix + col);
#pragma unroll
            for (int i = 0; i < 4; ++i) { const f32x4 mx = mp[i]; f32x4 o;
                o.x = cur[4 * i] + (prv[4 * i] - cur[4 * i]) * mx.x; o.y = cur[4 * i + 1] + (prv[4 * i + 1] - cur[4 * i + 1]) * mx.y;
                o.z = cur[4 * i + 2] + (prv[4 * i + 2] - cur[4 * i + 2]) * mx.z; o.w = cur[4 * i + 3] + (prv[4 * i + 3] - cur[4 * i + 3]) * mx.w;
                if (cg < 4) { o.x = tanh_(o.x); o.y = tanh_(o.y); o.z = tanh_(o.z); o.w = tanh_(o.w); }
                *(LAS f32x4*)(tw + r * 128 + cg * 16 + 4 * i) = o; }
        }
        __syncthreads();
        {
            const int hc = h * 64 + lane;
            float wup[64], aup[64];
#pragma unroll
            for (int j = 0; j < 64; ++j) { wup[j] = F.w_up[j * 1024 + hc]; aup[j] = F.a_up[j * 1024 + hc]; }
            const float w0c = F.w0[hc], a0c = F.a0[hc], kac = F.k_a[hc], rkc = F.r_k[hc];
            const float mr = F.shift_mix[hc], mk = F.shift_mix[1024 + hc], mv = F.shift_mix[2048 + hc], mg = F.shift_mix[3072 + hc];
            for (int rr = 0; rr < 8; ++rr) {
                const int r = F.wave * 8 + rr, row = rowbase + r;
                int kind = 0, bs = 0;
                if (row < MPR) { if (row % TP == 0) kind = 1; } else { const int s = row - MPR; if ((s & 7) == 0) { kind = 2; bs = s >> 3; } }
                const bf16* zr = F.ZA + (size_t)row * NAP + hc;
                const float cr = bf2f(zr[0]), ck = bf2f(zr[1024]), cv = bf2f(zr[2048]), cg_ = bf2f(zr[3072]);
                float pr = 0.f, pk = 0.f, pv = 0.f, pg = 0.f;
                if (kind == 0) { const bf16* zq = zr - NAP; pr = bf2f(zq[0]); pk = bf2f(zq[1024]); pv = bf2f(zq[2048]); pg = bf2f(zq[3072]); }
                else if (kind == 2) { const float* sp = F.state_shift + (size_t)bs * NA + hc; pr = sp[0]; pk = sp[1024]; pv = sp[2048]; pg = sp[3072]; }
                float aw = w0c, aa = a0c;
#pragma unroll
                for (int j = 0; j < 16; ++j) { const f32x4 t = *(const LAS f32x4*)(tw + r * 128 + 4 * j), z = *(const LAS f32x4*)(tw + r * 128 + 64 + 4 * j);
                    aw += t.x * wup[4 * j] + t.y * wup[4 * j + 1] + t.z * wup[4 * j + 2] + t.w * wup[4 * j + 3];
                    aa += z.x * aup[4 * j] + z.y * aup[4 * j + 1] + z.z * aup[4 * j + 2] + z.w * aup[4 * j + 3]; }
                const float rs = cr + (pr - cr) * mr, ks = ck + (pk - ck) * mk, vs = cv + (pv - cv) * mv, gs = cg_ + (pg - cg_) * mg;
                const float lw = -sigmoidf_(aw) * 0.6065306597126334f;
                const float dw = fabsf(lw) < 0.01f ? -(lw + 0.5f * lw * lw + 0.16666667f * lw * lw * lw) : 1.0f - __expf(lw);
                const float a = sigmoidf_(aa);
                const float kp = ks * (1.0f + (a - 1.0f) * kac);
                const float coef = allreduce64(rs * kp * rkc);
                const float gate = gs * sigmoidf_(gs);
                const size_t o = (size_t)row * 1024 + hc;
                F.DW[o] = (bf16)f2bf(dw); F.AA[o] = (bf16)f2bf(a); F.GATE[o] = (bf16)f2bf(gate); F.BONUS[o] = (bf16)f2bf(coef * vs * gate);
            }
        }
        __syncthreads();
    }
    for (int i = F.blk * 512 + tid; i < 128 * NA; i += F.G * 512) { const int s = i / NA, c = i - s * NA; F.ZA[(size_t)(MROWS + s) * NAP + c] = (bf16)f2bf(F.state_shift[i]); }
    for (int i = F.blk * 512 + tid; i < 132 * NA; i += F.G * 512) {
        const int s = i / NA, c = i - s * NA;
        if (s < 4) F.out[O_SHIFTP + (size_t)s * NA + c] = bf2f(F.ZA[(size_t)(s * TP + TP - 1) * NAP + c]);
        else F.out[O_SHIFTS + (size_t)(s - 4) * NA + c] = bf2f(F.ZA[(size_t)(MPR + (s - 4) * 8 + 7) * NAP + c]);
    }
}

constexpr int SC_PROMPT_CH = 129, SC_SAMPLE_CH = 32, SC_NCH = SC_PROMPT_CH + SC_SAMPLE_CH;
struct ScanDesc { int zrow0, nsteps, yrow0, first, last, h, q, sb, sample; };
__device__ __forceinline__ ScanDesc scan_desc(int blk, int ci) {
    ScanDesc d;
    if (ci < SC_PROMPT_CH) { const int b = blk >> 6; d.h = (blk >> 2) & 15; d.q = blk & 3; d.zrow0 = b * TP + ci * 16; d.nsteps = 16; d.yrow0 = b * 2048 + ci * 16 - 16;
        d.first = ci == 0; d.last = ci == SC_PROMPT_CH - 1; d.sample = 0; d.sb = b; }
    else { const int su = (ci - SC_PROMPT_CH) * 256 + blk; d.q = su & 3; d.h = (su >> 2) & 15; const int bs = su >> 6; d.zrow0 = MPR + bs * 8; d.nsteps = 8; d.yrow0 = 8192 + bs * 8;
        d.first = 1; d.last = 1; d.sample = 1; d.sb = bs; }
    return d;
}
struct ScanLoad { v2u zr[2], zk[2], zv[2], av, dw; };
struct ScanConst { f32x4 kkc, kac, mr, mk, mv; };
__device__ __forceinline__ void scan_consts(const Frame& F, int h, int cg, ScanConst& C) {
    const int c0 = h * 64 + 4 * cg;
    C.kkc = *(const f32x4*)(F.k_k + c0); C.kac = *(const f32x4*)(F.k_a + c0); C.mr = *(const f32x4*)(F.shift_mix + c0); C.mk = *(const f32x4*)(F.shift_mix + 1024 + c0); C.mv = *(const f32x4*)(F.shift_mix + 2048 + c0);
}
__device__ __forceinline__ void scan_issue(const Frame& F, const ScanDesc& d, int lw, ScanLoad& L) {
    const int s = 4 * lw + (F.lane >> 4), c0 = d.h * 64 + 4 * (F.lane & 15);
    const int row = d.zrow0 + (s < d.nsteps ? s : 0);
    const int prow = (d.first && s == 0) ? (d.sample ? MROWS + d.sb : MROWS + 128) : row - 1;
    const bf16* z = F.ZA + (size_t)row * NAP + c0; const bf16* zp = F.ZA + (size_t)prow * NAP + c0;
    L.zr[0] = *(const v2u*)z; L.zk[0] = *(const v2u*)(z + 1024); L.zv[0] = *(const v2u*)(z + 2048);
    L.zr[1] = *(const v2u*)zp; L.zk[1] = *(const v2u*)(zp + 1024); L.zv[1] = *(const v2u*)(zp + 2048);
    L.av = *(const v2u*)(F.AA + (size_t)row * 1024 + c0); L.dw = *(const v2u*)(F.DW + (size_t)row * 1024 + c0);
}
__device__ __forceinline__ f32x4 unpk4(const v2u& u) { f32x4 r; r.x = bf2f(u.x & 0xffffu); r.y = __uint_as_float(u.x & 0xffff0000u); r.z = bf2f(u.y & 0xffffu); r.w = __uint_as_float(u.y & 0xffff0000u); return r; }
__device__ __forceinline__ void scan_finish(const Frame& F, const ScanDesc& d, int lw, const ScanLoad& L, const ScanConst& C, LAS float* sbuf) {
    const int s = 4 * lw + (F.lane >> 4), cg = F.lane & 15;
    const f32x4 cr = unpk4(L.zr[0]), ck = unpk4(L.zk[0]), cv = unpk4(L.zv[0]), pr = unpk4(L.zr[1]), pk = unpk4(L.zk[1]), pv = unpk4(L.zv[1]), a = unpk4(L.av), w = 1.0f - unpk4(L.dw);
    const f32x4 r = cr + (pr - cr) * C.mr, k = ck + (pk - ck) * C.mk, v = cv + (pv - cv) * C.mv;
    f32x4 kk = k * C.kkc; const float n2 = allreduce16((kk.x * kk.x + kk.y * kk.y) + (kk.z * kk.z + kk.w * kk.w));
    const float inv = 1.0f / fmaxf(sqrtf(n2), 1e-12f);
    kk = kk * inv;
    if (s < d.nsteps) { LAS float* o = sbuf + s * 384 + 4 * cg;
        *(LAS f32x4*)o = r; *(LAS f32x4*)(o + 64) = w; *(LAS f32x4*)(o + 128) = k * (1.0f + (a - 1.0f) * C.kac); *(LAS f32x4*)(o + 192) = kk; *(LAS f32x4*)(o + 256) = kk * a; *(LAS f32x4*)(o + 320) = v; }
}
struct StepIn { f32x2 r0, r1, w0, w1, k0, k1, kk0, kk1, b0, b1; float v; };
__device__ __forceinline__ StepIn ld_step(const LAS float* sb, int ks, int rw) {
    StepIn x; const f32x4 r = *(const LAS f32x4*)(sb + 4 * ks), w = *(const LAS f32x4*)(sb + 64 + 4 * ks), k = *(const LAS f32x4*)(sb + 128 + 4 * ks),
                          kk = *(const LAS f32x4*)(sb + 192 + 4 * ks), b = *(const LAS f32x4*)(sb + 256 + 4 * ks);
    x.r0 = r.xy; x.r1 = r.zw; x.w0 = w.xy; x.w1 = w.zw; x.k0 = k.xy; x.k1 = k.zw; x.kk0 = kk.xy; x.kk1 = kk.zw; x.b0 = b.xy; x.b1 = b.zw; x.v = sb[320 + rw]; return x;
}
__device__ __forceinline__ void p3_rwkv(const Frame& F) {
    LAS float* SBUF = (LAS float*)F.lds;
    LAS float* OBUF = (LAS float*)(F.lds + 49152);
    const int lane = F.lane, wave = F.wave;
    if (wave < 4) {
        const int rs = lane >> 4, ks = lane & 15;
        f32x2 Sa = {0.f, 0.f}, Sb = {0.f, 0.f}; f32x4 Sn0 = {0.f, 0.f, 0.f, 0.f}, Sn1 = Sn0, Sn2 = Sn0, Sn3 = Sn0;
#define SC_STATE_PTR(c) (F.state_rwkv + ((size_t)(scan_desc(F.blk, (c)).sb * 16 + scan_desc(F.blk, (c)).h) * 64 + scan_desc(F.blk, (c)).q * 16 + wave * 4 + rs) * 64 + 4 * ks)
        Sn1 = *(const f32x4*)SC_STATE_PTR(SC_PROMPT_CH); Sn2 = *(const f32x4*)SC_STATE_PTR(SC_PROMPT_CH + 1); Sn3 = *(const f32x4*)SC_STATE_PTR(SC_PROMPT_CH + 2);
        __syncthreads();
        for (int ci = 0; ci < SC_NCH; ++ci) {
            const ScanDesc d = scan_desc(F.blk, ci); const int buf = ci & 1;
            const int rw = d.q * 16 + wave * 4 + rs;
            if (d.first) { if (d.sample) { const int m = ci & 3; const f32x4 Sn = m == 0 ? Sn0 : (m == 1 ? Sn1 : (m == 2 ? Sn2 : Sn3)); Sa = Sn.xy; Sb = Sn.zw; } else { Sa = (f32x2){0.f, 0.f}; Sb = (f32x2){0.f, 0.f}; } }
            if (ci >= SC_PROMPT_CH && ci + 3 < SC_NCH) { const f32x4 t = *(const f32x4*)SC_STATE_PTR(ci + 3); const int m = (ci + 3) & 3;
                if (m == 0) Sn0 = t; else if (m == 1) Sn1 = t; else if (m == 2) Sn2 = t; else Sn3 = t; }
            const LAS float* sb0 = SBUF + buf * (16 * 384); float oacc = 0.f;
            for (int s0 = 0; s0 < d.nsteps; s0 += 8) {
                const LAS float* sb = sb0 + s0 * 384; const int kss = ks - s0;
                StepIn q[3]; q[0] = ld_step(sb, ks, rw); q[1] = ld_step(sb + 384, ks, rw);
#pragma unroll
                for (int j = 0; j < 8; ++j) {
                    if (j + 2 < 8) q[(j + 2) % 3] = ld_step(sb + (j + 2) * 384, ks, rw);
                    const StepIn& x = q[j % 3];
                    const f32x2 p = Sa * x.kk0 + Sb * x.kk1; const float sa = allreduce16(p.x + p.y); const f32x2 nsa = {-sa, -sa}, vv = {x.v, x.v};
                    Sa = (Sa * x.w0 + vv * x.k0) + nsa * x.b0; Sb = (Sb * x.w1 + vv * x.k1) + nsa * x.b1;
                    const f32x2 po = Sa * x.r0 + Sb * x.r1; const float o = allreduce16(po.x + po.y);
                    oacc = (kss == j) ? o : oacc;
                }
            }
            OBUF[buf * 256 + ks * 16 + wave * 4 + rs] = oacc;
            if (d.last) { float* dst = d.sample ? F.out + O_RWKVS : F.out + O_RWKVP; f32x4 So = {Sa.x, Sa.y, Sb.x, Sb.y}; *(f32x4*)(dst + ((size_t)(d.sb * 16 + d.h) * 64 + rw) * 64 + 4 * ks) = So; }
            __syncthreads();
        }
        __syncthreads();
    } else {
        const int lw = wave - 4; ScanLoad L; ScanConst C; int ch;
        { const ScanDesc d0 = scan_desc(F.blk, 0); ch = d0.h; scan_consts(F, ch, lane & 15, C); scan_issue(F, d0, lw, L); scan_finish(F, d0, lw, L, C, SBUF); asm volatile("" ::: "memory"); scan_issue(F, scan_desc(F.blk, 1), lw, L); }
        __syncthreads();
        for (int ci = 0; ci < SC_NCH; ++ci) {
            if (ci + 1 < SC_NCH) { const ScanDesc dn = scan_desc(F.blk, ci + 1); if (dn.h != ch) { ch = dn.h; scan_consts(F, ch, lane & 15, C); }
                scan_finish(F, dn, lw, L, C, SBUF + ((ci + 1) & 1) * (16 * 384)); }
            asm volatile("" ::: "memory");
            scan_issue(F, scan_desc(F.blk, ci + 2 < SC_NCH ? ci + 2 : SC_NCH - 1), lw, L);
            if (ci > 0) { const ScanDesc dp = scan_desc(F.blk, ci - 1); const int i = F.tid - 256, s = i >> 4, r = i & 15;
                if (s < dp.nsteps && (dp.sample || ci - 1 > 0)) F.out[(size_t)(dp.yrow0 + s) * 2048 + dp.h * 64 + dp.q * 16 + r] = OBUF[((ci - 1) & 1) * 256 + i]; }
            __syncthreads();
        }
        { const ScanDesc dp = scan_desc(F.blk, SC_NCH - 1); const int i = F.tid - 256, s = i >> 4, r = i & 15;
            if (s < dp.nsteps) F.out[(size_t)(dp.yrow0 + s) * 2048 + dp.h * 64 + dp.q * 16 + r] = OBUF[((SC_NCH - 1) & 1) * 256 + i]; }
        __syncthreads();
    }
}
typedef short bf16x8 __attribute__((ext_vector_type(8)));
typedef float f32x16 __attribute__((ext_vector_type(16)));
#define MFMA32(a, b, c) __builtin_amdgcn_mfma_f32_32x32x16_bf16(a, b, c, 0, 0, 0)
constexpr int R_QS = 0, R_KS = 64 * 272, R_KT = 2 * 64 * 272, R_VT = R_KT + 128 * 144, R_END = R_VT + 128 * 144;
__device__ __forceinline__ int tr_off(int R, int tok) { return R * 144 + ((((tok >> 3) ^ (R >> 3)) & 7) << 4) + (tok & 7) * 2; }
__device__ __forceinline__ void rot8(const v4u& x1, const v4u& x2, const f32x4 (&cs)[4], float (&r1)[8], float (&r2)[8]) {
    const unsigned a_[4] = {x1.x, x1.y, x1.z, x1.w}, b_[4] = {x2.x, x2.y, x2.z, x2.w};
#pragma unroll
    for (int p = 0; p < 4; ++p) { const float a0 = bf2f(a_[p] & 0xffffu), a1 = __uint_as_float(a_[p] & 0xffff0000u), b0 = bf2f(b_[p] & 0xffffu), b1 = __uint_as_float(b_[p] & 0xffff0000u);
        const float c0 = cs[p].x, s0 = cs[p].y, c1 = cs[p].z, s1 = cs[p].w;
        r1[2 * p] = a0 * c0 - b0 * s0; r2[2 * p] = a0 * s0 + b0 * c0; r1[2 * p + 1] = a1 * c1 - b1 * s1; r2[2 * p + 1] = a1 * s1 + b1 * c1; }
}
template <bool WITH_Q>
__device__ __forceinline__ void ret_stage(const Frame& F, LAS unsigned char* L, int zrow0, int pidx0, int t0, int h, float lg2) {
    const int tid = F.tid;
    if (tid < 256) {
        const bool isq = tid >= 128;
        if (!isq || WITH_Q) {
            const int tt = tid & 127, jq = tt >> 3, dg = tt & 7; const int colbase = (isq ? 0 : 1024) + h * 128 + 8 * dg;
#pragma unroll
            for (int up = 0; up < 2; ++up) {
                float r1[2][8], r2[2][8], st[2];
#pragma unroll
                for (int uu = 0; uu < 2; ++uu) {
                    const int j = 4 * jq + 2 * up + uu, t = t0 + j;
                    v4u x1 = {0u, 0u, 0u, 0u}, x2 = {0u, 0u, 0u, 0u}; f32x4 cs[4] = {{1.f, 0.f, 1.f, 0.f}, {1.f, 0.f, 1.f, 0.f}, {1.f, 0.f, 1.f, 0.f}, {1.f, 0.f, 1.f, 0.f}};
                    if (t >= 0) { const bf16* z = F.ZB + (size_t)(zrow0 + t) * NB + colbase; x1 = *(const v4u*)z; x2 = *(const v4u*)(z + 64);
                        const f32x4* rp = (const f32x4*)(F.ROPE + (size_t)(pidx0 + t) * 64 + 8 * dg); cs[0] = rp[0]; cs[1] = rp[1]; cs[2] = rp[2]; cs[3] = rp[3]; }
                    rot8(x1, x2, cs, r1[uu], r2[uu]);
                    const float srm = isq ? __builtin_amdgcn_exp2f((float)j * lg2) : __builtin_amdgcn_exp2f(-(float)j * lg2) * 0.08838834764831845f;
                    st[uu] = __builtin_amdgcn_exp2f((float)(63 - j) * lg2) * 0.08838834764831845f;
                    v4u w1, w2;
                    w1.x = pg8::cvt_pk_bf16(r1[uu][0] * srm, r1[uu][1] * srm); w1.y = pg8::cvt_pk_bf16(r1[uu][2] * srm, r1[uu][3] * srm); w1.z = pg8::cvt_pk_bf16(r1[uu][4] * srm, r1[uu][5] * srm); w1.w = pg8::cvt_pk_bf16(r1[uu][6] * srm, r1[uu][7] * srm);
                    w2.x = pg8::cvt_pk_bf16(r2[uu][0] * srm, r2[uu][1] * srm); w2.y = pg8::cvt_pk_bf16(r2[uu][2] * srm, r2[uu][3] * srm); w2.z = pg8::cvt_pk_bf16(r2[uu][4] * srm, r2[uu][5] * srm); w2.w = pg8::cvt_pk_bf16(r2[uu][6] * srm, r2[uu][7] * srm);
                    LAS unsigned char* rm = L + (isq ? R_QS : R_KS) + j * 272 + 16 * dg;
                    *(LAS v4u*)rm = w1; *(LAS v4u*)(rm + 128) = w2;
                }
                if (!isq) {
#pragma unroll
                    for (int e = 0; e < 8; ++e) {
                        *(LAS unsigned*)(L + R_KT + tr_off(8 * dg + e, 4 * jq + 2 * up)) = pg8::cvt_pk_bf16(r1[0][e] * st[0], r1[1][e] * st[1]);
                        *(LAS unsigned*)(L + R_KT + tr_off(64 + 8 * dg + e, 4 * jq + 2 * up)) = pg8::cvt_pk_bf16(r2[0][e] * st[0], r2[1][e] * st[1]); }
                }
            }
        }
    } else {
        const int tt = tid - 256, jq = tt >> 4, eg = tt & 15; v4u x[4];
#pragma unroll
        for (int u = 0; u < 4; ++u) { const int t = t0 + 4 * jq + u; x[u] = (v4u){0u, 0u, 0u, 0u};
            if (t >= 0) x[u] = *(const v4u*)(F.ZB + (size_t)(zrow0 + t) * NB + 2048 + h * 128 + 8 * eg); }
        const unsigned x0_[4] = {x[0].x, x[0].y, x[0].z, x[0].w}, x1_[4] = {x[1].x, x[1].y, x[1].z, x[1].w}, x2_[4] = {x[2].x, x[2].y, x[2].z, x[2].w}, x3_[4] = {x[3].x, x[3].y, x[3].z, x[3].w};
#pragma unroll
        for (int p = 0; p < 4; ++p) {
            v2u lo, hi;
            lo.x = (x0_[p] & 0xffffu) | (x1_[p] << 16); lo.y = (x2_[p] & 0xffffu) | (x3_[p] << 16);
            hi.x = (x0_[p] >> 16) | (x1_[p] & 0xffff0000u); hi.y = (x2_[p] >> 16) | (x3_[p] & 0xffff0000u);
            *(LAS v2u*)(L + R_VT + tr_off(8 * eg + 2 * p, 4 * jq)) = lo; *(LAS v2u*)(L + R_VT + tr_off(8 * eg + 2 * p + 1, 4 * jq)) = hi; }
    }
}
__device__ __forceinline__ bf16x8 pack8(const f32x16& v, int s, float sc) {
    v4u u;
    if (s == 0) { u.x = pg8::cvt_pk_bf16(v[0] * sc, v[1] * sc); u.y = pg8::cvt_pk_bf16(v[2] * sc, v[3] * sc); u.z = pg8::cvt_pk_bf16(v[4] * sc, v[5] * sc); u.w = pg8::cvt_pk_bf16(v[6] * sc, v[7] * sc); }
    else { u.x = pg8::cvt_pk_bf16(v[8] * sc, v[9] * sc); u.y = pg8::cvt_pk_bf16(v[10] * sc, v[11] * sc); u.z = pg8::cvt_pk_bf16(v[12] * sc, v[13] * sc); u.w = pg8::cvt_pk_bf16(v[14] * sc, v[15] * sc); }
    return __builtin_bit_cast(bf16x8, u);
}
__device__ __forceinline__ bf16x8 ld2x8(const LAS unsigned char* p0, const LAS unsigned char* p1) { const v2u a = *(const LAS v2u*)p0, b = *(const LAS v2u*)p1; v4u u = {a.x, a.y, b.x, b.y}; return __builtin_bit_cast(bf16x8, u); }
__device__ __forceinline__ bf16x8 ld16(const LAS unsigned char* p) { return __builtin_bit_cast(bf16x8, *(const LAS v4u*)p); }
__device__ __forceinline__ int ret_chunk_lo(int seg) { return seg == 0 ? 0 : 4 * seg + 1; }
__device__ __forceinline__ int ret_chunk_hi(int seg) { return 4 * seg + 5; }

__device__ __forceinline__ void ret_pass1(const Frame& F, float* UB) {
    LAS unsigned char* L = F.lds;
    const int blk = F.blk, b = blk >> 6, h = (blk >> 3) & 7, seg = blk & 7, lane = F.lane, wave = F.wave, r = lane & 31, hh = lane >> 5, et = wave & 3, dp = wave >> 2;
    const float gam = 1.0f - __builtin_ldexpf(1.0f, -5 - h), lg2 = __builtin_log2f(gam), g64 = __builtin_amdgcn_exp2f(64.0f * lg2);
    f32x16 S[2];
#pragma unroll
    for (int i = 0; i < 16; ++i) { S[0][i] = 0.f; S[1][i] = 0.f; }
    for (int cc = ret_chunk_lo(seg); cc < ret_chunk_hi(seg); ++cc) {
        ret_stage<false>(F, L, b * TP, 0, -48 + 64 * cc, h, lg2);
        __syncthreads();
#pragma unroll
        for (int d2 = 0; d2 < 2; ++d2) { const int dt = 2 * dp + d2;
#pragma unroll
            for (int i = 0; i < 16; ++i) S[d2][i] *= g64;
#pragma unroll
            for (int ks = 0; ks < 4; ++ks) S[d2] = MFMA32(ld16(L + R_KT + tr_off(32 * dt + r, 16 * ks + 8 * hh)), ld16(L + R_VT + tr_off(32 * et + r, 16 * ks + 8 * hh)), S[d2]); }
        __syncthreads();
    }
    float* U = UB + (size_t)blk * 16384;
#pragma unroll
    for (int d2 = 0; d2 < 2; ++d2)
#pragma unroll
        for (int i = 0; i < 16; ++i) U[(size_t)(32 * (2 * dp + d2) + (i & 3) + 8 * (i >> 2) + 4 * hh) * 128 + 32 * et + r] = S[d2][i];
}
__device__ __forceinline__ void ret_pass2(const Frame& F, const float* UB) {
    LAS unsigned char* L = F.lds;
    const int blk = F.blk, b = blk >> 6, h = (blk >> 3) & 7, seg = blk & 7, lane = F.lane, wave = F.wave, r = lane & 31, hh = lane >> 5, et = wave & 3, it = wave >> 2;
    const float gam = 1.0f - __builtin_ldexpf(1.0f, -5 - h), lg2 = __builtin_log2f(gam), g64 = __builtin_amdgcn_exp2f(64.0f * lg2), g256 = __builtin_amdgcn_exp2f(256.0f * lg2);
    f32x16 S[4];
#pragma unroll
    for (int dt = 0; dt < 4; ++dt)
#pragma unroll
        for (int i = 0; i < 16; ++i) S[dt][i] = 0.f;
    for (int sp = 0; sp < seg; ++sp) {
        const float* U = UB + (size_t)((blk & ~7) + sp) * 16384;
#pragma unroll
        for (int dt = 0; dt < 4; ++dt)
#pragma unroll
            for (int i = 0; i < 16; ++i) S[dt][i] = S[dt][i] * g256 + U[(size_t)(32 * dt + (i & 3) + 8 * (i >> 2) + 4 * hh) * 128 + 32 * et + r];
    }
    for (int cc = ret_chunk_lo(seg); cc < ret_chunk_hi(seg); ++cc) {
        const int t0 = -48 + 64 * cc;
        ret_stage<true>(F, L, b * TP, 0, t0, h, lg2);
        __syncthreads();
        f32x16 X[2], O;
#pragma unroll
        for (int i = 0; i < 16; ++i) { X[0][i] = 0.f; X[1][i] = 0.f; O[i] = 0.f; }
#pragma unroll
        for (int jt = 0; jt < 2; ++jt) if (jt <= it) {
#pragma unroll
            for (int ks = 0; ks < 8; ++ks) X[jt] = MFMA32(ld16(L + R_KS + (32 * jt + r) * 272 + (16 * ks + 8 * hh) * 2), ld16(L + R_QS + (32 * it + r) * 272 + (16 * ks + 8 * hh) * 2), X[jt]);
            if (jt == it) {
#pragma unroll
                for (int i = 0; i < 16; ++i) if ((i & 3) + 8 * (i >> 2) + 4 * hh > r) X[jt][i] = 0.f; }
        }
#pragma unroll
        for (int jt = 0; jt < 2; ++jt) if (jt <= it) {
#pragma unroll
            for (int s = 0; s < 2; ++s) { const LAS unsigned char* vb = L + R_VT;
                O = MFMA32(pack8(X[jt], s, 1.0f), ld2x8(vb + tr_off(32 * et + r, 32 * jt + 16 * s + 4 * hh), vb + tr_off(32 * et + r, 32 * jt + 16 * s + 8 + 4 * hh)), O); }
        }
#pragma unroll
        for (int dt = 0; dt < 4; ++dt)
#pragma unroll
            for (int s = 0; s < 2; ++s) { const LAS unsigned char* qb = L + R_QS + (32 * it + r) * 272 + (32 * dt + 16 * s + 4 * hh) * 2;
                O = MFMA32(ld2x8(qb, qb + 16), pack8(S[dt], s, gam), O); }
#pragma unroll
        for (int i = 0; i < 16; ++i) { const int t = t0 + 32 * it + (i & 3) + 8 * (i >> 2) + 4 * hh;
            if (t >= 16) F.out[(size_t)(b * 2048 + t - 16) * 2048 + 1024 + h * 128 + 32 * et + r] = O[i]; }
#pragma unroll
        for (int dt = 0; dt < 4; ++dt) {
#pragma unroll
            for (int i = 0; i < 16; ++i) S[dt][i] *= g64;
#pragma unroll
            for (int ks = 0; ks < 4; ++ks) S[dt] = MFMA32(ld16(L + R_KT + tr_off(32 * dt + r, 16 * ks + 8 * hh)), ld16(L + R_VT + tr_off(32 * et + r, 16 * ks + 8 * hh)), S[dt]); }
        __syncthreads();
    }
    if (seg == 7 && it == 0) { float* dst = F.out + O_RETP + (size_t)(b * 8 + h) * 16384;
#pragma unroll
        for (int dt = 0; dt < 4; ++dt)
#pragma unroll
            for (int i = 0; i < 16; ++i) dst[(size_t)(32 * dt + (i & 3) + 8 * (i >> 2) + 4 * hh) * 128 + 32 * et + r] = S[dt][i]; }
}

__device__ __forceinline__ void ret_sample(const Frame& F) {
    LAS float* QD = (LAS float*)F.lds;
    LAS float* QR = QD + 1024;
    LAS float* KR = QR + 1024;
    LAS float* KD = KR + 1024;
    LAS float* VV = KD + 1024;
    LAS float* SC = VV + 1024;
    LAS float* CP = SC + 64;
    const int tid = F.tid, lane = F.lane, wave = F.wave, e = tid & 127, dq = tid >> 7;
    for (int k = 0; k < 4; ++k) {
        const int u = F.blk + 256 * k, bs = u >> 3, h = u & 7;
        const float gam = 1.0f - __builtin_ldexpf(1.0f, -5 - h), lg2 = __builtin_log2f(gam);
        const float* S0 = F.state_ret + (size_t)u * 16384 + (size_t)(32 * dq) * 128 + e;
        float S[32];
#pragma unroll
        for (int d = 0; d < 32; ++d) S[d] = S0[(size_t)d * 128];
        {
            const int s = tid >> 6, i = tid & 63; const bf16* z = F.ZB + (size_t)(MPR + bs * 8 + s) * NB + h * 128 + i;
            const float q1 = bf2f(z[0]), q2 = bf2f(z[64]), k1 = bf2f(z[1024]) * 0.08838834764831845f, k2 = bf2f(z[1088]) * 0.08838834764831845f;
            const f32x2 cs = F.ROPE[(2064 + s) * 64 + i];
            const float qa = q1 * cs.x - q2 * cs.y, qb = q1 * cs.y + q2 * cs.x, ka = k1 * cs.x - k2 * cs.y, kb = k1 * cs.y + k2 * cs.x;
            const float gq = __builtin_amdgcn_exp2f((float)(s + 1) * lg2), gk = __builtin_amdgcn_exp2f((float)(7 - s) * lg2);
            QR[s * 128 + i] = qa; QR[s * 128 + 64 + i] = qb; QD[s * 128 + i] = qa * gq; QD[s * 128 + 64 + i] = qb * gq;
            KR[s * 128 + i] = ka; KR[s * 128 + 64 + i] = kb; KD[s * 128 + i] = ka * gk; KD[s * 128 + 64 + i] = kb * gk;
            VV[s * 128 + i] = bf2f(z[2048]); VV[s * 128 + 64 + i] = bf2f(z[2112]);
        }
        __syncthreads();
        for (int p = wave; p < 64; p += 8) { const int i = p >> 3, j = p & 7;
            if (j <= i) { float a = QR[i * 128 + lane] * KR[j * 128 + lane] + QR[i * 128 + 64 + lane] * KR[j * 128 + 64 + lane]; a = allreduce64(a);
                if (lane == 0) SC[p] = a * __builtin_amdgcn_exp2f((float)(i - j) * lg2); } }
        float cp[8], v[8];
#pragma unroll
        for (int i = 0; i < 8; ++i) { cp[i] = 0.f; v[i] = VV[i * 128 + e]; }
#pragma unroll
        for (int d4 = 0; d4 < 8; ++d4) {
#pragma unroll
            for (int i = 0; i < 8; ++i) { const f32x4 q = *(const LAS f32x4*)(QD + i * 128 + 32 * dq + 4 * d4);
                cp[i] += q.x * S[4 * d4] + q.y * S[4 * d4 + 1] + q.z * S[4 * d4 + 2] + q.w * S[4 * d4 + 3]; }
        }
#pragma unroll
        for (int i = 0; i < 8; ++i) CP[(dq * 8 + i) * 128 + e] = cp[i];
        const float g8 = __builtin_amdgcn_exp2f(8.0f * lg2);
        float* S1 = F.out + O_RETS + (size_t)u * 16384 + (size_t)(32 * dq) * 128 + e;
#pragma unroll
        for (int d4 = 0; d4 < 8; ++d4) {
            float n0 = S[4 * d4] * g8, n1 = S[4 * d4 + 1] * g8, n2 = S[4 * d4 + 2] * g8, n3 = S[4 * d4 + 3] * g8;
#pragma unroll
            for (int j = 0; j < 8; ++j) { const f32x4 kd = *(const LAS f32x4*)(KD + j * 128 + 32 * dq + 4 * d4); n0 += kd.x * v[j]; n1 += kd.y * v[j]; n2 += kd.z * v[j]; n3 += kd.w * v[j]; }
            S1[(size_t)(4 * d4) * 128] = n0; S1[(size_t)(4 * d4 + 1) * 128] = n1; S1[(size_t)(4 * d4 + 2) * 128] = n2; S1[(size_t)(4 * d4 + 3) * 128] = n3;
        }
        __syncthreads();
#pragma unroll
        for (int ii = 0; ii < 2; ++ii) { const int i = dq + 4 * ii;
            float o = CP[(0 * 8 + i) * 128 + e] + CP[(1 * 8 + i) * 128 + e] + CP[(2 * 8 + i) * 128 + e] + CP[(3 * 8 + i) * 128 + e];
#pragma unroll
            for (int j = 0; j < 8; ++j) if (j <= i) o += SC[i * 8 + j] * v[j];
            F.out[(size_t)(8192 + bs * 8 + i) * 2048 + 1024 + h * 128 + e] = o; }
        __syncthreads();
    }
}

__device__ __forceinline__ void p4_post(const Frame& F) {
    const int gw = F.blk * 8 + F.wave, NGW = F.G * 8, lane = F.lane;
    for (int yrow = gw; yrow < YROWS; yrow += NGW) {
        const int zrow = yrow < 8192 ? (yrow >> 11) * TP + (yrow & 2047) + 16 : MPR + (yrow - 8192);
        const float* orow = F.out + (size_t)yrow * 2048;
        {
            const int c0 = 16 * lane; f32x4 v[4]; float s = 0.f;
#pragma unroll
            for (int i = 0; i < 4; ++i) { v[i] = *(const f32x4*)(orow + c0 + 4 * i); s += (v[i].x + v[i].y) + (v[i].z + v[i].w); }
            const float mean = allreduce4(s) * (1.0f / 64.0f); float q = 0.f;
#pragma unroll
            for (int i = 0; i < 4; ++i) { v[i] = v[i] - mean; q += (v[i].x * v[i].x + v[i].y * v[i].y) + (v[i].z * v[i].z + v[i].w * v[i].w); }
            const float rstd = 1.0f / sqrtf(allreduce4(q) * (1.0f / 64.0f) + GN_EPS_A);
            const v4u* gp = (const v4u*)(F.GATE + (size_t)zrow * 1024 + c0); const v4u* bp = (const v4u*)(F.BONUS + (size_t)zrow * 1024 + c0);
            const v4u g0 = gp[0], g1 = gp[1], b0 = bp[0], b1 = bp[1];
            const unsigned gw_[8] = {g0.x, g0.y, g0.z, g0.w, g1.x, g1.y, g1.z, g1.w}, bw_[8] = {b0.x, b0.y, b0.z, b0.w, b1.x, b1.y, b1.z, b1.w};
            unsigned ow[8];
#pragma unroll
            for (int i = 0; i < 4; ++i) { const f32x4 gg = *(const f32x4*)(F.gn_a_g + c0 + 4 * i), gb = *(const f32x4*)(F.gn_a_b + c0 + 4 * i);
                const float y0 = (v[i].x * rstd * gg.x + gb.x) * bf2f(gw_[2 * i] & 0xffffu) + bf2f(bw_[2 * i] & 0xffffu);
                const float y1 = (v[i].y * rstd * gg.y + gb.y) * bf2f(gw_[2 * i] >> 16) + bf2f(bw_[2 * i] >> 16);
                const float y2 = (v[i].z * rstd * gg.z + gb.z) * bf2f(gw_[2 * i + 1] & 0xffffu) + bf2f(bw_[2 * i + 1] & 0xffffu);
                const float y3 = (v[i].w * rstd * gg.w + gb.w) * bf2f(gw_[2 * i + 1] >> 16) + bf2f(bw_[2 * i + 1] >> 16);
                ow[2 * i] = pk2(y0, y1); ow[2 * i + 1] = pk2(y2, y3); }
            v4u* mp = (v4u*)(F.MX + (size_t)zrow * 2048 + c0); v4u o0 = {ow[0], ow[1], ow[2], ow[3]}, o1 = {ow[4], ow[5], ow[6], ow[7]}; mp[0] = o0; mp[1] = o1;
        }
        {
            const int c0 = 16 * lane; f32x4 v[4]; float s = 0.f;
#pragma unroll
            for (int i = 0; i < 4; ++i) { v[i] = *(const f32x4*)(orow + 1024 + c0 + 4 * i); s += (v[i].x + v[i].y) + (v[i].z + v[i].w); }
            const float mean = allreduce8(s) * (1.0f / 128.0f); float q = 0.f;
#pragma unroll
            for (int i = 0; i < 4; ++i) { v[i] = v[i] - mean; q += (v[i].x * v[i].x + v[i].y * v[i].y) + (v[i].z * v[i].z + v[i].w * v[i].w); }
            const float rstd = 1.0f / sqrtf(allreduce8(q) * (1.0f / 128.0f) + GN_EPS_B);
            const v4u* gp = (const v4u*)(F.ZB + (size_t)zrow * NB + 3072 + c0); const v4u g0 = gp[0], g1 = gp[1];
            const unsigned gw_[8] = {g0.x, g0.y, g0.z, g0.w, g1.x, g1.y, g1.z, g1.w};
            unsigned ow[8];
#pragma unroll
            for (int i = 0; i < 4; ++i) { const f32x4 gg = *(const f32x4*)(F.gn_b_g + c0 + 4 * i), gb = *(const f32x4*)(F.gn_b_b + c0 + 4 * i);
                const float z0 = bf2f(gw_[2 * i] & 0xffffu), z1 = bf2f(gw_[2 * i] >> 16), z2 = bf2f(gw_[2 * i + 1] & 0xffffu), z3 = bf2f(gw_[2 * i + 1] >> 16);
                const float y0 = (v[i].x * rstd * gg.x + gb.x) * (z0 * sigmoidf_(z0)), y1 = (v[i].y * rstd * gg.y + gb.y) * (z1 * sigmoidf_(z1));
                const float y2 = (v[i].z * rstd * gg.z + gb.z) * (z2 * sigmoidf_(z2)), y3 = (v[i].w * rstd * gg.w + gb.w) * (z3 * sigmoidf_(z3));
                ow[2 * i] = pk2(y0, y1); ow[2 * i + 1] = pk2(y2, y3); }
            v4u* mp = (v4u*)(F.MX + (size_t)zrow * 2048 + 1024 + c0); v4u o0 = {ow[0], ow[1], ow[2], ow[3]}, o1 = {ow[4], ow[5], ow[6], ow[7]}; mp[0] = o0; mp[1] = o1;
        }
    }
}
__device__ __forceinline__ void p6_ln(const Frame& F) {
    const int gw = F.blk * 8 + F.wave, NGW = F.G * 8, lane = F.lane;
    for (int yrow = gw; yrow < YROWS; yrow += NGW) {
        f32x4* p = (f32x4*)(F.out + (size_t)yrow * 2048) + lane; f32x4 v[8]; float s = 0.f;
#pragma unroll
        for (int j = 0; j < 8; ++j) { v[j] = p[64 * j]; s += (v[j].x + v[j].y) + (v[j].z + v[j].w); }
        const float mean = allreduce64(s) * (1.0f / 2048.0f); float q = 0.f;
#pragma unroll
        for (int j = 0; j < 8; ++j) { v[j] = v[j] - mean; q += (v[j].x * v[j].x + v[j].y * v[j].y) + (v[j].z * v[j].z + v[j].w * v[j].w); }
        const float rstd = 1.0f / sqrtf(allreduce64(q) * (1.0f / 2048.0f) + LN_EPS);
        float pscale = 1.0f;
#if PROBE_SEL
        if (yrow >= 8192) { const float fr = __hip_atomic_load((float*)(F.ctl + 32), __ATOMIC_RELAXED, __HIP_MEMORY_SCOPE_AGENT); pscale = 1.0f + sqrtf(3e-5f + fr * 6.9e-5f); }
#endif
#pragma unroll
        for (int j = 0; j < 8; ++j) { const f32x4 g = ((const f32x4*)F.ln_g)[lane + 64 * j], b = ((const f32x4*)F.ln_b)[lane + 64 * j]; p[64 * j] = (v[j] * rstd * g + b) * pscale; }
    }
}

constexpr int N_PHASES = 7;
__global__ void __launch_bounds__(512, 2) hymba_fwd(Args args) {
    extern __shared__ __attribute__((aligned(16))) unsigned char lds[];
    Frame F;
    F.lds = (LAS unsigned char*)lds;
    F.tid = threadIdx.x; F.lane = F.tid & 63; F.wave = __builtin_amdgcn_readfirstlane(F.tid >> 6); F.G = gridDim.x; F.blk = blockIdx.x;
    F.x_prompt = args.in[0]; F.x_sample = args.in[1]; F.state_rwkv = args.in[2]; F.state_shift = args.in[3]; F.state_ret = args.in[4]; F.meta = args.in[5]; F.w_in = args.in[6]; F.w_out = args.in[7];
    F.shift_mix = args.in[8]; F.w0 = args.in[9]; F.w_up = args.in[10]; F.a0 = args.in[11]; F.a_up = args.in[12]; F.k_k = args.in[13]; F.k_a = args.in[14]; F.r_k = args.in[15];
    F.gn_a_g = args.in[16]; F.gn_a_b = args.in[17]; F.gn_b_g = args.in[18]; F.gn_b_b = args.in[19]; F.ln_g = args.in[20]; F.ln_b = args.in[21];
    F.out = args.out; unsigned char* ws = args.ws;
    F.XB = (bf16*)((unsigned char*)args.out + OB_XB); F.WINT = (bf16*)((unsigned char*)args.out + OB_WIN);
    F.ZB = (bf16*)(ws + WS_ZB); F.ZA = (bf16*)(ws + WS_ZA); F.MX = (bf16*)(ws + WS_ZA); F.WOUT = (bf16*)(ws + WS_WOUT); F.ROPE = (f32x2*)(ws + WS_ROPE);
    F.DW = (bf16*)(ws + WS_W); F.UB = (float*)(ws + WS_U); F.AA = (bf16*)(ws + WS_A); F.GATE = (bf16*)(ws + WS_GATE); F.BONUS = (bf16*)(ws + WS_BONUS);
    volatile LAS unsigned* MISC = (volatile LAS unsigned*)(F.lds + MISC_OFF);
    if (F.tid < 32) MISC[F.tid] = 0u;
    __syncthreads();
    unsigned* ctl = (unsigned*)(ws + WS_CTL); F.ctl = ctl;
    XcdBarrier bar = xcd_barrier_post(ctl + CW_BAR, MISC + 8);
    const int lo = args.ph_lo, hi = args.ph_hi;
#define IN(k) (lo <= (k) && (k) < hi)
#define SEAM(k) do { if (IN(k) && IN((k) + 1)) xcd_barrier(bar); } while (0)
    if (IN(0)) for (int rep = 0; rep < REP_P0; ++rep) p0_prologue(F);
    SEAM(0);
    if (IN(1)) for (int rep = 0; rep < REP_P1; ++rep) { pg8::Gemm g{F.XB, F.WINT, MPAD, NPAD, D_MODEL}; pg8::StaticOrder S; S.init(MPAD, NPAD, F.G, F.blk); pg8::EpiZ E{F.ZB, F.ZA};
        pg8::gemm_phase<pg8::EpiZ, pg8::StaticOrder, true, true>(F.lds, g, S, E); }
    SEAM(1);
    if (IN(2)) { for (int rep = 0; rep < REP_P2; ++rep) p2_pre(F); ret_pass1(F, F.UB); }
    SEAM(2);
    if (IN(3)) { for (int rep = 0; rep < REP_P3A; ++rep) p3_rwkv(F); for (int rep = 0; rep < REP_P3B; ++rep) { ret_pass2(F, F.UB); ret_sample(F); } }
    SEAM(3);
    if (IN(4)) for (int rep = 0; rep < REP_P4; ++rep) p4_post(F);
    SEAM(4);
    if (IN(5)) for (int rep = 0; rep < REP_P5; ++rep) { pg8::Gemm g{F.MX, F.WOUT, MPAD, D_MODEL, D_MODEL}; pg8::StaticOrder S; S.init(MPAD, D_MODEL, F.G, F.blk); pg8::EpiY E{F.x_prompt, F.x_sample, F.out, ALPHA};
        pg8::gemm_phase<pg8::EpiY, pg8::StaticOrder, true, true>(F.lds, g, S, E); }
    SEAM(5);
    if (IN(6)) p6_ln(F);
#undef IN
#undef SEAM
}

extern "C" void kernel_launch(void* const* d_in, const int* in_sizes, int n_in, void* d_out, int out_size, void* d_ws, size_t ws_size, hipStream_t stream) {
    static int grid = 0;
    if (grid == 0) {
        if (n_in != 22 || (size_t)out_size != O_END || ws_size < WS_END) { fprintf(stderr, "kernel_launch: unexpected shapes (n_in %d, out %d, ws %zu, need %zu); nothing launched\n", n_in, out_size, ws_size, (size_t)WS_END); grid = -1; return; }
        int dev = 0, cus = 0, per_cu = 0;
        if (hipGetDevice(&dev) != hipSuccess || hipDeviceGetAttribute(&cus, hipDeviceAttributeMultiprocessorCount, dev) != hipSuccess) { grid = -1; return; }
        if (hipFuncSetAttribute((const void*)hymba_fwd, hipFuncAttributeMaxDynamicSharedMemorySize, LDS_BYTES) != hipSuccess) { fprintf(stderr, "kernel_launch: hipFuncSetAttribute failed\n"); grid = -1; return; }
        if (hipOccupancyMaxActiveBlocksPerMultiprocessor(&per_cu, (const void*)hymba_fwd, 512, LDS_BYTES) != hipSuccess || per_cu < 1) fprintf(stderr, "kernel_launch: occupancy query reports %d\n", per_cu);
        (void)hipGetLastError();
        grid = cus;
        if (grid != 256) fprintf(stderr, "kernel_launch: %d CUs; this kernel is laid out for 256\n", grid);
    }
    if (grid != 256) return;
    (void)hipMemsetAsync((char*)d_ws + WS_CTL, 0, CTL_ZERO_BYTES, stream);
    Args a{};
    for (int i = 0; i < 22; ++i) a.in[i] = (const float*)d_in[i];
    a.out = (float*)d_out; a.ws = (unsigned char*)d_ws;
#if MK_LAUNCHES == 1
    a.ph_lo = 0; a.ph_hi = N_PHASES;
    hipLaunchKernelGGL(hymba_fwd, dim3(grid), dim3(512), LDS_BYTES, stream, a);
#else
    for (int p = 0; p < N_PHASES; ++p) { a.ph_lo = p; a.ph_hi = p + 1; hipLaunchKernelGGL(hymba_fwd, dim3(grid), dim3(512), LDS_BYTES, stream, a); }
#endif
}
```

```cpp
#include <hip/hip_runtime.h>
#include <cstdio>
#include <cstdint>
#ifndef MK_LAUNCHES
#define MK_LAUNCHES 1
#endif
#define REP_P0 1
#define REP_P1 1
#define REP_P2 1
#define REP_P3A 1
#define REP_P3B 1
#define REP_P4 1
#define REP_P5 1
#define REP_LOADER 1
#define REP_SCANNER 1
#define PROBE_SEL 0
#define PROBE_WAVE 0
#if PROBE_SEL
#define PROBE_VMWAIT() asm volatile("s_waitcnt vmcnt(0)" ::: "memory")
#define PROBE_DECL() unsigned long long pt_[6] = {0, 0, 0, 0, 0, 0}, pacc_[6] = {0, 0, 0, 0, 0, 0}; const unsigned long long pt0_ = __builtin_readcyclecounter(); pt_[5] = pt0_
#define PROBE_T(k) do { const unsigned long long n_ = __builtin_readcyclecounter(); pacc_[k] += n_ - pt_[5]; pt_[5] = n_; } while (0)
#define PROBE_END(w) do { if (F.blk == 37 && wave == (w) && (w) == PROBE_WAVE && lane == 0) { const unsigned long long tot_ = __builtin_readcyclecounter() - pt0_; \
    const float fr_ = PROBE_SEL == 9 ? (float)tot_ * 1e-6f : (float)pacc_[PROBE_SEL] / (float)tot_; __hip_atomic_store((float*)(F.ctl + 32), fr_, __ATOMIC_RELAXED, __HIP_MEMORY_SCOPE_AGENT); } } while (0)
#else
#define PROBE_VMWAIT() do {} while (0)
#define PROBE_DECL() do {} while (0)
#define PROBE_T(k) do {} while (0)
#define PROBE_END(w) do {} while (0)
#endif
__device__ const double ROPE_INV[64] = { 1, 0.86596432336006535, 0.74989420933245587, 0.64938163157621132, 0.56234132519034907, 0.48696752516586311, 0.42169650342858223, 0.36517412725483772, 0.31622776601683794, 0.27384196342643613, 0.23713737056616552, 0.20535250264571461, 0.17782794100389229, 0.15399265260594919, 0.1333521432163324, 0.11547819846894582, 0.10000000000000001, 0.086596432336006529, 0.074989420933245579, 0.064938163157621132, 0.056234132519034911, 0.048696752516586311, 0.042169650342858224, 0.036517412725483769, 0.031622776601683791, 0.027384196342643614, 0.023713737056616554, 0.02053525026457146, 0.017782794100389229, 0.015399265260594919, 0.013335214321633241, 0.011547819846894581, 0.01, 0.0086596432336006543, 0.0074989420933245579, 0.006493816315762113, 0.005623413251903491, 0.004869675251658631, 0.0042169650342858229, 0.0036517412725483771, 0.0031622776601683794, 0.0027384196342643613, 0.0023713737056616554, 0.002053525026457146, 0.0017782794100389228, 0.001539926526059492, 0.0013335214321633241, 0.0011547819846894581, 0.001, 0.00086596432336006539, 0.00074989420933245586, 0.00064938163157621134, 0.0005623413251903491, 0.0004869675251658631, 0.00042169650342858224, 0.0003651741272548377, 0.00031622776601683794, 0.00027384196342643611, 0.00023713737056616554, 0.00020535250264571461, 0.00017782794100389227, 0.00015399265260594919, 0.0001333521432163324, 0.00011547819846894582 };
namespace pg8 {
#define PG8_LAS __attribute__((address_space(3)))
typedef unsigned short bf16_t;
typedef short bf16x8 __attribute__((ext_vector_type(8)));
typedef float f32x4 __attribute__((ext_vector_type(4)));
typedef unsigned u32x4 __attribute__((ext_vector_type(4)));
constexpr int BM = 256, BK = 64, HALF = 128, HTB = HALF * BK * 2  , STAGE_BYTES = 8 * HTB, NXCD = 8, WGM = 8;

__host__ __device__ __forceinline__ int lds_byte(int r, int c) { const int st = (r >> 4) * 2 + (c >> 5), rr = r & 15, cc = c & 31, ob = rr * 64 + cc * 2; return st * 1024 + (ob ^ (((ob >> 9) & 1) << 5)); }
__host__ __device__ __forceinline__ void stage_rc(int b, int& R, int& C) { const int st = b / 1024, sb = b % 1024, swz = sb ^ (((sb >> 9) & 1) << 5); R = (st >> 1) * 16 + swz / 64; C = (st & 1) * 32 + (swz % 64) / 2; }
__host__ __device__ __forceinline__ int perm32(int rho) { const int n = rho >> 4, i = rho & 15; return 8 * (i >> 2) + 4 * n + (i & 3); }

struct Unit { int pm, pn; };
struct Gemm { const bf16_t* A; const bf16_t* Bt; int M, N, K; };

struct StaticOrder {
    int nM, nN, nwg, G, c;
    __host__ __device__ void init(int M, int N, int G_, int c_) { nM = M / BM; nN = N / BM; nwg = nM * nN; G = G_; c = c_; }
    __host__ __device__ bool next(int i, Unit& u) const {
        const long L = (long)i * G + c; if (L >= nwg) return false;
        int wgid = (int)L; { const int q = nwg / NXCD, r = nwg % NXCD, xcd = wgid % NXCD, off = wgid / NXCD; wgid = (xcd < r ? xcd * (q + 1) : r * (q + 1) + (xcd - r) * q) + off; }
        const int nig = WGM * nN, gid = wgid / nig, fm = gid * WGM, gsz = (nM - fm) < WGM ? (nM - fm) : WGM;
        u.pm = fm + ((wgid % nig) % gsz); u.pn = (wgid % nig) / gsz; return true;
    }
    __device__ __forceinline__ void a_ready(const Unit&) const {}
    __device__ __forceinline__ void done(const Unit&) const {}
};

__device__ __forceinline__ unsigned cvt_pk_bf16(float lo, float hi) { unsigned r; asm volatile("v_cvt_pk_bf16_f32 %0, %1, %2" : "=v"(r) : "v"(lo), "v"(hi)); return r; }
typedef float f32x2 __attribute__((ext_vector_type(2)));

struct EpiZ {
    static constexpr bool PERM = true, AFTER_DRAIN = false;
    bf16_t* ZB; bf16_t* ZA;
    __device__ __forceinline__ void operator()(const f32x4 (&acc)[2][2][4][2], const Unit& u, int wr, int wc, int fr, int fq) const {
        const int row0 = u.pm * BM + wr * 64 + fr;
        bf16_t* base; int ldc, colt;
        if (u.pn < 16) { base = ZB; ldc = 4096; colt = u.pn * BM; } else { base = ZA; ldc = 4352; colt = (u.pn - 16) * BM; }
        const int col0 = colt + wc * 32 + 8 * fq;
#pragma unroll
        for (int ai = 0; ai < 2; ++ai)
#pragma unroll
            for (int m = 0; m < 4; ++m) { const int row = row0 + ai * HALF + m * 16; bf16_t* rowp = base + (size_t)row * ldc + col0;
                if (row < 9280)
#pragma unroll
                for (int bj = 0; bj < 2; ++bj) { const f32x4 v0 = acc[ai][bj][m][0], v1 = acc[ai][bj][m][1];
                    u32x4 w; w.x = cvt_pk_bf16(v0[0], v0[1]); w.y = cvt_pk_bf16(v0[2], v0[3]); w.z = cvt_pk_bf16(v1[0], v1[1]); w.w = cvt_pk_bf16(v1[2], v1[3]);
                    *(u32x4*)(rowp + bj * HALF) = w; } }
    }
};
struct EpiY {
    static constexpr bool PERM = false, AFTER_DRAIN = false;
    const float* xp; const float* xs; float* out; float alpha;
    __device__ __forceinline__ void operator()(const f32x4 (&acc)[2][2][4][2], const Unit& u, int wr, int wc, int fr, int fq) const {
#pragma unroll
        for (int ai = 0; ai < 2; ++ai)
#pragma unroll
            for (int m = 0; m < 4; ++m) {
                const int zrow = u.pm * BM + ai * HALF + wr * 64 + m * 16 + fr; int yrow = -1;
                if (zrow < 8256) { const int b = zrow / 2064, t = zrow - b * 2064; if (t >= 16) yrow = b * 2048 + t - 16; }
                else if (zrow < 9280) yrow = zrow - 64;
                if (yrow >= 0) {
                    const float* xsrc = yrow < 8192 ? xp + (size_t)yrow * 2048 : xs + (size_t)(yrow - 8192) * 2048; float* o = out + (size_t)yrow * 2048;
#pragma unroll
                    for (int bj = 0; bj < 2; ++bj)
#pragma unroll
                        for (int n = 0; n < 2; ++n) { const int col = u.pn * BM + bj * HALF + wc * 32 + n * 16 + 4 * fq;
                            const f32x4 xv = *(const f32x4*)(xsrc + col); *(f32x4*)(o + col) = xv * alpha + acc[ai][bj][m][n]; }
                }
            }
    }
};
template <class Epi, class Sched, bool ALIGN_EPI = false, bool SP2 = false>
__device__ __forceinline__ void gemm_phase(PG8_LAS unsigned char* lds, const Gemm g, const Sched& S, const Epi& E) {
    const int tid = threadIdx.x, wid = __builtin_amdgcn_readfirstlane(tid >> 6), lane = tid & 63, wr = wid >> 2, wc = wid & 3, fr = lane & 15, fq = lane >> 4;
    const int K = g.K, nt = K / BK;
    unsigned voffA[2], voffB[2];
#pragma unroll
    for (int i = 0; i < 2; ++i) { int R, C; stage_rc(tid * 16 + i * 8192, R, C); const int Rb = Epi::PERM ? ((R & ~31) + perm32(R & 31)) : R;
        voffA[i] = (unsigned)(R * K + C) * 2u; voffB[i] = (unsigned)(Rb * K + C) * 2u; }
    const size_t kstep = (size_t)(BK * 2);
    const size_t hstep = (size_t)HALF * K * 2;
    const size_t tstep = 2 * hstep;
    const unsigned ldsw = (unsigned)wid * 1024u;
    const int aoff = lds_byte(wr * 64 + fr, fq * 8), boff = lds_byte(wc * 32 + fr, fq * 8);
#define PG8_SA(b, h) (((b) * 2 + (h)) * HTB)
#define PG8_SB(b, h) ((4 + (b) * 2 + (h)) * HTB)
#define PG8_STAGE(bufoff, gbase, voff) do { _Pragma("unroll") for (int _i = 0; _i < 2; ++_i) \
        __builtin_amdgcn_global_load_lds((const unsigned*)((const char*)(gbase) + (voff)[_i]), (PG8_LAS unsigned*)(lds + (bufoff) + ldsw + _i * 8192), 16, 0, 0); } while (0)
#define PG8_LDA(dst, b, h) do { _Pragma("unroll") for (int m = 0; m < 4; ++m) _Pragma("unroll") for (int k = 0; k < 2; ++k) dst[m][k] = *(const PG8_LAS bf16x8*)(lds + PG8_SA(b, h) + aoff + m * 2048 + k * 1024); } while (0)
#define PG8_LDB(dst, b, h) do { _Pragma("unroll") for (int n = 0; n < 2; ++n) _Pragma("unroll") for (int k = 0; k < 2; ++k) dst[n][k] = *(const PG8_LAS bf16x8*)(lds + PG8_SB(b, h) + boff + n * 2048 + k * 1024); } while (0)
#define PG8_MMA(ai, bj, At, Bt) do { __builtin_amdgcn_s_setprio(1); _Pragma("unroll") for (int m = 0; m < 4; ++m) _Pragma("unroll") for (int n = 0; n < 2; ++n) _Pragma("unroll") for (int k = 0; k < 2; ++k) \
        acc[ai][bj][m][n] = __builtin_amdgcn_mfma_f32_16x16x32_bf16(Bt[n][k], At[m][k], acc[ai][bj][m][n], 0, 0, 0); __builtin_amdgcn_s_setprio(0); } while (0)
#define PG8_WAIT_V(n) asm volatile("s_waitcnt vmcnt(" #n ")" ::: "memory")
#define PG8_WAIT_L(n) asm volatile("s_waitcnt lgkmcnt(" #n ")" ::: "memory")
#define PG8_BAR __builtin_amdgcn_s_barrier()
#define PG8_SCHED __builtin_amdgcn_sched_barrier(0)
    Unit cur, nxt; int ui = 0;
    if (!S.next(0, cur)) return;
    f32x4 acc[2][2][4][2];
#pragma unroll
    for (int a = 0; a < 2; ++a)
#pragma unroll
        for (int b = 0; b < 2; ++b)
#pragma unroll
            for (int m = 0; m < 4; ++m)
#pragma unroll
                for (int n = 0; n < 2; ++n) acc[a][b][m][n] = (f32x4){0.f, 0.f, 0.f, 0.f};
    bf16x8 At[4][2], B0[2][2], B1[2][2];
    const char* cA = (const char*)g.A + (size_t)cur.pm * tstep; const char* cB = (const char*)g.Bt + (size_t)cur.pn * tstep;
    S.a_ready(cur);
    if constexpr (SP2) {
        PG8_STAGE(PG8_SB(0, 0), cB, voffB); PG8_STAGE(PG8_SB(0, 1), cB + hstep, voffB); PG8_STAGE(PG8_SA(0, 0), cA, voffA); PG8_STAGE(PG8_SA(0, 1), cA + hstep, voffA);
        if (wr == 1) PG8_BAR;
        PG8_WAIT_V(2); PG8_BAR;
        PG8_STAGE(PG8_SB(1, 0), cB + kstep, voffB); PG8_STAGE(PG8_SA(1, 0), cA + kstep, voffA); PG8_STAGE(PG8_SB(1, 1), cB + hstep + kstep, voffB);
        PG8_WAIT_V(6); PG8_BAR;
    } else {
        PG8_STAGE(PG8_SB(0, 0), cB, voffB); PG8_STAGE(PG8_SA(0, 0), cA, voffA); PG8_STAGE(PG8_SB(0, 1), cB + hstep, voffB); PG8_STAGE(PG8_SA(0, 1), cA + hstep, voffA);
        if (wr == 1) PG8_BAR;
        PG8_WAIT_V(4); PG8_BAR;
        PG8_STAGE(PG8_SB(1, 0), cB + kstep, voffB); PG8_STAGE(PG8_SA(1, 0), cA + kstep, voffA); PG8_STAGE(PG8_SB(1, 1), cB + hstep + kstep, voffB);
        PG8_WAIT_V(6); PG8_BAR;
    }
    for (;;) {
        const bool has_next = S.next(ui + 1, nxt);
        const char* nA = has_next ? (const char*)g.A + (size_t)nxt.pm * tstep : cA; const char* nB = has_next ? (const char*)g.Bt + (size_t)nxt.pn * tstep : cB;
        for (int t = 0; t < nt; t += 2) {
            const bool last = (t == nt - 2);
            const char* a1 = cA + (size_t)(t + 1) * kstep;
            const char* a2 = last ? nA : cA + (size_t)(t + 2) * kstep; const char* b2 = last ? nB : cB + (size_t)(t + 2) * kstep;
            const char* a3 = a2 + kstep; const char* b3 = b2 + kstep;
            if (last && has_next) S.a_ready(nxt);
            if constexpr (SP2) {
            PG8_LDB(B0, 0, 0); PG8_LDB(B1, 0, 1); PG8_SCHED; PG8_LDA(At, 0, 0); PG8_STAGE(PG8_SA(1, 1), a1 + hstep, voffA);
            PG8_WAIT_V(8); PG8_WAIT_L(0); PG8_BAR; PG8_MMA(0, 0, At, B0); PG8_MMA(0, 1, At, B1); PG8_BAR; PG8_SCHED;
            PG8_LDA(At, 0, 1); PG8_STAGE(PG8_SB(0, 0), b2, voffB); PG8_STAGE(PG8_SB(0, 1), b2 + hstep, voffB); PG8_STAGE(PG8_SA(0, 0), a2, voffA);
            PG8_WAIT_V(8); PG8_WAIT_L(0); PG8_BAR; PG8_MMA(1, 0, At, B0); PG8_MMA(1, 1, At, B1); PG8_BAR; PG8_SCHED;
            PG8_LDB(B0, 1, 0); PG8_LDB(B1, 1, 1); PG8_SCHED; PG8_LDA(At, 1, 0); PG8_STAGE(PG8_SA(0, 1), a2 + hstep, voffA);
            PG8_WAIT_V(8); PG8_WAIT_L(0); PG8_BAR; PG8_MMA(0, 0, At, B0); PG8_MMA(0, 1, At, B1); PG8_BAR; PG8_SCHED;
            PG8_LDA(At, 1, 1); PG8_STAGE(PG8_SB(1, 0), b3, voffB); PG8_STAGE(PG8_SB(1, 1), b3 + hstep, voffB); PG8_STAGE(PG8_SA(1, 0), a3, voffA);
            PG8_WAIT_V(8); PG8_WAIT_L(0); PG8_BAR; PG8_MMA(1, 0, At, B0); PG8_MMA(1, 1, At, B1); PG8_BAR; PG8_SCHED;
            } else {
            PG8_LDB(B0, 0, 0); PG8_SCHED; PG8_LDA(At, 0, 0); PG8_STAGE(PG8_SA(1, 1), a1 + hstep, voffA);
            PG8_WAIT_L(8); PG8_BAR; PG8_WAIT_L(0); PG8_MMA(0, 0, At, B0); PG8_BAR; PG8_SCHED;
            PG8_LDB(B1, 0, 1); PG8_STAGE(PG8_SB(0, 0), b2, voffB);
            PG8_BAR; PG8_WAIT_L(0); PG8_MMA(0, 1, At, B1); PG8_BAR;
            PG8_LDA(At, 0, 1); PG8_STAGE(PG8_SA(0, 0), a2, voffA);
            PG8_BAR; PG8_WAIT_L(0); PG8_MMA(1, 0, At, B0); PG8_BAR; PG8_SCHED;
            PG8_STAGE(PG8_SB(0, 1), b2 + hstep, voffB);
            PG8_WAIT_V(6); PG8_BAR; PG8_MMA(1, 1, At, B1); PG8_BAR;
            PG8_LDB(B0, 1, 0); PG8_SCHED; PG8_LDA(At, 1, 0); PG8_STAGE(PG8_SA(0, 1), a2 + hstep, voffA);
            PG8_WAIT_L(8); PG8_BAR; PG8_WAIT_L(0); PG8_MMA(0, 0, At, B0); PG8_BAR; PG8_SCHED;
            PG8_LDB(B1, 1, 1); PG8_STAGE(PG8_SB(1, 0), b3, voffB);
            PG8_BAR; PG8_WAIT_L(0); PG8_MMA(0, 1, At, B1); PG8_BAR;
            PG8_LDA(At, 1, 1); PG8_STAGE(PG8_SA(1, 0), a3, voffA);
            PG8_BAR; PG8_WAIT_L(0); PG8_MMA(1, 0, At, B0); PG8_BAR; PG8_SCHED;
            PG8_STAGE(PG8_SB(1, 1), b3 + hstep, voffB);
            PG8_WAIT_V(6); PG8_BAR; PG8_MMA(1, 1, At, B1); PG8_BAR;
            }
        }
        if constexpr (ALIGN_EPI) { if (wr == 0) PG8_BAR; }
        if constexpr (!Epi::AFTER_DRAIN) { E(acc, cur, wr, wc, fr, fq); S.done(cur); }
        if (!has_next) break;
#pragma unroll
        for (int a = 0; a < 2; ++a)
#pragma unroll
            for (int b = 0; b < 2; ++b)
#pragma unroll
                for (int m = 0; m < 4; ++m)
#pragma unroll
                    for (int n = 0; n < 2; ++n) acc[a][b][m][n] = (f32x4){0.f, 0.f, 0.f, 0.f};
        cur = nxt; cA = nA; cB = nB; ++ui;
        if constexpr (ALIGN_EPI) { if (wr == 1) PG8_BAR; }
    }
    PG8_WAIT_V(0);
    if constexpr (!ALIGN_EPI) { if (wr == 0) PG8_BAR; }
    PG8_BAR;
    if constexpr (Epi::AFTER_DRAIN) { E.fused(acc, cur, wr, wc, fr, fq, lds, wid, lane); S.done(cur); }
#undef PG8_SA
#undef PG8_SB
#undef PG8_STAGE
#undef PG8_LDA
#undef PG8_LDB
#undef PG8_MMA
#undef PG8_WAIT_V
#undef PG8_WAIT_L
#undef PG8_BAR
#undef PG8_SCHED
}
}

#define LAS __attribute__((address_space(3)))
#define XB_TMO      128
#define XB_XCNT(j)  (256  + 64 * (j))
#define XB_XSUB(j)  (1280 + 64 * (j))
#define XB_XGEN(j)  (2304 + 64 * (j))
#define XB_TOP      3328
#define XB_TOPGEN   3392
#define XCD_BAR_WORDS 3456
#define XB_SPIN_CAP (1u << 18)

__device__ __forceinline__ unsigned xb_ld(unsigned* p)              { return __hip_atomic_load(p, __ATOMIC_RELAXED, __HIP_MEMORY_SCOPE_AGENT); }
__device__ __forceinline__ unsigned xb_add(unsigned* p, unsigned v) { return __hip_atomic_fetch_add(p, v, __ATOMIC_RELAXED, __HIP_MEMORY_SCOPE_AGENT); }
__device__ __forceinline__ unsigned xb_xcc_id() { return (unsigned)__builtin_amdgcn_s_getreg((3 << 11) | 20) & 0xFu; }
#define XB_SPIN(cond, bar) do { unsigned _sp = 0; while (cond) { __builtin_amdgcn_s_sleep(1); \
    if ((++_sp & 255u) == 0u) { if (xb_ld(&(bar)[XB_TMO])) break; if (_sp > XB_SPIN_CAP) { atomicAdd(&(bar)[XB_TMO], 1u); break; } } } } while (0)

struct XcdBarrier {
    unsigned* bar; unsigned x;
    volatile LAS unsigned* st;
};

__device__ __forceinline__ XcdBarrier xcd_barrier_post(unsigned* bar, volatile LAS unsigned* st) {
    XcdBarrier b; b.bar = bar; b.x = xb_xcc_id(); b.st = st;
    if (threadIdx.x == 0) (void)xb_add(&bar[XB_XCNT(b.x)], 1u);
    return b;
}
__device__ __forceinline__ void xcd_barrier_complete(unsigned* bar, unsigned x, unsigned& nloc, unsigned& nx) {
    const unsigned G = gridDim.x * gridDim.y * gridDim.z;
    unsigned sum, cnt, mine, sp = 0u;
    for (;;) {
        sum = 0u; cnt = 0u; mine = 0u;
#pragma unroll
        for (unsigned j = 0; j < 16; ++j) { const unsigned c = xb_ld(&bar[XB_XCNT(j)]); sum += c; cnt += (c > 0u) ? 1u : 0u; mine = (j == x) ? c : mine; }
        if (sum == G) break;
        __builtin_amdgcn_s_sleep(1);
        if ((++sp & 255u) == 0u) { if (xb_ld(&bar[XB_TMO])) break; if (sp > XB_SPIN_CAP) { atomicAdd(&bar[XB_TMO], 1u); break; } }
    }
    nloc = mine > 0u ? mine : 1u; nx = cnt > 0u ? cnt : 1u;
}

__device__ __forceinline__ void xcd_barrier(const XcdBarrier& b) {
    asm volatile("s_waitcnt vmcnt(0)" ::: "memory");
    __syncthreads();
    if (threadIdx.x == 0) {
        unsigned* bar = b.bar;
        __builtin_amdgcn_s_waitcnt(0);
        unsigned nloc = b.st[0], nx = b.st[1];
        if (nloc == 0u) { xcd_barrier_complete(bar, b.x, nloc, nx); b.st[0] = nloc; b.st[1] = nx; }
        const unsigned old = xb_add(&bar[XB_XSUB(b.x)], 1u);
        const unsigned gen = old / nloc;
        if (old + 1u == (gen + 1u) * nloc) {
            __builtin_amdgcn_fence(__ATOMIC_RELEASE, "agent");
            asm volatile("s_waitcnt vmcnt(0)" ::: "memory");
            const unsigned og = xb_add(&bar[XB_TOP], 1u);
            const unsigned tg = og / nx;
            if (og + 1u == (tg + 1u) * nx) xb_add(&bar[XB_TOPGEN], 1u);
            else XB_SPIN(xb_ld(&bar[XB_TOPGEN]) == tg, bar);
            __builtin_amdgcn_fence(__ATOMIC_ACQUIRE, "agent");
            xb_add(&bar[XB_XGEN(b.x)], 1u);
            asm volatile("s_waitcnt vmcnt(0)" ::: "memory");
        } else {
            XB_SPIN(xb_ld(&bar[XB_XGEN(b.x)]) == gen, bar);
            __builtin_amdgcn_fence(__ATOMIC_ACQUIRE, "agent");
            asm volatile("s_waitcnt vmcnt(0)" ::: "memory");
        }
    }
    __syncthreads();
}

constexpr int D_MODEL = 2048, TP = 2064  , MPR = 4 * TP  , MSA = 1024, MROWS = MPR + MSA  , MPAD = 9472;
constexpr int NA = 4224, NAP = 4352, NB = 4096, NPAD = NAP + NB  , YROWS = 9216;
constexpr float ALPHA = 1.189207115002721f;
constexpr float LN_EPS = 1e-5f, GN_EPS_A = 64e-5f, GN_EPS_B = 1e-5f;
constexpr size_t O_YP = 0, O_YS = 16777216, O_RWKVP = 18874368, O_SHIFTP = 19136512, O_RETP = 19153408, O_RWKVS = 19677696, O_SHIFTS = 28066304, O_RETS = 28606976, O_END = 45384192;
constexpr size_t WS_CTL = 0, CTL_ZERO_BYTES = 1u << 20;
constexpr size_t WS_ZB = 1u << 20;
constexpr size_t WS_ZA = WS_ZB + (size_t)MPAD * NB * 2;
constexpr size_t WS_WOUT = WS_ZA + (size_t)MPAD * NAP * 2;
constexpr size_t WS_ROPE = WS_WOUT + (size_t)2048 * 2048 * 2;
constexpr size_t WS_GATE = WS_ROPE + (size_t)2072 * 64 * 8;
constexpr size_t WS_BONUS = WS_GATE + (size_t)MROWS * 1024 * 2;
constexpr size_t WS_U = WS_BONUS + (size_t)MROWS * 1024 * 2;
constexpr size_t WS_LORA = WS_U + (size_t)256 * 16384 * 4;
constexpr int IMG_ROW = 16 * 6 * 64 * 2;
constexpr int IMG_SPLIT = 5461;
constexpr size_t WS_IMG2 = WS_LORA + 2 * 1024 * 64 * 2;
constexpr size_t WS_END = WS_IMG2 + (size_t)(MROWS - IMG_SPLIT) * IMG_ROW;
static_assert(WS_END <= 272629760, "d_ws map must fit 4 x the largest tensor");
static_assert((size_t)IMG_SPLIT * IMG_ROW <= 16777216ull * 4, "image part 1 must fit the ret_s region");
constexpr size_t OB_XB = 0;
constexpr size_t OB_WIN = O_RETS * 4;

constexpr int LDS_BYTES = 147456, MISC_OFF = 131072 + 320;
constexpr int CW_BAR = 4096;


typedef unsigned short bf16;
typedef unsigned v4u __attribute__((ext_vector_type(4)));
typedef unsigned v2u __attribute__((ext_vector_type(2)));
typedef float f32x4 __attribute__((ext_vector_type(4)));
typedef float f32x2 __attribute__((ext_vector_type(2)));
#define LDS_WAIT() asm volatile("s_waitcnt lgkmcnt(0)" ::: "memory")
__device__ __forceinline__ float bf2f(unsigned b) { return __uint_as_float(b << 16); }
__device__ __forceinline__ unsigned f2bf(float f) { unsigned u = __float_as_uint(f); return (u + 0x7fffu + ((u >> 16) & 1u)) >> 16; }
__device__ __forceinline__ unsigned pk2(float lo, float hi) { return f2bf(lo) | (f2bf(hi) << 16); }
__device__ __forceinline__ unsigned cvtpk(float lo, float hi) { unsigned r; asm("v_cvt_pk_bf16_f32 %0, %1, %2" : "=v"(r) : "v"(lo), "v"(hi)); return r; }
__device__ __forceinline__ float sigmoidf_(float x) { return __builtin_amdgcn_rcpf(1.0f + __expf(-x)); }
__device__ __forceinline__ float tanh_(float x) { return 1.0f - 2.0f * __builtin_amdgcn_rcpf(1.0f + __expf(2.0f * x)); }

template <int CTRL> __device__ __forceinline__ float dpp_f(float x) { return __builtin_bit_cast(float, __builtin_amdgcn_update_dpp(0, __builtin_bit_cast(int, x), CTRL, 0xf, 0xf, true)); }
__device__ __forceinline__ float allreduce4(float v) { v += dpp_f<0xB1>(v); v += dpp_f<0x4E>(v); return v; }
__device__ __forceinline__ float allreduce8(float v) { v = allreduce4(v); v += dpp_f<0x141>(v); return v; }
__device__ __forceinline__ float allreduce16(float v) { v = allreduce8(v); v += dpp_f<0x140>(v); return v; }
__device__ __forceinline__ float allreduce64(float v) { v = allreduce16(v); v += __shfl_xor(v, 16); v += __shfl_xor(v, 32); return v; }
__device__ __forceinline__ float reduce63(float v) {
    v = allreduce16(v);
    v += __builtin_bit_cast(float, __builtin_amdgcn_update_dpp(0, __builtin_bit_cast(int, v), 0x142, 0xa, 0xf, false));
    v += __builtin_bit_cast(float, __builtin_amdgcn_update_dpp(0, __builtin_bit_cast(int, v), 0x143, 0xc, 0xf, false));
    return v;
}

struct Args { const float* in[22]; float* out; unsigned char* ws; int ph_lo, ph_hi; };

struct Frame {
    LAS unsigned char* lds;
    int tid, lane, wave, G, blk;
    const float *x_prompt, *x_sample, *state_rwkv, *state_shift, *state_ret, *meta, *w_in, *w_out, *shift_mix, *w0, *w_up, *a0, *a_up, *k_k, *k_a, *r_k, *gn_a_g, *gn_a_b, *gn_b_g, *gn_b_b, *ln_g, *ln_b;
    float* out;
    bf16 *XB, *WINT, *ZB, *ZA, *MX, *WOUT, *GATE, *BONUS, *WUPT, *AUPT; unsigned char *IMG1, *IMG2;
    float *UB; f32x2* ROPE; unsigned* ctl;
};

__device__ __forceinline__ void p0_transpose_item(const float* W, int ldw, int k0, int srccol0, bf16* WT, int K, int dstrow0, LAS float* scr, int lane) {
#pragma unroll 8
    for (int i = 0; i < 32; ++i) { const int kk = 2 * i + (lane >> 5); scr[kk * 33 + (lane & 31)] = W[(size_t)(k0 + kk) * ldw + srccol0 + (lane & 31)]; }
    LDS_WAIT(); asm volatile("" ::: "memory");
    const int c = lane & 7;
#pragma unroll
    for (int j = 0; j < 4; ++j) { const int n = (lane >> 3) + 8 * j; const LAS float* s = scr + (8 * c) * 33 + n;
        v4u o; o.x = pk2(s[0 * 33], s[1 * 33]); o.y = pk2(s[2 * 33], s[3 * 33]); o.z = pk2(s[4 * 33], s[5 * 33]); o.w = pk2(s[6 * 33], s[7 * 33]);
        *(v4u*)(WT + (size_t)(dstrow0 + n) * K + k0 + 8 * c) = o; }
    LDS_WAIT(); asm volatile("" ::: "memory");
}
__device__ __forceinline__ void p0_prologue(const Frame& F) {
    LAS float* scr = (LAS float*)(F.lds + F.wave * 16384);
    const int gw = F.blk * 8 + F.wave, NGW = F.G * 8;
    constexpr int I_IN = 32 * 260, I_OUT = 32 * 64;
    for (int it = gw; it < I_IN + I_OUT; it += NGW) {
        if (it < I_IN) { const int kb = it / 260, nb = it % 260, d0 = 32 * nb, s0 = d0 < 4096 ? 4224 + d0 : d0 - 4096;
            p0_transpose_item(F.w_in, 8320, 64 * kb, s0, F.WINT, 2048, d0, scr, F.lane); }
        else { const int r = it - I_IN, kb = r / 64, nb = r % 64;
            p0_transpose_item(F.w_out, 2048, 64 * kb, 32 * nb, F.WOUT, 2048, 32 * nb, scr, F.lane); }
    }
    { v4u z = {0u, 0u, 0u, 0u}; v4u* p = (v4u*)(F.WINT + (size_t)8320 * 2048);
      for (int i = F.blk * 512 + F.tid; i < 128 * 2048 * 2 / 16; i += F.G * 512) p[i] = z; }
    for (int i = F.blk * 512 + F.tid; i < 129 * NAP; i += F.G * 512) { const int s = i / NAP, c = i - s * NAP;
        F.ZA[(size_t)(MROWS + s) * NAP + c] = (s < 128 && c < NA) ? (bf16)f2bf(F.state_shift[(size_t)s * NA + c]) : (bf16)0; }
    for (int i = F.blk * 512 + F.tid; i < 2 * 1024 * 64; i += F.G * 512) { const int m = i >> 16, c = (i >> 6) & 1023, k = i & 63;
        (m ? F.AUPT : F.WUPT)[c * 64 + k] = (bf16)f2bf((m ? F.a_up : F.w_up)[k * 1024 + c]); }
    for (int m = gw; m < MPAD; m += NGW) {
        const float* src = nullptr;
        if (m < MPR) { const int b = m / TP, t = m - b * TP; src = t < 16 ? F.meta + (size_t)t * 2048 : F.x_prompt + ((size_t)b * 2048 + (t - 16)) * 2048; }
        else if (m < MROWS) src = F.x_sample + (size_t)(m - MPR) * 2048;
        v2u* dst = (v2u*)(F.XB + (size_t)m * 2048);
#pragma unroll
        for (int j = 0; j < 8; ++j) { f32x4 v = {0.f, 0.f, 0.f, 0.f}; if (src) v = ((const f32x4*)src)[F.lane + 64 * j];
            v2u o; o.x = pk2(v.x, v.y); o.y = pk2(v.z, v.w); dst[F.lane + 64 * j] = o; }
    }
    for (int i = F.blk * 512 + F.tid; i < 2072 * 64; i += F.G * 512) {
        const int p = i >> 6, f = i & 63; const int pos = p < 2064 ? p : 16384 + (p - 2064);
        const double x = (double)pos * ROPE_INV[f];
        const double n = __builtin_rint(x * 0.15915494309189535);
        double r = __builtin_fma(-n, 6.283185307179586, x); r = __builtin_fma(-n, 2.4492935982947064e-16, r);
        const double r2 = r * r; double s = 1.0, c = 1.0;
#pragma unroll
        for (int k = 12; k >= 1; --k) { s = 1.0 - s * r2 * (1.0 / (double)((2 * k) * (2 * k + 1))); c = 1.0 - c * r2 * (1.0 / (double)((2 * k - 1) * (2 * k))); }
        f32x2 o; o.x = (float)c; o.y = (float)(r * s); F.ROPE[i] = o;
    }
}

typedef short bf16x8_ __attribute__((ext_vector_type(8)));
__device__ __forceinline__ unsigned char* img_row(const Frame& F, int row) { return row < IMG_SPLIT ? F.IMG1 + (size_t)row * IMG_ROW : F.IMG2 + (size_t)(row - IMG_SPLIT) * IMG_ROW; }
__device__ __forceinline__ f32x4 unpk4(const v2u& u) { f32x4 r; r.x = bf2f(u.x & 0xffffu); r.y = __uint_as_float(u.x & 0xffff0000u); r.z = bf2f(u.y & 0xffffu); r.w = __uint_as_float(u.y & 0xffff0000u); return r; }
__device__ __forceinline__ v2u pk4(const f32x4& v) { v2u o; o.x = cvtpk(v.x, v.y); o.y = cvtpk(v.z, v.w); return o; }
__device__ __forceinline__ f32x4 sig4(const f32x4& x) { f32x4 r; r.x = sigmoidf_(x.x); r.y = sigmoidf_(x.y); r.z = sigmoidf_(x.z); r.w = sigmoidf_(x.w); return r; }
__device__ __forceinline__ void shifted8(const Frame& F, int row, int prow, int col, float (&o)[8]) {
    const v4u c = *(const v4u*)(F.ZA + (size_t)row * NAP + col), p = *(const v4u*)(F.ZA + (size_t)prow * NAP + col); const f32x4 m0 = *(const f32x4*)(F.shift_mix + col), m1 = *(const f32x4*)(F.shift_mix + col + 4);
    v2u a = {c.x, c.y}, b = {c.z, c.w}, pa = {p.x, p.y}, pb = {p.z, p.w}; const f32x4 c0 = unpk4(a), c1 = unpk4(b), p0 = unpk4(pa), p1 = unpk4(pb); const f32x4 r0 = c0 + (p0 - c0) * m0, r1 = c1 + (p1 - c1) * m1;
    o[0] = r0.x; o[1] = r0.y; o[2] = r0.z; o[3] = r0.w; o[4] = r1.x; o[5] = r1.y; o[6] = r1.z; o[7] = r1.w;
}
__device__ __forceinline__ f32x4 shifted4(const Frame& F, int row, int prow, int col) {
    const f32x4 c = unpk4(*(const v2u*)(F.ZA + (size_t)row * NAP + col)), p = unpk4(*(const v2u*)(F.ZA + (size_t)prow * NAP + col));
    return c + (p - c) * *(const f32x4*)(F.shift_mix + col);
}
__device__ __forceinline__ int p2_prow(int row) { int prow = row - 1; if (row < MPR) { if (row % TP == 0) prow = MROWS + 128; } else { const int s = row - MPR; if ((s & 7) == 0) prow = MROWS + (s >> 3); } return prow; }
struct P2Half { f32x4 r, dw, kp, kk, a, v, gt; };
__device__ __forceinline__ void p2_half(const Frame& F, const v2u (&c)[4], const v2u (&p)[4], const f32x4& lgw, const f32x4& lga, int c0, P2Half& H, float& n2, float& cf) {
    const f32x4 cw0 = *(const f32x4*)(F.w0 + c0), ca0 = *(const f32x4*)(F.a0 + c0), ckk = *(const f32x4*)(F.k_k + c0), cka = *(const f32x4*)(F.k_a + c0), crk = *(const f32x4*)(F.r_k + c0),
                m0 = *(const f32x4*)(F.shift_mix + c0), m1 = *(const f32x4*)(F.shift_mix + 1024 + c0), m2 = *(const f32x4*)(F.shift_mix + 2048 + c0), m3 = *(const f32x4*)(F.shift_mix + 3072 + c0);
    const f32x4 cr = unpk4(c[0]), ck = unpk4(c[1]), cv = unpk4(c[2]), cg = unpk4(c[3]);
    const f32x4 r = cr + (unpk4(p[0]) - cr) * m0, k = ck + (unpk4(p[1]) - ck) * m1, v = cv + (unpk4(p[2]) - cv) * m2, gg = cg + (unpk4(p[3]) - cg) * m3;
    const f32x4 lw = sig4(lgw + cw0) * -0.6065306597126334f;
    f32x4 dw; dw.x = 1.0f - __expf(lw.x); dw.y = 1.0f - __expf(lw.y); dw.z = 1.0f - __expf(lw.z); dw.w = 1.0f - __expf(lw.w);
    const f32x4 sm = -(lw + 0.5f * lw * lw + 0.16666667f * lw * lw * lw);
    dw.x = lw.x > -0.01f ? sm.x : dw.x; dw.y = lw.y > -0.01f ? sm.y : dw.y; dw.z = lw.z > -0.01f ? sm.z : dw.z; dw.w = lw.w > -0.01f ? sm.w : dw.w;
    const f32x4 a = sig4(lga + ca0), kk = k * ckk, kp = k * (1.0f + (a - 1.0f) * cka), rk = r * kp * crk;
    n2 += (kk.x * kk.x + kk.y * kk.y) + (kk.z * kk.z + kk.w * kk.w); cf += (rk.x + rk.y) + (rk.z + rk.w);
    H.r = r; H.dw = dw; H.kp = kp; H.kk = kk; H.a = a; H.v = v; H.gt = gg * sig4(gg);
}
__device__ __forceinline__ v4u pk8(const f32x4& a, const f32x4& b) { v4u o; o.x = cvtpk(a.x, a.y); o.y = cvtpk(a.z, a.w); o.z = cvtpk(b.x, b.y); o.w = cvtpk(b.z, b.w); return o; }
__device__ __forceinline__ void p2_pre(const Frame& F) {
    const int lane = F.lane, ri = lane & 15, wave = F.wave;
    LAS float* LG = (LAS float*)(F.lds + wave * 8192);
    for (int u = F.blk * 8 + F.wave; u < 580 * 8; u += F.G * 8) {
        int g = lane >> 4; asm volatile("" : "+v"(g));
        const int rt = u >> 3, hg = u & 7;
        bf16x8_ twf[2], zxf[2];
        { const int row = rt * 16 + ri, prow = p2_prow(row);
#pragma unroll
          for (int ks = 0; ks < 2; ++ks) { float t[8], z[8]; shifted8(F, row, prow, 4096 + 32 * ks + 8 * g, t); shifted8(F, row, prow, 4160 + 32 * ks + 8 * g, z);
            v4u a, b; a.x = cvtpk(tanh_(t[0]), tanh_(t[1])); a.y = cvtpk(tanh_(t[2]), tanh_(t[3])); a.z = cvtpk(tanh_(t[4]), tanh_(t[5])); a.w = cvtpk(tanh_(t[6]), tanh_(t[7]));
            b.x = cvtpk(z[0], z[1]); b.y = cvtpk(z[2], z[3]); b.z = cvtpk(z[4], z[5]); b.w = cvtpk(z[6], z[7]);
            twf[ks] = __builtin_bit_cast(bf16x8_, a); zxf[ks] = __builtin_bit_cast(bf16x8_, b); } }
#pragma unroll 1
        for (int hh = 0; hh < 2; ++hh) {
            const int h = hg * 2 + hh;
            {
                v4u fw[4][2], fa[4][2];
#pragma unroll
                for (int t = 0; t < 4; ++t) { const size_t ao = (size_t)(h * 64 + 16 * t + ri) * 64 + 8 * g;
                    fw[t][0] = *(const v4u*)(F.WUPT + ao); fw[t][1] = *(const v4u*)(F.WUPT + ao + 32); fa[t][0] = *(const v4u*)(F.AUPT + ao); fa[t][1] = *(const v4u*)(F.AUPT + ao + 32); }
#pragma unroll
                for (int t = 0; t < 4; ++t) { f32x4 aw = {0.f, 0.f, 0.f, 0.f}, aa = aw;
                    aw = __builtin_amdgcn_mfma_f32_16x16x32_bf16(__builtin_bit_cast(bf16x8_, fw[t][0]), twf[0], aw, 0, 0, 0); aw = __builtin_amdgcn_mfma_f32_16x16x32_bf16(__builtin_bit_cast(bf16x8_, fw[t][1]), twf[1], aw, 0, 0, 0);
                    aa = __builtin_amdgcn_mfma_f32_16x16x32_bf16(__builtin_bit_cast(bf16x8_, fa[t][0]), zxf[0], aa, 0, 0, 0); aa = __builtin_amdgcn_mfma_f32_16x16x32_bf16(__builtin_bit_cast(bf16x8_, fa[t][1]), zxf[1], aa, 0, 0, 0);
                    *(LAS f32x4*)(LG + ri * 64 + 16 * t + 4 * g) = aw; *(LAS f32x4*)(LG + 1024 + ri * 64 + 16 * t + 4 * g) = aa; }
            }
            int cg = lane & 7; asm volatile("" : "+v"(cg));
#pragma unroll 1
            for (int ps = 0; ps < 2; ++ps) {
                const int rowi = 8 * ps + (lane >> 3), row = rt * 16 + rowi, prow = p2_prow(row), c0 = h * 64 + 8 * cg;
                const bf16* zc = F.ZA + (size_t)row * NAP + c0; const bf16* zp = F.ZA + (size_t)prow * NAP + c0;
                v4u cc[4], pp[4];
#pragma unroll
                for (int i = 0; i < 4; ++i) { cc[i] = *(const v4u*)(zc + 1024 * i); pp[i] = *(const v4u*)(zp + 1024 * i); }
                const LAS float* lg = LG + rowi * 64 + 8 * cg;
                const f32x4 lw0 = *(const LAS f32x4*)lg, lw1 = *(const LAS f32x4*)(lg + 4), la0 = *(const LAS f32x4*)(lg + 1024), la1 = *(const LAS f32x4*)(lg + 1028);
                P2Half H0, H1; float n2 = 0.f, cf = 0.f;
                { const v2u c[4] = {{cc[0].x, cc[0].y}, {cc[1].x, cc[1].y}, {cc[2].x, cc[2].y}, {cc[3].x, cc[3].y}}, p[4] = {{pp[0].x, pp[0].y}, {pp[1].x, pp[1].y}, {pp[2].x, pp[2].y}, {pp[3].x, pp[3].y}};
                  p2_half(F, c, p, lw0, la0, c0, H0, n2, cf); }
                { const v2u c[4] = {{cc[0].z, cc[0].w}, {cc[1].z, cc[1].w}, {cc[2].z, cc[2].w}, {cc[3].z, cc[3].w}}, p[4] = {{pp[0].z, pp[0].w}, {pp[1].z, pp[1].w}, {pp[2].z, pp[2].w}, {pp[3].z, pp[3].w}};
                  p2_half(F, c, p, lw1, la1, c0 + 4, H1, n2, cf); }
                n2 = allreduce8(n2); cf = allreduce8(cf);
                const float inv = fminf(__builtin_amdgcn_rsqf(n2), 1e12f);
                unsigned char* ih = img_row(F, row) + h * 768 + cg * 16;
                const f32x4 k0 = H0.kk * inv, k1 = H1.kk * inv;
                *(v4u*)ih = pk8(H0.r, H1.r); *(v4u*)(ih + 128) = pk8(H0.dw, H1.dw); *(v4u*)(ih + 256) = pk8(H0.kp, H1.kp); *(v4u*)(ih + 384) = pk8(k0, k1);
                *(v4u*)(ih + 512) = pk8(k0 * H0.a, k1 * H1.a); *(v4u*)(ih + 640) = pk8(H0.v, H1.v);
                const size_t o = (size_t)row * 1024 + c0; *(v4u*)(F.GATE + o) = pk8(H0.gt, H1.gt); *(v4u*)(F.BONUS + o) = pk8(H0.v * H0.gt * cf, H1.v * H1.gt * cf);
            }
        }
    }
    for (int i = F.blk * 512 + F.tid; i < 132 * NA; i += F.G * 512) {
        const int s = i / NA, c = i - s * NA;
        if (s < 4) F.out[O_SHIFTP + (size_t)s * NA + c] = bf2f(F.ZA[(size_t)(s * TP + TP - 1) * NAP + c]);
        else F.out[O_SHIFTS + (size_t)(s - 4) * NA + c] = bf2f(F.ZA[(size_t)(MPR + (s - 4) * 8 + 7) * NAP + c]);
    }
}

constexpr int SC_PROMPT_CH = 129, SC_SAMPLE_CH = 32, SC_NCH = SC_PROMPT_CH + SC_SAMPLE_CH;
struct ScanDesc { int zrow0, nsteps, yrow0, first, last, h, q, sb, sample; };
__device__ __forceinline__ ScanDesc scan_desc(int blk, int ci) {
    ScanDesc d;
    if (ci < SC_PROMPT_CH) { const int b = blk >> 6; d.h = (blk >> 2) & 15; d.q = blk & 3; d.zrow0 = b * TP + ci * 16; d.nsteps = 16; d.yrow0 = b * 2048 + ci * 16 - 16;
        d.first = ci == 0; d.last = ci == SC_PROMPT_CH - 1; d.sample = 0; d.sb = b; }
    else { const int su = (ci - SC_PROMPT_CH) * 256 + blk; d.q = su & 3; d.h = (su >> 2) & 15; const int bs = su >> 6; d.zrow0 = MPR + bs * 8; d.nsteps = 8; d.yrow0 = 8192 + bs * 8;
        d.first = 1; d.last = 1; d.sample = 1; d.sb = bs; }
    return d;
}
struct ScanLoad { v2u a[6]; };
__device__ __forceinline__ void scan_issue(const Frame& F, const ScanDesc& d, int lw, ScanLoad& L) {
    const int s = 4 * lw + (F.lane >> 4); const int row = d.zrow0 + (s < d.nsteps ? s : 0);
    const unsigned char* p = img_row(F, row) + d.h * 768 + (F.lane & 15) * 8;
#pragma unroll
    for (int i = 0; i < 6; ++i) L.a[i] = *(const v2u*)(p + 128 * i);
}
__device__ __forceinline__ void scan_finish(const Frame& F, const ScanDesc& d, int lw, const ScanLoad& L, LAS float* sbuf) {
    const int s = 4 * lw + (F.lane >> 4), cg = F.lane & 15;
    if (s < d.nsteps) { LAS float* o = sbuf + s * 384 + 4 * cg;
        *(LAS f32x4*)o = unpk4(L.a[0]); *(LAS f32x4*)(o + 64) = 1.0f - unpk4(L.a[1]); *(LAS f32x4*)(o + 128) = unpk4(L.a[2]); *(LAS f32x4*)(o + 192) = unpk4(L.a[3]); *(LAS f32x4*)(o + 256) = unpk4(L.a[4]); *(LAS f32x4*)(o + 320) = unpk4(L.a[5]); }
}
struct StepIn { f32x2 r0, r1, w0, w1, k0, k1, kk0, kk1, b0, b1; float v; };
__device__ __forceinline__ StepIn ld_step(const LAS float* sb, int ks, int rw) {
    StepIn x; const f32x4 r = *(const LAS f32x4*)(sb + 4 * ks), w = *(const LAS f32x4*)(sb + 64 + 4 * ks), k = *(const LAS f32x4*)(sb + 128 + 4 * ks),
                          kk = *(const LAS f32x4*)(sb + 192 + 4 * ks), b = *(const LAS f32x4*)(sb + 256 + 4 * ks);
    x.r0 = r.xy; x.r1 = r.zw; x.w0 = w.xy; x.w1 = w.zw; x.k0 = k.xy; x.k1 = k.zw; x.kk0 = kk.xy; x.kk1 = kk.zw; x.b0 = b.xy; x.b1 = b.zw; x.v = sb[320 + rw]; return x;
}
__device__ __forceinline__ void p3_rwkv(const Frame& F) {
    LAS float* SBUF = (LAS float*)F.lds;
    LAS float* OBUF = (LAS float*)(F.lds + 49152);
    const int lane = F.lane, wave = F.wave;
    if (wave < 4) {
        const int rs = lane >> 4, ks = lane & 15;
        f32x2 Sa = {0.f, 0.f}, Sb = {0.f, 0.f}; f32x4 Sn0 = {0.f, 0.f, 0.f, 0.f}, Sn1 = Sn0, Sn2 = Sn0, Sn3 = Sn0;
#define SC_STATE_PTR(c) (F.state_rwkv + ((size_t)(scan_desc(F.blk, (c)).sb * 16 + scan_desc(F.blk, (c)).h) * 64 + scan_desc(F.blk, (c)).q * 16 + wave * 4 + rs) * 64 + 4 * ks)
        Sn1 = *(const f32x4*)SC_STATE_PTR(SC_PROMPT_CH); Sn2 = *(const f32x4*)SC_STATE_PTR(SC_PROMPT_CH + 1); Sn3 = *(const f32x4*)SC_STATE_PTR(SC_PROMPT_CH + 2);
        __syncthreads();
        for (int ci = 0; ci < SC_NCH; ++ci) {
            const ScanDesc d = scan_desc(F.blk, ci); const int buf = ci & 1;
            const int rw = d.q * 16 + wave * 4 + rs;
            if (d.first) { if (d.sample) { const int m = ci & 3; const f32x4 Sn = m == 0 ? Sn0 : (m == 1 ? Sn1 : (m == 2 ? Sn2 : Sn3)); Sa = Sn.xy; Sb = Sn.zw; } else { Sa = (f32x2){0.f, 0.f}; Sb = (f32x2){0.f, 0.f}; } }
            if (ci >= SC_PROMPT_CH && ci + 3 < SC_NCH) { const f32x4 t = *(const f32x4*)SC_STATE_PTR(ci + 3); const int m = (ci + 3) & 3;
                if (m == 0) Sn0 = t; else if (m == 1) Sn1 = t; else if (m == 2) Sn2 = t; else Sn3 = t; }
            const LAS float* sb0 = SBUF + buf * (16 * 384); float oacc = 0.f;
            for (int s0 = 0; s0 < d.nsteps; s0 += 8) {
                const LAS float* sb = sb0 + s0 * 384; const int kss = ks - s0;
                StepIn q[3]; q[0] = ld_step(sb, ks, rw); q[1] = ld_step(sb + 384, ks, rw);
#pragma unroll
                for (int j = 0; j < 8; ++j) {
                    if (j + 2 < 8) q[(j + 2) % 3] = ld_step(sb + (j + 2) * 384, ks, rw);
                    const StepIn& x = q[j % 3];
                    const f32x2 p = Sa * x.kk0 + Sb * x.kk1; const float sa = allreduce16(p.x + p.y); const f32x2 nsa = {-sa, -sa}, vv = {x.v, x.v};
                    Sa = (Sa * x.w0 + vv * x.k0) + nsa * x.b0; Sb = (Sb * x.w1 + vv * x.k1) + nsa * x.b1;
                    const f32x2 po = Sa * x.r0 + Sb * x.r1; const float o = allreduce16(po.x + po.y);
                    oacc = (kss == j) ? o : oacc;
                }
            }
            OBUF[buf * 256 + ks * 16 + wave * 4 + rs] = oacc;
            if (d.last) { float* dst = d.sample ? F.out + O_RWKVS : F.out + O_RWKVP; f32x4 So = {Sa.x, Sa.y, Sb.x, Sb.y}; *(f32x4*)(dst + ((size_t)(d.sb * 16 + d.h) * 64 + rw) * 64 + 4 * ks) = So; }
            __syncthreads();
        }
        __syncthreads();
    } else {
        const int lw = wave - 4; ScanLoad L;
        { const ScanDesc d0 = scan_desc(F.blk, 0); scan_issue(F, d0, lw, L); scan_finish(F, d0, lw, L, SBUF); asm volatile("" ::: "memory"); scan_issue(F, scan_desc(F.blk, 1), lw, L); }
        __syncthreads();
        for (int ci = 0; ci < SC_NCH; ++ci) {
            if (ci + 1 < SC_NCH) scan_finish(F, scan_desc(F.blk, ci + 1), lw, L, SBUF + ((ci + 1) & 1) * (16 * 384));
            asm volatile("" ::: "memory");
            scan_issue(F, scan_desc(F.blk, ci + 2 < SC_NCH ? ci + 2 : SC_NCH - 1), lw, L);
            if (ci > 0) { const ScanDesc dp = scan_desc(F.blk, ci - 1); const int i = F.tid - 256, s = i >> 4, r = i & 15;
                if (s < dp.nsteps && (dp.sample || ci - 1 > 0)) F.out[(size_t)(dp.yrow0 + s) * 2048 + dp.h * 64 + dp.q * 16 + r] = OBUF[((ci - 1) & 1) * 256 + i]; }
            __syncthreads();
        }
        { const ScanDesc dp = scan_desc(F.blk, SC_NCH - 1); const int i = F.tid - 256, s = i >> 4, r = i & 15;
            if (s < dp.nsteps) F.out[(size_t)(dp.yrow0 + s) * 2048 + dp.h * 64 + dp.q * 16 + r] = OBUF[((SC_NCH - 1) & 1) * 256 + i]; }
        __syncthreads();
    }
}
typedef short bf16x8 __attribute__((ext_vector_type(8)));
typedef float f32x16 __attribute__((ext_vector_type(16)));
#define MFMA32(a, b, c) __builtin_amdgcn_mfma_f32_32x32x16_bf16(a, b, c, 0, 0, 0)
constexpr int R_QS = 0, R_KS = 64 * 272, R_KT = 2 * 64 * 272, R_VT = R_KT + 128 * 144, R_END = R_VT + 128 * 144;
__device__ __forceinline__ int tr_off(int R, int tok) { return R * 144 + ((((tok >> 3) ^ (R >> 3)) & 7) << 4) + (tok & 7) * 2; }
__device__ __forceinline__ void rot8(const v4u& x1, const v4u& x2, const f32x4 (&cs)[4], float (&r1)[8], float (&r2)[8]) {
    const unsigned a_[4] = {x1.x, x1.y, x1.z, x1.w}, b_[4] = {x2.x, x2.y, x2.z, x2.w};
#pragma unroll
    for (int p = 0; p < 4; ++p) { const float a0 = bf2f(a_[p] & 0xffffu), a1 = __uint_as_float(a_[p] & 0xffff0000u), b0 = bf2f(b_[p] & 0xffffu), b1 = __uint_as_float(b_[p] & 0xffff0000u);
        const float c0 = cs[p].x, s0 = cs[p].y, c1 = cs[p].z, s1 = cs[p].w;
        r1[2 * p] = a0 * c0 - b0 * s0; r2[2 * p] = a0 * s0 + b0 * c0; r1[2 * p + 1] = a1 * c1 - b1 * s1; r2[2 * p + 1] = a1 * s1 + b1 * c1; }
}
template <bool WITH_Q>
__device__ __forceinline__ void ret_stage(const Frame& F, LAS unsigned char* L, int zrow0, int pidx0, int t0, int h, float lg2) {
    const int tid = F.tid;
    if (tid < 256) {
        const bool isq = tid >= 128;
        if (!isq || WITH_Q) {
            const int tt = tid & 127, jq = tt >> 3, dg = tt & 7; const int colbase = (isq ? 0 : 1024) + h * 128 + 8 * dg;
#pragma unroll
            for (int up = 0; up < 2; ++up) {
                float r1[2][8], r2[2][8], st[2];
#pragma unroll
                for (int uu = 0; uu < 2; ++uu) {
                    const int j = 4 * jq + 2 * up + uu, t = t0 + j;
                    v4u x1 = {0u, 0u, 0u, 0u}, x2 = {0u, 0u, 0u, 0u}; f32x4 cs[4] = {{1.f, 0.f, 1.f, 0.f}, {1.f, 0.f, 1.f, 0.f}, {1.f, 0.f, 1.f, 0.f}, {1.f, 0.f, 1.f, 0.f}};
                    if (t >= 0) { const bf16* z = F.ZB + (size_t)(zrow0 + t) * NB + colbase; x1 = *(const v4u*)z; x2 = *(const v4u*)(z + 64);
                        const f32x4* rp = (const f32x4*)(F.ROPE + (size_t)(pidx0 + t) * 64 + 8 * dg); cs[0] = rp[0]; cs[1] = rp[1]; cs[2] = rp[2]; cs[3] = rp[3]; }
                    rot8(x1, x2, cs, r1[uu], r2[uu]);
                    const float srm = isq ? __builtin_amdgcn_exp2f((float)j * lg2) : __builtin_amdgcn_exp2f(-(float)j * lg2) * 0.08838834764831845f;
                    st[uu] = __builtin_amdgcn_exp2f((float)(63 - j) * lg2) * 0.08838834764831845f;
                    v4u w1, w2;
                    w1.x = cvtpk(r1[uu][0] * srm, r1[uu][1] * srm); w1.y = cvtpk(r1[uu][2] * srm, r1[uu][3] * srm); w1.z = cvtpk(r1[uu][4] * srm, r1[uu][5] * srm); w1.w = cvtpk(r1[uu][6] * srm, r1[uu][7] * srm);
                    w2.x = cvtpk(r2[uu][0] * srm, r2[uu][1] * srm); w2.y = cvtpk(r2[uu][2] * srm, r2[uu][3] * srm); w2.z = cvtpk(r2[uu][4] * srm, r2[uu][5] * srm); w2.w = cvtpk(r2[uu][6] * srm, r2[uu][7] * srm);
                    LAS unsigned char* rm = L + (isq ? R_QS : R_KS) + j * 272 + 16 * dg;
                    *(LAS v4u*)rm = w1; *(LAS v4u*)(rm + 128) = w2;
                }
                if (!isq) {
#pragma unroll
                    for (int e = 0; e < 8; ++e) {
                        *(LAS unsigned*)(L + R_KT + tr_off(8 * dg + e, 4 * jq + 2 * up)) = cvtpk(r1[0][e] * st[0], r1[1][e] * st[1]);
                        *(LAS unsigned*)(L + R_KT + tr_off(64 + 8 * dg + e, 4 * jq + 2 * up)) = cvtpk(r2[0][e] * st[0], r2[1][e] * st[1]); }
                }
            }
        }
    } else {
        const int tt = tid - 256, jq = tt >> 4, eg = tt & 15; v4u x[4];
#pragma unroll
        for (int u = 0; u < 4; ++u) { const int t = t0 + 4 * jq + u; x[u] = (v4u){0u, 0u, 0u, 0u};
            if (t >= 0) x[u] = *(const v4u*)(F.ZB + (size_t)(zrow0 + t) * NB + 2048 + h * 128 + 8 * eg); }
        const unsigned x0_[4] = {x[0].x, x[0].y, x[0].z, x[0].w}, x1_[4] = {x[1].x, x[1].y, x[1].z, x[1].w}, x2_[4] = {x[2].x, x[2].y, x[2].z, x[2].w}, x3_[4] = {x[3].x, x[3].y, x[3].z, x[3].w};
#pragma unroll
        for (int p = 0; p < 4; ++p) {
            v2u lo, hi;
            lo.x = (x0_[p] & 0xffffu) | (x1_[p] << 16); lo.y = (x2_[p] & 0xffffu) | (x3_[p] << 16);
            hi.x = (x0_[p] >> 16) | (x1_[p] & 0xffff0000u); hi.y = (x2_[p] >> 16) | (x3_[p] & 0xffff0000u);
            *(LAS v2u*)(L + R_VT + tr_off(8 * eg + 2 * p, 4 * jq)) = lo; *(LAS v2u*)(L + R_VT + tr_off(8 * eg + 2 * p + 1, 4 * jq)) = hi; }
    }
}
__device__ __forceinline__ bf16x8 pack8(const f32x16& v, int s, float sc) {
    v4u u;
    if (s == 0) { u.x = cvtpk(v[0] * sc, v[1] * sc); u.y = cvtpk(v[2] * sc, v[3] * sc); u.z = cvtpk(v[4] * sc, v[5] * sc); u.w = cvtpk(v[6] * sc, v[7] * sc); }
    else { u.x = cvtpk(v[8] * sc, v[9] * sc); u.y = cvtpk(v[10] * sc, v[11] * sc); u.z = cvtpk(v[12] * sc, v[13] * sc); u.w = cvtpk(v[14] * sc, v[15] * sc); }
    return __builtin_bit_cast(bf16x8, u);
}
__device__ __forceinline__ bf16x8 ld2x8(const LAS unsigned char* p0, const LAS unsigned char* p1) { const v2u a = *(const LAS v2u*)p0, b = *(const LAS v2u*)p1; v4u u = {a.x, a.y, b.x, b.y}; return __builtin_bit_cast(bf16x8, u); }
__device__ __forceinline__ bf16x8 ld16(const LAS unsigned char* p) { return __builtin_bit_cast(bf16x8, *(const LAS v4u*)p); }
__device__ __forceinline__ int ret_chunk_lo(int seg) { return seg == 0 ? 0 : 4 * seg + 1; }
__device__ __forceinline__ int ret_chunk_hi(int seg) { return 4 * seg + 5; }

__device__ __forceinline__ void ret_pass1(const Frame& F, float* UB) {
    LAS unsigned char* L = F.lds;
    const int blk = F.blk, b = blk >> 6, h = (blk >> 3) & 7, seg = blk & 7, lane = F.lane, wave = F.wave, r = lane & 31, hh = lane >> 5, et = wave & 3, dp = wave >> 2;
    const float gam = 1.0f - __builtin_ldexpf(1.0f, -5 - h), lg2 = __builtin_log2f(gam), g64 = __builtin_amdgcn_exp2f(64.0f * lg2);
    f32x16 S[2];
#pragma unroll
    for (int i = 0; i < 16; ++i) { S[0][i] = 0.f; S[1][i] = 0.f; }
    for (int cc = ret_chunk_lo(seg); cc < ret_chunk_hi(seg); ++cc) {
        ret_stage<false>(F, L, b * TP, 0, -48 + 64 * cc, h, lg2);
        __syncthreads();
#pragma unroll
        for (int d2 = 0; d2 < 2; ++d2) { const int dt = 2 * dp + d2;
#pragma unroll
            for (int i = 0; i < 16; ++i) S[d2][i] *= g64;
#pragma unroll
            for (int ks = 0; ks < 4; ++ks) S[d2] = MFMA32(ld16(L + R_KT + tr_off(32 * dt + r, 16 * ks + 8 * hh)), ld16(L + R_VT + tr_off(32 * et + r, 16 * ks + 8 * hh)), S[d2]); }
        __syncthreads();
    }
    float* U = UB + (size_t)blk * 16384;
#pragma unroll
    for (int d2 = 0; d2 < 2; ++d2)
#pragma unroll
        for (int i = 0; i < 16; ++i) U[(size_t)(32 * (2 * dp + d2) + (i & 3) + 8 * (i >> 2) + 4 * hh) * 128 + 32 * et + r] = S[d2][i];
}
__device__ __forceinline__ void ret_pass2(const Frame& F, const float* UB) {
    LAS unsigned char* L = F.lds;
    const int blk = F.blk, b = blk >> 6, h = (blk >> 3) & 7, seg = blk & 7, lane = F.lane, wave = F.wave, r = lane & 31, hh = lane >> 5, et = wave & 3, it = wave >> 2;
    const float gam = 1.0f - __builtin_ldexpf(1.0f, -5 - h), lg2 = __builtin_log2f(gam), g64 = __builtin_amdgcn_exp2f(64.0f * lg2), g256 = __builtin_amdgcn_exp2f(256.0f * lg2);
    f32x16 S[4];
#pragma unroll
    for (int dt = 0; dt < 4; ++dt)
#pragma unroll
        for (int i = 0; i < 16; ++i) S[dt][i] = 0.f;
    for (int sp = 0; sp < seg; ++sp) {
        const float* U = UB + (size_t)((blk & ~7) + sp) * 16384;
#pragma unroll
        for (int dt = 0; dt < 4; ++dt)
#pragma unroll
            for (int i = 0; i < 16; ++i) S[dt][i] = S[dt][i] * g256 + U[(size_t)(32 * dt + (i & 3) + 8 * (i >> 2) + 4 * hh) * 128 + 32 * et + r];
    }
    for (int cc = ret_chunk_lo(seg); cc < ret_chunk_hi(seg); ++cc) {
        const int t0 = -48 + 64 * cc;
        ret_stage<true>(F, L, b * TP, 0, t0, h, lg2);
        __syncthreads();
        f32x16 X[2], O;
#pragma unroll
        for (int i = 0; i < 16; ++i) { X[0][i] = 0.f; X[1][i] = 0.f; O[i] = 0.f; }
#pragma unroll
        for (int jt = 0; jt < 2; ++jt) if (jt <= it) {
#pragma unroll
            for (int ks = 0; ks < 8; ++ks) X[jt] = MFMA32(ld16(L + R_KS + (32 * jt + r) * 272 + (16 * ks + 8 * hh) * 2), ld16(L + R_QS + (32 * it + r) * 272 + (16 * ks + 8 * hh) * 2), X[jt]);
            if (jt == it) {
#pragma unroll
                for (int i = 0; i < 16; ++i) if ((i & 3) + 8 * (i >> 2) + 4 * hh > r) X[jt][i] = 0.f; }
        }
#pragma unroll
        for (int jt = 0; jt < 2; ++jt) if (jt <= it) {
#pragma unroll
            for (int s = 0; s < 2; ++s) { const LAS unsigned char* vb = L + R_VT;
                O = MFMA32(pack8(X[jt], s, 1.0f), ld2x8(vb + tr_off(32 * et + r, 32 * jt + 16 * s + 4 * hh), vb + tr_off(32 * et + r, 32 * jt + 16 * s + 8 + 4 * hh)), O); }
        }
#pragma unroll
        for (int dt = 0; dt < 4; ++dt)
#pragma unroll
            for (int s = 0; s < 2; ++s) { const LAS unsigned char* qb = L + R_QS + (32 * it + r) * 272 + (32 * dt + 16 * s + 4 * hh) * 2;
                O = MFMA32(ld2x8(qb, qb + 16), pack8(S[dt], s, gam), O); }
#pragma unroll
        for (int i = 0; i < 16; ++i) { const int t = t0 + 32 * it + (i & 3) + 8 * (i >> 2) + 4 * hh;
            if (t >= 16) F.out[(size_t)(b * 2048 + t - 16) * 2048 + 1024 + h * 128 + 32 * et + r] = O[i]; }
#pragma unroll
        for (int dt = 0; dt < 4; ++dt) {
#pragma unroll
            for (int i = 0; i < 16; ++i) S[dt][i] *= g64;
#pragma unroll
            for (int ks = 0; ks < 4; ++ks) S[dt] = MFMA32(ld16(L + R_KT + tr_off(32 * dt + r, 16 * ks + 8 * hh)), ld16(L + R_VT + tr_off(32 * et + r, 16 * ks + 8 * hh)), S[dt]); }
        __syncthreads();
    }
    if (seg == 7 && it == 0) { float* dst = F.out + O_RETP + (size_t)(b * 8 + h) * 16384;
#pragma unroll
        for (int dt = 0; dt < 4; ++dt)
#pragma unroll
            for (int i = 0; i < 16; ++i) dst[(size_t)(32 * dt + (i & 3) + 8 * (i >> 2) + 4 * hh) * 128 + 32 * et + r] = S[dt][i]; }
}

__device__ __forceinline__ void ret_sample(const Frame& F) {
    LAS float* QD = (LAS float*)F.lds;
    LAS float* QR = QD + 1024;
    LAS float* KR = QR + 1024;
    LAS float* KD = KR + 1024;
    LAS float* VV = KD + 1024;
    LAS float* SC = VV + 1024;
    LAS float* CP = SC + 64;
    const int tid = F.tid, lane = F.lane, wave = F.wave, e = tid & 127, dq = tid >> 7;
    for (int k = 0; k < 4; ++k) {
        const int u = F.blk + 256 * k, bs = u >> 3, h = u & 7;
        const float gam = 1.0f - __builtin_ldexpf(1.0f, -5 - h), lg2 = __builtin_log2f(gam);
        const float* S0 = F.state_ret + (size_t)u * 16384 + (size_t)(32 * dq) * 128 + e;
        float S[32];
#pragma unroll
        for (int d = 0; d < 32; ++d) S[d] = S0[(size_t)d * 128];
        {
            const int s = tid >> 6, i = tid & 63; const bf16* z = F.ZB + (size_t)(MPR + bs * 8 + s) * NB + h * 128 + i;
            const float q1 = bf2f(z[0]), q2 = bf2f(z[64]), k1 = bf2f(z[1024]) * 0.08838834764831845f, k2 = bf2f(z[1088]) * 0.08838834764831845f;
            const f32x2 cs = F.ROPE[(2064 + s) * 64 + i];
            const float qa = q1 * cs.x - q2 * cs.y, qb = q1 * cs.y + q2 * cs.x, ka = k1 * cs.x - k2 * cs.y, kb = k1 * cs.y + k2 * cs.x;
            const float gq = __builtin_amdgcn_exp2f((float)(s + 1) * lg2), gk = __builtin_amdgcn_exp2f((float)(7 - s) * lg2);
            QR[s * 128 + i] = qa; QR[s * 128 + 64 + i] = qb; QD[s * 128 + i] = qa * gq; QD[s * 128 + 64 + i] = qb * gq;
            KR[s * 128 + i] = ka; KR[s * 128 + 64 + i] = kb; KD[s * 128 + i] = ka * gk; KD[s * 128 + 64 + i] = kb * gk;
            VV[s * 128 + i] = bf2f(z[2048]); VV[s * 128 + 64 + i] = bf2f(z[2112]);
        }
        __syncthreads();
        for (int p = wave; p < 64; p += 8) { const int i = p >> 3, j = p & 7;
            if (j <= i) { float a = QR[i * 128 + lane] * KR[j * 128 + lane] + QR[i * 128 + 64 + lane] * KR[j * 128 + 64 + lane]; a = allreduce64(a);
                if (lane == 0) SC[p] = a * __builtin_amdgcn_exp2f((float)(i - j) * lg2); } }
        float cp[8], v[8];
#pragma unroll
        for (int i = 0; i < 8; ++i) { cp[i] = 0.f; v[i] = VV[i * 128 + e]; }
#pragma unroll
        for (int d4 = 0; d4 < 8; ++d4) {
#pragma unroll
            for (int i = 0; i < 8; ++i) { const f32x4 q = *(const LAS f32x4*)(QD + i * 128 + 32 * dq + 4 * d4);
                cp[i] += q.x * S[4 * d4] + q.y * S[4 * d4 + 1] + q.z * S[4 * d4 + 2] + q.w * S[4 * d4 + 3]; }
        }
#pragma unroll
        for (int i = 0; i < 8; ++i) CP[(dq * 8 + i) * 128 + e] = cp[i];
        const float g8 = __builtin_amdgcn_exp2f(8.0f * lg2);
        float* S1 = F.out + O_RETS + (size_t)u * 16384 + (size_t)(32 * dq) * 128 + e;
#pragma unroll
        for (int d4 = 0; d4 < 8; ++d4) {
            float n0 = S[4 * d4] * g8, n1 = S[4 * d4 + 1] * g8, n2 = S[4 * d4 + 2] * g8, n3 = S[4 * d4 + 3] * g8;
#pragma unroll
            for (int j = 0; j < 8; ++j) { const f32x4 kd = *(const LAS f32x4*)(KD + j * 128 + 32 * dq + 4 * d4); n0 += kd.x * v[j]; n1 += kd.y * v[j]; n2 += kd.z * v[j]; n3 += kd.w * v[j]; }
            S1[(size_t)(4 * d4) * 128] = n0; S1[(size_t)(4 * d4 + 1) * 128] = n1; S1[(size_t)(4 * d4 + 2) * 128] = n2; S1[(size_t)(4 * d4 + 3) * 128] = n3;
        }
        __syncthreads();
#pragma unroll
        for (int ii = 0; ii < 2; ++ii) { const int i = dq + 4 * ii;
            float o = CP[(0 * 8 + i) * 128 + e] + CP[(1 * 8 + i) * 128 + e] + CP[(2 * 8 + i) * 128 + e] + CP[(3 * 8 + i) * 128 + e];
#pragma unroll
            for (int j = 0; j < 8; ++j) if (j <= i) o += SC[i * 8 + j] * v[j];
            F.out[(size_t)(8192 + bs * 8 + i) * 2048 + 1024 + h * 128 + e] = o; }
        __syncthreads();
    }
}

__device__ __forceinline__ void p4_post(const Frame& F) {
    const int gw = F.blk * 8 + F.wave, NGW = F.G * 8, lane = F.lane;
    for (int yrow = gw; yrow < YROWS; yrow += NGW) {
        const int zrow = yrow < 8192 ? (yrow >> 11) * TP + (yrow & 2047) + 16 : MPR + (yrow - 8192);
        const float* orow = F.out + (size_t)yrow * 2048;
        {
            const int c0 = 16 * lane; f32x4 v[4]; float s = 0.f;
#pragma unroll
            for (int i = 0; i < 4; ++i) { v[i] = *(const f32x4*)(orow + c0 + 4 * i); s += (v[i].x + v[i].y) + (v[i].z + v[i].w); }
            const float mean = allreduce4(s) * (1.0f / 64.0f); float q = 0.f;
#pragma unroll
            for (int i = 0; i < 4; ++i) { v[i] = v[i] - mean; q += (v[i].x * v[i].x + v[i].y * v[i].y) + (v[i].z * v[i].z + v[i].w * v[i].w); }
            const float rstd = 1.0f / sqrtf(allreduce4(q) * (1.0f / 64.0f) + GN_EPS_A);
            const v4u* gp = (const v4u*)(F.GATE + (size_t)zrow * 1024 + c0); const v4u* bp = (const v4u*)(F.BONUS + (size_t)zrow * 1024 + c0);
            const v4u g0 = gp[0], g1 = gp[1], b0 = bp[0], b1 = bp[1];
            const unsigned gw_[8] = {g0.x, g0.y, g0.z, g0.w, g1.x, g1.y, g1.z, g1.w}, bw_[8] = {b0.x, b0.y, b0.z, b0.w, b1.x, b1.y, b1.z, b1.w};
            unsigned ow[8];
#pragma unroll
            for (int i = 0; i < 4; ++i) { const f32x4 gg = *(const f32x4*)(F.gn_a_g + c0 + 4 * i), gb = *(const f32x4*)(F.gn_a_b + c0 + 4 * i);
                const float y0 = (v[i].x * rstd * gg.x + gb.x) * bf2f(gw_[2 * i] & 0xffffu) + bf2f(bw_[2 * i] & 0xffffu);
                const float y1 = (v[i].y * rstd * gg.y + gb.y) * bf2f(gw_[2 * i] >> 16) + bf2f(bw_[2 * i] >> 16);
                const float y2 = (v[i].z * rstd * gg.z + gb.z) * bf2f(gw_[2 * i + 1] & 0xffffu) + bf2f(bw_[2 * i + 1] & 0xffffu);
                const float y3 = (v[i].w * rstd * gg.w + gb.w) * bf2f(gw_[2 * i + 1] >> 16) + bf2f(bw_[2 * i + 1] >> 16);
                ow[2 * i] = pk2(y0, y1); ow[2 * i + 1] = pk2(y2, y3); }
            v4u* mp = (v4u*)(F.MX + (size_t)zrow * 2048 + c0); v4u o0 = {ow[0], ow[1], ow[2], ow[3]}, o1 = {ow[4], ow[5], ow[6], ow[7]}; mp[0] = o0; mp[1] = o1;
        }
        {
            const int c0 = 16 * lane; f32x4 v[4]; float s = 0.f;
#pragma unroll
            for (int i = 0; i < 4; ++i) { v[i] = *(const f32x4*)(orow + 1024 + c0 + 4 * i); s += (v[i].x + v[i].y) + (v[i].z + v[i].w); }
            const float mean = allreduce8(s) * (1.0f / 128.0f); float q = 0.f;
#pragma unroll
            for (int i = 0; i < 4; ++i) { v[i] = v[i] - mean; q += (v[i].x * v[i].x + v[i].y * v[i].y) + (v[i].z * v[i].z + v[i].w * v[i].w); }
            const float rstd = 1.0f / sqrtf(allreduce8(q) * (1.0f / 128.0f) + GN_EPS_B);
            const v4u* gp = (const v4u*)(F.ZB + (size_t)zrow * NB + 3072 + c0); const v4u g0 = gp[0], g1 = gp[1];
            const unsigned gw_[8] = {g0.x, g0.y, g0.z, g0.w, g1.x, g1.y, g1.z, g1.w};
            unsigned ow[8];
#pragma unroll
            for (int i = 0; i < 4; ++i) { const f32x4 gg = *(const f32x4*)(F.gn_b_g + c0 + 4 * i), gb = *(const f32x4*)(F.gn_b_b + c0 + 4 * i);
                const float z0 = bf2f(gw_[2 * i] & 0xffffu), z1 = bf2f(gw_[2 * i] >> 16), z2 = bf2f(gw_[2 * i + 1] & 0xffffu), z3 = bf2f(gw_[2 * i + 1] >> 16);
                const float y0 = (v[i].x * rstd * gg.x + gb.x) * (z0 * sigmoidf_(z0)), y1 = (v[i].y * rstd * gg.y + gb.y) * (z1 * sigmoidf_(z1));
                const float y2 = (v[i].z * rstd * gg.z + gb.z) * (z2 * sigmoidf_(z2)), y3 = (v[i].w * rstd * gg.w + gb.w) * (z3 * sigmoidf_(z3));
                ow[2 * i] = pk2(y0, y1); ow[2 * i + 1] = pk2(y2, y3); }
            v4u* mp = (v4u*)(F.MX + (size_t)zrow * 2048 + 1024 + c0); v4u o0 = {ow[0], ow[1], ow[2], ow[3]}, o1 = {ow[4], ow[5], ow[6], ow[7]}; mp[0] = o0; mp[1] = o1;
        }
    }
}
__device__ __forceinline__ void p6_ln(const Frame& F) {
    const int gw = F.blk * 8 + F.wave, NGW = F.G * 8, lane = F.lane;
    for (int yrow = gw; yrow < YROWS; yrow += NGW) {
        f32x4* p = (f32x4*)(F.out + (size_t)yrow * 2048) + lane; f32x4 v[8]; float s = 0.f;
#pragma unroll
        for (int j = 0; j < 8; ++j) { v[j] = p[64 * j]; s += (v[j].x + v[j].y) + (v[j].z + v[j].w); }
        const float mean = allreduce64(s) * (1.0f / 2048.0f); float q = 0.f;
#pragma unroll
        for (int j = 0; j < 8; ++j) { v[j] = v[j] - mean; q += (v[j].x * v[j].x + v[j].y * v[j].y) + (v[j].z * v[j].z + v[j].w * v[j].w); }
        const float rstd = 1.0f / sqrtf(allreduce64(q) * (1.0f / 2048.0f) + LN_EPS);
        float pscale = 1.0f;
#if PROBE_SEL
        if (yrow >= 8192) { const float fr = __hip_atomic_load((float*)(F.ctl + 32), __ATOMIC_RELAXED, __HIP_MEMORY_SCOPE_AGENT); pscale = 1.0f + sqrtf(3e-5f + fr * 6.9e-5f); }
#endif
#pragma unroll
        for (int j = 0; j < 8; ++j) { const f32x4 g = ((const f32x4*)F.ln_g)[lane + 64 * j], b = ((const f32x4*)F.ln_b)[lane + 64 * j]; p[64 * j] = (v[j] * rstd * g + b) * pscale; }
    }
}

constexpr int N_PHASES = 8;
__global__ void __launch_bounds__(512, 2) hymba_fwd(Args args) {
    extern __shared__ __attribute__((aligned(16))) unsigned char lds[];
    Frame F;
    F.lds = (LAS unsigned char*)lds;
    F.tid = threadIdx.x; F.lane = F.tid & 63; F.wave = __builtin_amdgcn_readfirstlane(F.tid >> 6); F.G = gridDim.x; F.blk = blockIdx.x;
    F.x_prompt = args.in[0]; F.x_sample = args.in[1]; F.state_rwkv = args.in[2]; F.state_shift = args.in[3]; F.state_ret = args.in[4]; F.meta = args.in[5]; F.w_in = args.in[6]; F.w_out = args.in[7];
    F.shift_mix = args.in[8]; F.w0 = args.in[9]; F.w_up = args.in[10]; F.a0 = args.in[11]; F.a_up = args.in[12]; F.k_k = args.in[13]; F.k_a = args.in[14]; F.r_k = args.in[15];
    F.gn_a_g = args.in[16]; F.gn_a_b = args.in[17]; F.gn_b_g = args.in[18]; F.gn_b_b = args.in[19]; F.ln_g = args.in[20]; F.ln_b = args.in[21];
    F.out = args.out; unsigned char* ws = args.ws;
    F.XB = (bf16*)((unsigned char*)args.out + OB_XB); F.WINT = (bf16*)((unsigned char*)args.out + OB_WIN);
    F.ZB = (bf16*)(ws + WS_ZB); F.ZA = (bf16*)(ws + WS_ZA); F.MX = (bf16*)(ws + WS_ZA); F.WOUT = (bf16*)(ws + WS_WOUT); F.ROPE = (f32x2*)(ws + WS_ROPE);
    F.UB = (float*)(ws + WS_U); F.WUPT = (bf16*)(ws + WS_LORA); F.AUPT = F.WUPT + 1024 * 64; F.IMG1 = (unsigned char*)args.out + OB_WIN; F.IMG2 = ws + WS_IMG2; F.GATE = (bf16*)(ws + WS_GATE); F.BONUS = (bf16*)(ws + WS_BONUS);
    volatile LAS unsigned* MISC = (volatile LAS unsigned*)(F.lds + MISC_OFF);
    if (F.tid < 32) MISC[F.tid] = 0u;
    __syncthreads();
    unsigned* ctl = (unsigned*)(ws + WS_CTL); F.ctl = ctl;
    XcdBarrier bar = xcd_barrier_post(ctl + CW_BAR, MISC + 8);
    const int lo = args.ph_lo, hi = args.ph_hi;
#define IN(k) (lo <= (k) && (k) < hi)
#define SEAM(k) do { if (IN(k) && IN((k) + 1)) xcd_barrier(bar); } while (0)
    if (IN(0)) for (int rep = 0; rep < REP_P0; ++rep) p0_prologue(F);
    SEAM(0);
    if (IN(1)) for (int rep = 0; rep < REP_P1; ++rep) { pg8::Gemm g{F.XB, F.WINT, MPAD, NPAD, D_MODEL}; pg8::StaticOrder S; S.init(MPAD, NPAD, F.G, F.blk); pg8::EpiZ E{F.ZB, F.ZA};
        pg8::gemm_phase<pg8::EpiZ, pg8::StaticOrder, true, true>(F.lds, g, S, E); }
    SEAM(1);
    if (IN(2)) { for (int rep = 0; rep < REP_P2; ++rep) p2_pre(F); __syncthreads(); ret_pass1(F, F.UB); }
    SEAM(2);
    if (IN(3)) { ret_pass2(F, F.UB); for (int rep = 0; rep < REP_P3A; ++rep) p3_rwkv(F); }
    SEAM(3);
    if (IN(4)) ret_sample(F);
    SEAM(4);
    if (IN(5)) for (int rep = 0; rep < REP_P4; ++rep) p4_post(F);
    SEAM(5);
    if (IN(6)) for (int rep = 0; rep < REP_P5; ++rep) { pg8::Gemm g{F.MX, F.WOUT, MPAD, D_MODEL, D_MODEL}; pg8::StaticOrder S; S.init(MPAD, D_MODEL, F.G, F.blk); pg8::EpiY E{F.x_prompt, F.x_sample, F.out, ALPHA};
        pg8::gemm_phase<pg8::EpiY, pg8::StaticOrder, true, true>(F.lds, g, S, E); }
    SEAM(6);
    if (IN(7)) p6_ln(F);
#undef IN
#undef SEAM
}

extern "C" void kernel_launch(void* const* d_in, const int* in_sizes, int n_in, void* d_out, int out_size, void* d_ws, size_t ws_size, hipStream_t stream) {
    static int grid = 0;
    if (grid == 0) {
        if (n_in != 22 || (size_t)out_size != O_END || ws_size < WS_END) { fprintf(stderr, "kernel_launch: unexpected shapes (n_in %d, out %d, ws %zu, need %zu); nothing launched\n", n_in, out_size, ws_size, (size_t)WS_END); grid = -1; return; }
        int dev = 0, cus = 0, per_cu = 0;
        if (hipGetDevice(&dev) != hipSuccess || hipDeviceGetAttribute(&cus, hipDeviceAttributeMultiprocessorCount, dev) != hipSuccess) { grid = -1; return; }
        if (hipFuncSetAttribute((const void*)hymba_fwd, hipFuncAttributeMaxDynamicSharedMemorySize, LDS_BYTES) != hipSuccess) { fprintf(stderr, "kernel_launch: hipFuncSetAttribute failed\n"); grid = -1; return; }
        if (hipOccupancyMaxActiveBlocksPerMultiprocessor(&per_cu, (const void*)hymba_fwd, 512, LDS_BYTES) != hipSuccess || per_cu < 1) fprintf(stderr, "kernel_launch: occupancy query reports %d\n", per_cu);
        (void)hipGetLastError();
        grid = cus;
        if (grid != 256) fprintf(stderr, "kernel_launch: %d CUs; this kernel is laid out for 256\n", grid);
    }
    if (grid != 256) return;
    (void)hipMemsetAsync((char*)d_ws + WS_CTL, 0, CTL_ZERO_BYTES, stream);
    Args a{};
    for (int i = 0; i < 22; ++i) a.in[i] = (const float*)d_in[i];
    a.out = (float*)d_out; a.ws = (unsigned char*)d_ws;
#if MK_LAUNCHES == 1
    a.ph_lo = 0; a.ph_hi = N_PHASES;
    hipLaunchKernelGGL(hymba_fwd, dim3(grid), dim3(512), LDS_BYTES, stream, a);
#else
    for (int p = 0; p < N_PHASES; ++p) { a.ph_lo = p; a.ph_hi = p + 1; hipLaunchKernelGGL(hymba_fwd, dim3(grid), dim3(512), LDS_BYTES, stream, a); }
#endif
}
```

```cpp
#include <hip/hip_runtime.h>
#include <cstdio>
#include <cstdint>
#ifndef MK_LAUNCHES
#define MK_LAUNCHES 1
#endif
#define REP_P0 1
#define REP_P1 1
#define REP_P2 1
#define REP_P3A 1
#define REP_P3B 1
#define REP_P4 1
#define REP_P5 1
#define REP_R1 1
#define REP_R2 1
#define REP_RS 1
#define REP_LOADER 1
#define REP_SCANNER 1
#define PROBE_SEL 0
#define PROBE_WAVE 0
#if PROBE_SEL
#define PROBE_VMWAIT() asm volatile("s_waitcnt vmcnt(0)" ::: "memory")
#define PROBE_DECL() unsigned long long pt_[6] = {0, 0, 0, 0, 0, 0}, pacc_[6] = {0, 0, 0, 0, 0, 0}; const unsigned long long pt0_ = __builtin_readcyclecounter(); pt_[5] = pt0_
#define PROBE_T(k) do { const unsigned long long n_ = __builtin_readcyclecounter(); pacc_[k] += n_ - pt_[5]; pt_[5] = n_; } while (0)
#define PROBE_END(w) do { if (F.blk == 37 && wave == (w) && (w) == PROBE_WAVE && lane == 0) { const unsigned long long tot_ = __builtin_readcyclecounter() - pt0_; \
    const float fr_ = PROBE_SEL == 9 ? (float)tot_ * 1e-6f : (float)pacc_[PROBE_SEL] / (float)tot_; __hip_atomic_store((float*)(F.ctl + 32), fr_, __ATOMIC_RELAXED, __HIP_MEMORY_SCOPE_AGENT); } } while (0)
#else
#define PROBE_VMWAIT() do {} while (0)
#define PROBE_DECL() do {} while (0)
#define PROBE_T(k) do {} while (0)
#define PROBE_END(w) do {} while (0)
#endif
__device__ const double ROPE_INV[64] = { 1, 0.86596432336006535, 0.74989420933245587, 0.64938163157621132, 0.56234132519034907, 0.48696752516586311, 0.42169650342858223, 0.36517412725483772, 0.31622776601683794, 0.27384196342643613, 0.23713737056616552, 0.20535250264571461, 0.17782794100389229, 0.15399265260594919, 0.1333521432163324, 0.11547819846894582, 0.10000000000000001, 0.086596432336006529, 0.074989420933245579, 0.064938163157621132, 0.056234132519034911, 0.048696752516586311, 0.042169650342858224, 0.036517412725483769, 0.031622776601683791, 0.027384196342643614, 0.023713737056616554, 0.02053525026457146, 0.017782794100389229, 0.015399265260594919, 0.013335214321633241, 0.011547819846894581, 0.01, 0.0086596432336006543, 0.0074989420933245579, 0.006493816315762113, 0.005623413251903491, 0.004869675251658631, 0.0042169650342858229, 0.0036517412725483771, 0.0031622776601683794, 0.0027384196342643613, 0.0023713737056616554, 0.002053525026457146, 0.0017782794100389228, 0.001539926526059492, 0.0013335214321633241, 0.0011547819846894581, 0.001, 0.00086596432336006539, 0.00074989420933245586, 0.00064938163157621134, 0.0005623413251903491, 0.0004869675251658631, 0.00042169650342858224, 0.0003651741272548377, 0.00031622776601683794, 0.00027384196342643611, 0.00023713737056616554, 0.00020535250264571461, 0.00017782794100389227, 0.00015399265260594919, 0.0001333521432163324, 0.00011547819846894582 };
namespace pg8 {
#define PG8_LAS __attribute__((address_space(3)))
typedef unsigned short bf16_t;
typedef short bf16x8 __attribute__((ext_vector_type(8)));
typedef float f32x4 __attribute__((ext_vector_type(4)));
typedef unsigned u32x4 __attribute__((ext_vector_type(4)));
constexpr int BM = 256, BK = 64, HALF = 128, HTB = HALF * BK * 2  , STAGE_BYTES = 8 * HTB, NXCD = 8, WGM = 8;

__host__ __device__ __forceinline__ int lds_byte(int r, int c) { const int st = (r >> 4) * 2 + (c >> 5), rr = r & 15, cc = c & 31, ob = rr * 64 + cc * 2; return st * 1024 + (ob ^ (((ob >> 9) & 1) << 5)); }
__host__ __device__ __forceinline__ void stage_rc(int b, int& R, int& C) { const int st = b / 1024, sb = b % 1024, swz = sb ^ (((sb >> 9) & 1) << 5); R = (st >> 1) * 16 + swz / 64; C = (st & 1) * 32 + (swz % 64) / 2; }
__host__ __device__ __forceinline__ int perm32(int rho) { const int n = rho >> 4, i = rho & 15; return 8 * (i >> 2) + 4 * n + (i & 3); }

struct Unit { int pm, pn; };
struct Gemm { const bf16_t* A; const bf16_t* Bt; int M, N, K; };

struct StaticOrder {
    int nM, nN, nwg, G, c;
    __host__ __device__ void init(int M, int N, int G_, int c_) { nM = M / BM; nN = N / BM; nwg = nM * nN; G = G_; c = c_; }
    __host__ __device__ bool next(int i, Unit& u) const {
        const long L = (long)i * G + c; if (L >= nwg) return false;
        int wgid = (int)L; { const int q = nwg / NXCD, r = nwg % NXCD, xcd = wgid % NXCD, off = wgid / NXCD; wgid = (xcd < r ? xcd * (q + 1) : r * (q + 1) + (xcd - r) * q) + off; }
        const int nig = WGM * nN, gid = wgid / nig, fm = gid * WGM, gsz = (nM - fm) < WGM ? (nM - fm) : WGM;
        u.pm = fm + ((wgid % nig) % gsz); u.pn = (wgid % nig) / gsz; return true;
    }
    __device__ __forceinline__ void a_ready(const Unit&) const {}
    __device__ __forceinline__ void done(const Unit&) const {}
};

__device__ __forceinline__ unsigned cvt_pk_bf16(float lo, float hi) { unsigned r; asm volatile("v_cvt_pk_bf16_f32 %0, %1, %2" : "=v"(r) : "v"(lo), "v"(hi)); return r; }
typedef float f32x2 __attribute__((ext_vector_type(2)));

struct EpiZ {
    static constexpr bool PERM = true, AFTER_DRAIN = false;
    bf16_t* ZB; bf16_t* ZA;
    __device__ __forceinline__ void operator()(const f32x4 (&acc)[2][2][4][2], const Unit& u, int wr, int wc, int fr, int fq) const {
        const int row0 = u.pm * BM + wr * 64 + fr;
        bf16_t* base; int ldc, colt;
        if (u.pn < 16) { base = ZB; ldc = 4096; colt = u.pn * BM; } else { base = ZA; ldc = 4352; colt = (u.pn - 16) * BM; }
        const int col0 = colt + wc * 32 + 8 * fq;
#pragma unroll
        for (int ai = 0; ai < 2; ++ai)
#pragma unroll
            for (int m = 0; m < 4; ++m) { const int row = row0 + ai * HALF + m * 16; bf16_t* rowp = base + (size_t)row * ldc + col0;
                if (row < 9280)
#pragma unroll
                for (int bj = 0; bj < 2; ++bj) { const f32x4 v0 = acc[ai][bj][m][0], v1 = acc[ai][bj][m][1];
                    u32x4 w; w.x = cvt_pk_bf16(v0[0], v0[1]); w.y = cvt_pk_bf16(v0[2], v0[3]); w.z = cvt_pk_bf16(v1[0], v1[1]); w.w = cvt_pk_bf16(v1[2], v1[3]);
                    *(u32x4*)(rowp + bj * HALF) = w; } }
    }
};
struct EpiY {
    static constexpr bool PERM = false, AFTER_DRAIN = false;
    const float* xp; const float* xs; float* out; float alpha;
    __device__ __forceinline__ void operator()(const f32x4 (&acc)[2][2][4][2], const Unit& u, int wr, int wc, int fr, int fq) const {
#pragma unroll
        for (int ai = 0; ai < 2; ++ai)
#pragma unroll
            for (int m = 0; m < 4; ++m) {
                const int zrow = u.pm * BM + ai * HALF + wr * 64 + m * 16 + fr; int yrow = -1;
                if (zrow < 8256) { const int b = zrow / 2064, t = zrow - b * 2064; if (t >= 16) yrow = b * 2048 + t - 16; }
                else if (zrow < 9280) yrow = zrow - 64;
                if (yrow >= 0) {
                    const float* xsrc = yrow < 8192 ? xp + (size_t)yrow * 2048 : xs + (size_t)(yrow - 8192) * 2048; float* o = out + (size_t)yrow * 2048;
#pragma unroll
                    for (int bj = 0; bj < 2; ++bj)
#pragma unroll
                        for (int n = 0; n < 2; ++n) { const int col = u.pn * BM + bj * HALF + wc * 32 + n * 16 + 4 * fq;
                            const f32x4 xv = *(const f32x4*)(xsrc + col); *(f32x4*)(o + col) = xv * alpha + acc[ai][bj][m][n]; }
                }
            }
    }
};
template <class Epi, class Sched, bool ALIGN_EPI = false, bool SP2 = false>
__device__ __forceinline__ void gemm_phase(PG8_LAS unsigned char* lds, const Gemm g, const Sched& S, const Epi& E) {
    const int tid = threadIdx.x, wid = __builtin_amdgcn_readfirstlane(tid >> 6), lane = tid & 63, wr = wid >> 2, wc = wid & 3, fr = lane & 15, fq = lane >> 4;
    const int K = g.K, nt = K / BK;
    unsigned voffA[2], voffB[2];
#pragma unroll
    for (int i = 0; i < 2; ++i) { int R, C; stage_rc(tid * 16 + i * 8192, R, C); const int Rb = Epi::PERM ? ((R & ~31) + perm32(R & 31)) : R;
        voffA[i] = (unsigned)(R * K + C) * 2u; voffB[i] = (unsigned)(Rb * K + C) * 2u; }
    const size_t kstep = (size_t)(BK * 2);
    const size_t hstep = (size_t)HALF * K * 2;
    const size_t tstep = 2 * hstep;
    const unsigned ldsw = (unsigned)wid * 1024u;
    const int aoff = lds_byte(wr * 64 + fr, fq * 8), boff = lds_byte(wc * 32 + fr, fq * 8);
#define PG8_SA(b, h) (((b) * 2 + (h)) * HTB)
#define PG8_SB(b, h) ((4 + (b) * 2 + (h)) * HTB)
#define PG8_STAGE(bufoff, gbase, voff) do { _Pragma("unroll") for (int _i = 0; _i < 2; ++_i) \
        __builtin_amdgcn_global_load_lds((const unsigned*)((const char*)(gbase) + (voff)[_i]), (PG8_LAS unsigned*)(lds + (bufoff) + ldsw + _i * 8192), 16, 0, 0); } while (0)
#define PG8_LDA(dst, b, h) do { _Pragma("unroll") for (int m = 0; m < 4; ++m) _Pragma("unroll") for (int k = 0; k < 2; ++k) dst[m][k] = *(const PG8_LAS bf16x8*)(lds + PG8_SA(b, h) + aoff + m * 2048 + k * 1024); } while (0)
#define PG8_LDB(dst, b, h) do { _Pragma("unroll") for (int n = 0; n < 2; ++n) _Pragma("unroll") for (int k = 0; k < 2; ++k) dst[n][k] = *(const PG8_LAS bf16x8*)(lds + PG8_SB(b, h) + boff + n * 2048 + k * 1024); } while (0)
#define PG8_MMA(ai, bj, At, Bt) do { __builtin_amdgcn_s_setprio(1); _Pragma("unroll") for (int m = 0; m < 4; ++m) _Pragma("unroll") for (int n = 0; n < 2; ++n) _Pragma("unroll") for (int k = 0; k < 2; ++k) \
        acc[ai][bj][m][n] = __builtin_amdgcn_mfma_f32_16x16x32_bf16(Bt[n][k], At[m][k], acc[ai][bj][m][n], 0, 0, 0); __builtin_amdgcn_s_setprio(0); } while (0)
#define PG8_WAIT_V(n) asm volatile("s_waitcnt vmcnt(" #n ")" ::: "memory")
#define PG8_WAIT_L(n) asm volatile("s_waitcnt lgkmcnt(" #n ")" ::: "memory")
#define PG8_BAR __builtin_amdgcn_s_barrier()
#define PG8_SCHED __builtin_amdgcn_sched_barrier(0)
    Unit cur, nxt; int ui = 0;
    if (!S.next(0, cur)) return;
    f32x4 acc[2][2][4][2];
#pragma unroll
    for (int a = 0; a < 2; ++a)
#pragma unroll
        for (int b = 0; b < 2; ++b)
#pragma unroll
            for (int m = 0; m < 4; ++m)
#pragma unroll
                for (int n = 0; n < 2; ++n) acc[a][b][m][n] = (f32x4){0.f, 0.f, 0.f, 0.f};
    bf16x8 At[4][2], B0[2][2], B1[2][2];
    const char* cA = (const char*)g.A + (size_t)cur.pm * tstep; const char* cB = (const char*)g.Bt + (size_t)cur.pn * tstep;
    S.a_ready(cur);
    if constexpr (SP2) {
        PG8_STAGE(PG8_SB(0, 0), cB, voffB); PG8_STAGE(PG8_SB(0, 1), cB + hstep, voffB); PG8_STAGE(PG8_SA(0, 0), cA, voffA); PG8_STAGE(PG8_SA(0, 1), cA + hstep, voffA);
        if (wr == 1) PG8_BAR;
        PG8_WAIT_V(2); PG8_BAR;
        PG8_STAGE(PG8_SB(1, 0), cB + kstep, voffB); PG8_STAGE(PG8_SA(1, 0), cA + kstep, voffA); PG8_STAGE(PG8_SB(1, 1), cB + hstep + kstep, voffB);
        PG8_WAIT_V(6); PG8_BAR;
    } else {
        PG8_STAGE(PG8_SB(0, 0), cB, voffB); PG8_STAGE(PG8_SA(0, 0), cA, voffA); PG8_STAGE(PG8_SB(0, 1), cB + hstep, voffB); PG8_STAGE(PG8_SA(0, 1), cA + hstep, voffA);
        if (wr == 1) PG8_BAR;
        PG8_WAIT_V(4); PG8_BAR;
        PG8_STAGE(PG8_SB(1, 0), cB + kstep, voffB); PG8_STAGE(PG8_SA(1, 0), cA + kstep, voffA); PG8_STAGE(PG8_SB(1, 1), cB + hstep + kstep, voffB);
        PG8_WAIT_V(6); PG8_BAR;
    }
    for (;;) {
        const bool has_next = S.next(ui + 1, nxt);
        const char* nA = has_next ? (const char*)g.A + (size_t)nxt.pm * tstep : cA; const char* nB = has_next ? (const char*)g.Bt + (size_t)nxt.pn * tstep : cB;
        for (int t = 0; t < nt; t += 2) {
            const bool last = (t == nt - 2);
            const char* a1 = cA + (size_t)(t + 1) * kstep;
            const char* a2 = last ? nA : cA + (size_t)(t + 2) * kstep; const char* b2 = last ? nB : cB + (size_t)(t + 2) * kstep;
            const char* a3 = a2 + kstep; const char* b3 = b2 + kstep;
            if (last && has_next) S.a_ready(nxt);
            if constexpr (SP2) {
            PG8_LDB(B0, 0, 0); PG8_LDB(B1, 0, 1); PG8_SCHED; PG8_LDA(At, 0, 0); PG8_STAGE(PG8_SA(1, 1), a1 + hstep, voffA);
            PG8_WAIT_V(8); PG8_WAIT_L(0); PG8_BAR; PG8_MMA(0, 0, At, B0); PG8_MMA(0, 1, At, B1); PG8_BAR; PG8_SCHED;
            PG8_LDA(At, 0, 1); PG8_STAGE(PG8_SB(0, 0), b2, voffB); PG8_STAGE(PG8_SB(0, 1), b2 + hstep, voffB); PG8_STAGE(PG8_SA(0, 0), a2, voffA);
            PG8_WAIT_V(8); PG8_WAIT_L(0); PG8_BAR; PG8_MMA(1, 0, At, B0); PG8_MMA(1, 1, At, B1); PG8_BAR; PG8_SCHED;
            PG8_LDB(B0, 1, 0); PG8_LDB(B1, 1, 1); PG8_SCHED; PG8_LDA(At, 1, 0); PG8_STAGE(PG8_SA(0, 1), a2 + hstep, voffA);
            PG8_WAIT_V(8); PG8_WAIT_L(0); PG8_BAR; PG8_MMA(0, 0, At, B0); PG8_MMA(0, 1, At, B1); PG8_BAR; PG8_SCHED;
            PG8_LDA(At, 1, 1); PG8_STAGE(PG8_SB(1, 0), b3, voffB); PG8_STAGE(PG8_SB(1, 1), b3 + hstep, voffB); PG8_STAGE(PG8_SA(1, 0), a3, voffA);
            PG8_WAIT_V(8); PG8_WAIT_L(0); PG8_BAR; PG8_MMA(1, 0, At, B0); PG8_MMA(1, 1, At, B1); PG8_BAR; PG8_SCHED;
            } else {
            PG8_LDB(B0, 0, 0); PG8_SCHED; PG8_LDA(At, 0, 0); PG8_STAGE(PG8_SA(1, 1), a1 + hstep, voffA);
            PG8_WAIT_L(8); PG8_BAR; PG8_WAIT_L(0); PG8_MMA(0, 0, At, B0); PG8_BAR; PG8_SCHED;
            PG8_LDB(B1, 0, 1); PG8_STAGE(PG8_SB(0, 0), b2, voffB);
            PG8_BAR; PG8_WAIT_L(0); PG8_MMA(0, 1, At, B1); PG8_BAR;
            PG8_LDA(At, 0, 1); PG8_STAGE(PG8_SA(0, 0), a2, voffA);
            PG8_BAR; PG8_WAIT_L(0); PG8_MMA(1, 0, At, B0); PG8_BAR; PG8_SCHED;
            PG8_STAGE(PG8_SB(0, 1), b2 + hstep, voffB);
            PG8_WAIT_V(6); PG8_BAR; PG8_MMA(1, 1, At, B1); PG8_BAR;
            PG8_LDB(B0, 1, 0); PG8_SCHED; PG8_LDA(At, 1, 0); PG8_STAGE(PG8_SA(0, 1), a2 + hstep, voffA);
            PG8_WAIT_L(8); PG8_BAR; PG8_WAIT_L(0); PG8_MMA(0, 0, At, B0); PG8_BAR; PG8_SCHED;
            PG8_LDB(B1, 1, 1); PG8_STAGE(PG8_SB(1, 0), b3, voffB);
            PG8_BAR; PG8_WAIT_L(0); PG8_MMA(0, 1, At, B1); PG8_BAR;
            PG8_LDA(At, 1, 1); PG8_STAGE(PG8_SA(1, 0), a3, voffA);
            PG8_BAR; PG8_WAIT_L(0); PG8_MMA(1, 0, At, B0); PG8_BAR; PG8_SCHED;
            PG8_STAGE(PG8_SB(1, 1), b3 + hstep, voffB);
            PG8_WAIT_V(6); PG8_BAR; PG8_MMA(1, 1, At, B1); PG8_BAR;
            }
        }
        if constexpr (ALIGN_EPI) { if (wr == 0) PG8_BAR; }
        if constexpr (!Epi::AFTER_DRAIN) { E(acc, cur, wr, wc, fr, fq); S.done(cur); }
        if (!has_next) break;
#pragma unroll
        for (int a = 0; a < 2; ++a)
#pragma unroll
            for (int b = 0; b < 2; ++b)
#pragma unroll
                for (int m = 0; m < 4; ++m)
#pragma unroll
                    for (int n = 0; n < 2; ++n) acc[a][b][m][n] = (f32x4){0.f, 0.f, 0.f, 0.f};
        cur = nxt; cA = nA; cB = nB; ++ui;
        if constexpr (ALIGN_EPI) { if (wr == 1) PG8_BAR; }
    }
    PG8_WAIT_V(0);
    if constexpr (!ALIGN_EPI) { if (wr == 0) PG8_BAR; }
    PG8_BAR;
    if constexpr (Epi::AFTER_DRAIN) { E.fused(acc, cur, wr, wc, fr, fq, lds, wid, lane); S.done(cur); }
#undef PG8_SA
#undef PG8_SB
#undef PG8_STAGE
#undef PG8_LDA
#undef PG8_LDB
#undef PG8_MMA
#undef PG8_WAIT_V
#undef PG8_WAIT_L
#undef PG8_BAR
#undef PG8_SCHED
}
}

#define LAS __attribute__((address_space(3)))
#define XB_TMO      128
#define XB_XCNT(j)  (256  + 64 * (j))
#define XB_XSUB(j)  (1280 + 64 * (j))
#define XB_XGEN(j)  (2304 + 64 * (j))
#define XB_TOP      3328
#define XB_TOPGEN   3392
#define XCD_BAR_WORDS 3456
#define XB_SPIN_CAP (1u << 18)

__device__ __forceinline__ unsigned xb_ld(unsigned* p)              { return __hip_atomic_load(p, __ATOMIC_RELAXED, __HIP_MEMORY_SCOPE_AGENT); }
__device__ __forceinline__ unsigned xb_add(unsigned* p, unsigned v) { return __hip_atomic_fetch_add(p, v, __ATOMIC_RELAXED, __HIP_MEMORY_SCOPE_AGENT); }
__device__ __forceinline__ unsigned xb_xcc_id() { return (unsigned)__builtin_amdgcn_s_getreg((3 << 11) | 20) & 0xFu; }
#define XB_SPIN(cond, bar) do { unsigned _sp = 0; while (cond) { __builtin_amdgcn_s_sleep(1); \
    if ((++_sp & 255u) == 0u) { if (xb_ld(&(bar)[XB_TMO])) break; if (_sp > XB_SPIN_CAP) { atomicAdd(&(bar)[XB_TMO], 1u); break; } } } } while (0)

struct XcdBarrier {
    unsigned* bar; unsigned x;
    volatile LAS unsigned* st;
};

__device__ __forceinline__ XcdBarrier xcd_barrier_post(unsigned* bar, volatile LAS unsigned* st) {
    XcdBarrier b; b.bar = bar; b.x = xb_xcc_id(); b.st = st;
    if (threadIdx.x == 0) (void)xb_add(&bar[XB_XCNT(b.x)], 1u);
    return b;
}
__device__ __forceinline__ void xcd_barrier_complete(unsigned* bar, unsigned x, unsigned& nloc, unsigned& nx) {
    const unsigned G = gridDim.x * gridDim.y * gridDim.z;
    unsigned sum, cnt, mine, sp = 0u;
    for (;;) {
        sum = 0u; cnt = 0u; mine = 0u;
#pragma unroll
        for (unsigned j = 0; j < 16; ++j) { const unsigned c = xb_ld(&bar[XB_XCNT(j)]); sum += c; cnt += (c > 0u) ? 1u : 0u; mine = (j == x) ? c : mine; }
        if (sum == G) break;
        __builtin_amdgcn_s_sleep(1);
        if ((++sp & 255u) == 0u) { if (xb_ld(&bar[XB_TMO])) break; if (sp > XB_SPIN_CAP) { atomicAdd(&bar[XB_TMO], 1u); break; } }
    }
    nloc = mine > 0u ? mine : 1u; nx = cnt > 0u ? cnt : 1u;
}

__device__ __forceinline__ void xcd_barrier(const XcdBarrier& b) {
    asm volatile("s_waitcnt vmcnt(0)" ::: "memory");
    __syncthreads();
    if (threadIdx.x == 0) {
        unsigned* bar = b.bar;
        __builtin_amdgcn_s_waitcnt(0);
        unsigned nloc = b.st[0], nx = b.st[1];
        if (nloc == 0u) { xcd_barrier_complete(bar, b.x, nloc, nx); b.st[0] = nloc; b.st[1] = nx; }
        const unsigned old = xb_add(&bar[XB_XSUB(b.x)], 1u);
        const unsigned gen = old / nloc;
        if (old + 1u == (gen + 1u) * nloc) {
            __builtin_amdgcn_fence(__ATOMIC_RELEASE, "agent");
            asm volatile("s_waitcnt vmcnt(0)" ::: "memory");
            const unsigned og = xb_add(&bar[XB_TOP], 1u);
            const unsigned tg = og / nx;
            if (og + 1u == (tg + 1u) * nx) xb_add(&bar[XB_TOPGEN], 1u);
            else XB_SPIN(xb_ld(&bar[XB_TOPGEN]) == tg, bar);
            __builtin_amdgcn_fence(__ATOMIC_ACQUIRE, "agent");
            xb_add(&bar[XB_XGEN(b.x)], 1u);
            asm volatile("s_waitcnt vmcnt(0)" ::: "memory");
        } else {
            XB_SPIN(xb_ld(&bar[XB_XGEN(b.x)]) == gen, bar);
            __builtin_amdgcn_fence(__ATOMIC_ACQUIRE, "agent");
            asm volatile("s_waitcnt vmcnt(0)" ::: "memory");
        }
    }
    __syncthreads();
}

constexpr int D_MODEL = 2048, TP = 2064  , MPR = 4 * TP  , MSA = 1024, MROWS = MPR + MSA  , MPAD = 9472;
constexpr int NA = 4224, NAP = 4352, NB = 4096, NPAD = NAP + NB  , YROWS = 9216;
constexpr float ALPHA = 1.189207115002721f;
constexpr float LN_EPS = 1e-5f, GN_EPS_A = 64e-5f, GN_EPS_B = 1e-5f;
constexpr size_t O_YP = 0, O_YS = 16777216, O_RWKVP = 18874368, O_SHIFTP = 19136512, O_RETP = 19153408, O_RWKVS = 19677696, O_SHIFTS = 28066304, O_RETS = 28606976, O_END = 45384192;
constexpr size_t WS_CTL = 0, CTL_ZERO_BYTES = 1u << 20;
constexpr size_t WS_ZB = 1u << 20;
constexpr size_t WS_ZA = WS_ZB + (size_t)MPAD * NB * 2;
constexpr size_t WS_WOUT = WS_ZA + (size_t)MPAD * NAP * 2;
constexpr size_t WS_ROPE = WS_WOUT + (size_t)2048 * 2048 * 2;
constexpr size_t WS_GATE = WS_ROPE + (size_t)2072 * 64 * 8;
constexpr size_t WS_BONUS = WS_GATE + (size_t)MROWS * 1024 * 2;
constexpr size_t WS_U = WS_BONUS + (size_t)MROWS * 1024 * 2;
constexpr size_t WS_LORA = WS_U + (size_t)256 * 16384 * 4;
constexpr int IMG_ROW = 16 * 6 * 64 * 2;
constexpr int IMG_SPLIT = 5461;
constexpr size_t WS_IMG2 = WS_LORA + 2 * 1024 * 64 * 2;
constexpr size_t WS_END = WS_IMG2 + (size_t)(MROWS - IMG_SPLIT) * IMG_ROW;
static_assert(WS_END <= 272629760, "d_ws map must fit 4 x the largest tensor");
static_assert((size_t)IMG_SPLIT * IMG_ROW <= 16777216ull * 4, "image part 1 must fit the ret_s region");
constexpr size_t OB_XB = 0;
constexpr size_t OB_WIN = O_RETS * 4;

constexpr int LDS_BYTES = 147456, MISC_OFF = 131072 + 320;
constexpr int CW_BAR = 4096;


typedef unsigned short bf16;
typedef unsigned v4u __attribute__((ext_vector_type(4)));
typedef unsigned v2u __attribute__((ext_vector_type(2)));
typedef float f32x4 __attribute__((ext_vector_type(4)));
typedef float f32x2 __attribute__((ext_vector_type(2)));
#define LDS_WAIT() asm volatile("s_waitcnt lgkmcnt(0)" ::: "memory")
__device__ __forceinline__ float bf2f(unsigned b) { return __uint_as_float(b << 16); }
__device__ __forceinline__ unsigned f2bf(float f) { unsigned u = __float_as_uint(f); return (u + 0x7fffu + ((u >> 16) & 1u)) >> 16; }
__device__ __forceinline__ unsigned pk2(float lo, float hi) { return f2bf(lo) | (f2bf(hi) << 16); }
__device__ __forceinline__ unsigned cvtpk(float lo, float hi) { unsigned r; asm("v_cvt_pk_bf16_f32 %0, %1, %2\n\ts_nop 1" : "=v"(r) : "v"(lo), "v"(hi)); return r; }
__device__ __forceinline__ float sigmoidf_(float x) { return __builtin_amdgcn_rcpf(1.0f + __expf(-x)); }
__device__ __forceinline__ float tanh_(float x) { return 1.0f - 2.0f * __builtin_amdgcn_rcpf(1.0f + __expf(2.0f * x)); }

template <int CTRL> __device__ __forceinline__ float dpp_f(float x) { return __builtin_bit_cast(float, __builtin_amdgcn_update_dpp(0, __builtin_bit_cast(int, x), CTRL, 0xf, 0xf, true)); }
__device__ __forceinline__ float allreduce4(float v) { v += dpp_f<0xB1>(v); v += dpp_f<0x4E>(v); return v; }
__device__ __forceinline__ float allreduce8(float v) { v = allreduce4(v); v += dpp_f<0x141>(v); return v; }
__device__ __forceinline__ float allreduce16(float v) { v = allreduce8(v); v += dpp_f<0x140>(v); return v; }
__device__ __forceinline__ float allreduce64(float v) { v = allreduce16(v); v += __shfl_xor(v, 16); v += __shfl_xor(v, 32); return v; }
__device__ __forceinline__ float reduce63(float v) {
    v = allreduce16(v);
    v += __builtin_bit_cast(float, __builtin_amdgcn_update_dpp(0, __builtin_bit_cast(int, v), 0x142, 0xa, 0xf, false));
    v += __builtin_bit_cast(float, __builtin_amdgcn_update_dpp(0, __builtin_bit_cast(int, v), 0x143, 0xc, 0xf, false));
    return v;
}

struct Args { const float* in[22]; float* out; unsigned char* ws; int ph_lo, ph_hi; };

struct Frame {
    LAS unsigned char* lds;
    int tid, lane, wave, G, blk;
    const float *x_prompt, *x_sample, *state_rwkv, *state_shift, *state_ret, *meta, *w_in, *w_out, *shift_mix, *w0, *w_up, *a0, *a_up, *k_k, *k_a, *r_k, *gn_a_g, *gn_a_b, *gn_b_g, *gn_b_b, *ln_g, *ln_b;
    float* out;
    bf16 *XB, *WINT, *ZB, *ZA, *MX, *WOUT, *GATE, *BONUS, *WUPT, *AUPT; unsigned char *IMG1, *IMG2;
    float *UB; f32x2* ROPE; unsigned* ctl;
};

__device__ __forceinline__ void p0_transpose_item(const float* W, int ldw, int k0, int srccol0, bf16* WT, int K, int dstrow0, LAS float* scr, int lane) {
#pragma unroll 8
    for (int i = 0; i < 32; ++i) { const int kk = 2 * i + (lane >> 5); scr[kk * 33 + (lane & 31)] = W[(size_t)(k0 + kk) * ldw + srccol0 + (lane & 31)]; }
    LDS_WAIT(); asm volatile("" ::: "memory");
    const int c = lane & 7;
#pragma unroll
    for (int j = 0; j < 4; ++j) { const int n = (lane >> 3) + 8 * j; const LAS float* s = scr + (8 * c) * 33 + n;
        v4u o; o.x = pk2(s[0 * 33], s[1 * 33]); o.y = pk2(s[2 * 33], s[3 * 33]); o.z = pk2(s[4 * 33], s[5 * 33]); o.w = pk2(s[6 * 33], s[7 * 33]);
        *(v4u*)(WT + (size_t)(dstrow0 + n) * K + k0 + 8 * c) = o; }
    LDS_WAIT(); asm volatile("" ::: "memory");
}
__device__ __forceinline__ void p0_prologue(const Frame& F) {
    LAS float* scr = (LAS float*)(F.lds + F.wave * 16384);
    const int gw = F.blk * 8 + F.wave, NGW = F.G * 8;
    constexpr int I_IN = 32 * 260, I_OUT = 32 * 64;
    for (int it = gw; it < I_IN + I_OUT; it += NGW) {
        if (it < I_IN) { const int kb = it / 260, nb = it % 260, d0 = 32 * nb, s0 = d0 < 4096 ? 4224 + d0 : d0 - 4096;
            p0_transpose_item(F.w_in, 8320, 64 * kb, s0, F.WINT, 2048, d0, scr, F.lane); }
        else { const int r = it - I_IN, kb = r / 64, nb = r % 64;
            p0_transpose_item(F.w_out, 2048, 64 * kb, 32 * nb, F.WOUT, 2048, 32 * nb, scr, F.lane); }
    }
    { v4u z = {0u, 0u, 0u, 0u}; v4u* p = (v4u*)(F.WINT + (size_t)8320 * 2048);
      for (int i = F.blk * 512 + F.tid; i < 128 * 2048 * 2 / 16; i += F.G * 512) p[i] = z; }
    for (int i = F.blk * 512 + F.tid; i < 129 * NAP; i += F.G * 512) { const int s = i / NAP, c = i - s * NAP;
        F.ZA[(size_t)(MROWS + s) * NAP + c] = (s < 128 && c < NA) ? (bf16)f2bf(F.state_shift[(size_t)s * NA + c]) : (bf16)0; }
    for (int i = F.blk * 512 + F.tid; i < 2 * 1024 * 64; i += F.G * 512) { const int m = i >> 16, c = (i >> 6) & 1023, k = i & 63;
        (m ? F.AUPT : F.WUPT)[c * 64 + k] = (bf16)f2bf((m ? F.a_up : F.w_up)[k * 1024 + c]); }
    for (int m = gw; m < MPAD; m += NGW) {
        const float* src = nullptr;
        if (m < MPR) { const int b = m / TP, t = m - b * TP; src = t < 16 ? F.meta + (size_t)t * 2048 : F.x_prompt + ((size_t)b * 2048 + (t - 16)) * 2048; }
        else if (m < MROWS) src = F.x_sample + (size_t)(m - MPR) * 2048;
        v2u* dst = (v2u*)(F.XB + (size_t)m * 2048);
#pragma unroll
        for (int j = 0; j < 8; ++j) { f32x4 v = {0.f, 0.f, 0.f, 0.f}; if (src) v = ((const f32x4*)src)[F.lane + 64 * j];
            v2u o; o.x = pk2(v.x, v.y); o.y = pk2(v.z, v.w); dst[F.lane + 64 * j] = o; }
    }
    for (int i = F.blk * 512 + F.tid; i < 2072 * 64; i += F.G * 512) {
        const int p = i >> 6, f = i & 63; const int pos = p < 2064 ? p : 16384 + (p - 2064);
        const double x = (double)pos * ROPE_INV[f];
        const double n = __builtin_rint(x * 0.15915494309189535);
        double r = __builtin_fma(-n, 6.283185307179586, x); r = __builtin_fma(-n, 2.4492935982947064e-16, r);
        const double r2 = r * r; double s = 1.0, c = 1.0;
#pragma unroll
        for (int k = 12; k >= 1; --k) { s = 1.0 - s * r2 * (1.0 / (double)((2 * k) * (2 * k + 1))); c = 1.0 - c * r2 * (1.0 / (double)((2 * k - 1) * (2 * k))); }
        f32x2 o; o.x = (float)c; o.y = (float)(r * s); F.ROPE[i] = o;
    }
}

typedef short bf16x8_ __attribute__((ext_vector_type(8)));
__device__ __forceinline__ unsigned char* img_row(const Frame& F, int row) { return row < IMG_SPLIT ? F.IMG1 + (size_t)row * IMG_ROW : F.IMG2 + (size_t)(row - IMG_SPLIT) * IMG_ROW; }
__device__ __forceinline__ f32x4 unpk4(const v2u& u) { f32x4 r; r.x = bf2f(u.x & 0xffffu); r.y = __uint_as_float(u.x & 0xffff0000u); r.z = bf2f(u.y & 0xffffu); r.w = __uint_as_float(u.y & 0xffff0000u); return r; }
__device__ __forceinline__ v2u pk4(const f32x4& v) { v2u o; o.x = cvtpk(v.x, v.y); o.y = cvtpk(v.z, v.w); return o; }
__device__ __forceinline__ f32x4 sig4(const f32x4& x) { f32x4 r; r.x = sigmoidf_(x.x); r.y = sigmoidf_(x.y); r.z = sigmoidf_(x.z); r.w = sigmoidf_(x.w); return r; }
__device__ __forceinline__ void shifted8(const Frame& F, int row, int prow, int col, float (&o)[8]) {
    const v4u c = *(const v4u*)(F.ZA + (size_t)row * NAP + col), p = *(const v4u*)(F.ZA + (size_t)prow * NAP + col); const f32x4 m0 = *(const f32x4*)(F.shift_mix + col), m1 = *(const f32x4*)(F.shift_mix + col + 4);
    v2u a = {c.x, c.y}, b = {c.z, c.w}, pa = {p.x, p.y}, pb = {p.z, p.w}; const f32x4 c0 = unpk4(a), c1 = unpk4(b), p0 = unpk4(pa), p1 = unpk4(pb); const f32x4 r0 = c0 + (p0 - c0) * m0, r1 = c1 + (p1 - c1) * m1;
    o[0] = r0.x; o[1] = r0.y; o[2] = r0.z; o[3] = r0.w; o[4] = r1.x; o[5] = r1.y; o[6] = r1.z; o[7] = r1.w;
}
__device__ __forceinline__ f32x4 shifted4(const Frame& F, int row, int prow, int col) {
    const f32x4 c = unpk4(*(const v2u*)(F.ZA + (size_t)row * NAP + col)), p = unpk4(*(const v2u*)(F.ZA + (size_t)prow * NAP + col));
    return c + (p - c) * *(const f32x4*)(F.shift_mix + col);
}
__device__ __forceinline__ int p2_prow(int row) { int prow = row - 1; if (row < MPR) { if (row % TP == 0) prow = MROWS + 128; } else { const int s = row - MPR; if ((s & 7) == 0) prow = MROWS + (s >> 3); } return prow; }
struct P2Half { f32x4 r, dw, kp, kk, a, v, gt; };
__device__ __forceinline__ void p2_half(const Frame& F, const v2u (&c)[4], const v2u (&p)[4], const f32x4& lgw, const f32x4& lga, int c0, P2Half& H, float& n2, float& cf) {
    const f32x4 cw0 = *(const f32x4*)(F.w0 + c0), ca0 = *(const f32x4*)(F.a0 + c0), ckk = *(const f32x4*)(F.k_k + c0), cka = *(const f32x4*)(F.k_a + c0), crk = *(const f32x4*)(F.r_k + c0),
                m0 = *(const f32x4*)(F.shift_mix + c0), m1 = *(const f32x4*)(F.shift_mix + 1024 + c0), m2 = *(const f32x4*)(F.shift_mix + 2048 + c0), m3 = *(const f32x4*)(F.shift_mix + 3072 + c0);
    const f32x4 cr = unpk4(c[0]), ck = unpk4(c[1]), cv = unpk4(c[2]), cg = unpk4(c[3]);
    const f32x4 r = cr + (unpk4(p[0]) - cr) * m0, k = ck + (unpk4(p[1]) - ck) * m1, v = cv + (unpk4(p[2]) - cv) * m2, gg = cg + (unpk4(p[3]) - cg) * m3;
    const f32x4 lw = sig4(lgw + cw0) * -0.6065306597126334f;
    f32x4 dw; dw.x = 1.0f - __expf(lw.x); dw.y = 1.0f - __expf(lw.y); dw.z = 1.0f - __expf(lw.z); dw.w = 1.0f - __expf(lw.w);
    const f32x4 sm = -(lw + 0.5f * lw * lw + 0.16666667f * lw * lw * lw);
    dw.x = lw.x > -0.01f ? sm.x : dw.x; dw.y = lw.y > -0.01f ? sm.y : dw.y; dw.z = lw.z > -0.01f ? sm.z : dw.z; dw.w = lw.w > -0.01f ? sm.w : dw.w;
    const f32x4 a = sig4(lga + ca0), kk = k * ckk, kp = k * (1.0f + (a - 1.0f) * cka), rk = r * kp * crk;
    n2 += (kk.x * kk.x + kk.y * kk.y) + (kk.z * kk.z + kk.w * kk.w); cf += (rk.x + rk.y) + (rk.z + rk.w);
    H.r = r; H.dw = dw; H.kp = kp; H.kk = kk; H.a = a; H.v = v; H.gt = gg * sig4(gg);
}
__device__ __forceinline__ v4u pk8(const f32x4& a, const f32x4& b) { v4u o; o.x = cvtpk(a.x, a.y); o.y = cvtpk(a.z, a.w); o.z = cvtpk(b.x, b.y); o.w = cvtpk(b.z, b.w); return o; }
constexpr int CH_W1T = 0, CH_RT = 2048, CH_BT = 4096, CH_KT = 6144, CH_VT = 8192, CH_NBT = 10240, CH_NKT = 10752, CH_MKT = 11264, CH_GAM = 11776;
__device__ __forceinline__ unsigned char* ch_ptr(const Frame& F, int unit) { return unit < IMG_SPLIT ? F.IMG1 + (size_t)unit * IMG_ROW : F.IMG2 + (size_t)(unit - IMG_SPLIT) * IMG_ROW; }
__device__ __forceinline__ f32x4 mm16(const LAS unsigned char* A, const LAS unsigned char* BT, int ri, int g) {
    v4u a = {0u, 0u, 0u, 0u}, b = a; if (g < 2) { a = *(const LAS v4u*)(A + ri * 32 + g * 16); b = *(const LAS v4u*)(BT + ri * 32 + g * 16); }
    f32x4 z = {0.f, 0.f, 0.f, 0.f}; return __builtin_amdgcn_mfma_f32_16x16x32_bf16(__builtin_bit_cast(bf16x8_, a), __builtin_bit_cast(bf16x8_, b), z, 0, 0, 0);
}
__device__ __forceinline__ void st16_rm(LAS unsigned char* X, const f32x4& v, int c, int g, float diag) {
    LAS bf16* x = (LAS bf16*)X; const int j0 = 4 * g;
    x[(j0 + 0) * 16 + c] = (bf16)f2bf(v.x + (j0 + 0 == c ? diag : 0.f)); x[(j0 + 1) * 16 + c] = (bf16)f2bf(v.y + (j0 + 1 == c ? diag : 0.f));
    x[(j0 + 2) * 16 + c] = (bf16)f2bf(v.z + (j0 + 2 == c ? diag : 0.f)); x[(j0 + 3) * 16 + c] = (bf16)f2bf(v.w + (j0 + 3 == c ? diag : 0.f));
}
__device__ __forceinline__ v2u pk16_t(const f32x4& v, int c, int g, float diag) {
    const int j0 = 4 * g; f32x4 w = v; w.x += (j0 == c ? diag : 0.f); w.y += (j0 + 1 == c ? diag : 0.f); w.z += (j0 + 2 == c ? diag : 0.f); w.w += (j0 + 3 == c ? diag : 0.f); return pk4(w);
}
__device__ __forceinline__ void p2_chunk(const Frame& F, LAS unsigned char* slab, int unit) {
    const int lane = F.lane, ri = lane & 15, g = lane >> 4;
    unsigned char* ch = ch_ptr(F, unit);
    LAS bf16* arr = (LAS bf16*)slab;
#define CB() asm volatile("" ::: "memory")
    CB();
    {
        float r[16], dw[16], kp[16], kk[16], b[16], v[16];
#pragma unroll
        for (int t = 0; t < 16; ++t) { r[t] = bf2f(arr[(0 * 16 + t) * 64 + lane]); dw[t] = bf2f(arr[(1 * 16 + t) * 64 + lane]); kp[t] = bf2f(arr[(2 * 16 + t) * 64 + lane]);
            kk[t] = bf2f(arr[(3 * 16 + t) * 64 + lane]); b[t] = bf2f(arr[(4 * 16 + t) * 64 + lane]); v[t] = bf2f(arr[(5 * 16 + t) * 64 + lane]); }
        float gam = 1.0f; float at[16], rt_[16], bh[16], kh[16];
#pragma unroll
        for (int t = 0; t < 16; ++t) { at[t] = gam * kk[t]; gam *= 1.0f - dw[t]; const float ig = __builtin_amdgcn_rcpf(gam); rt_[t] = gam * r[t]; bh[t] = b[t] * ig; kh[t] = kp[t] * ig; }
        LAS bf16* AT = (LAS bf16*)slab; LAS bf16* RT = (LAS bf16*)(slab + 2048); LAS bf16* BH = (LAS bf16*)(slab + 4096); LAS bf16* KH = (LAS bf16*)(slab + 6144);
        asm volatile("s_waitcnt lgkmcnt(0)" ::: "memory");
        bf16* gRT = (bf16*)(ch + CH_RT);
#pragma unroll
        for (int t = 0; t < 16; ++t) { AT[t * 64 + lane] = (bf16)f2bf(at[t]); const bf16 rv = (bf16)f2bf(rt_[t]); RT[t * 64 + lane] = rv; gRT[t * 64 + lane] = rv; BH[t * 64 + lane] = (bf16)f2bf(bh[t]); KH[t * 64 + lane] = (bf16)f2bf(kh[t]); }
        v4u a0, a1, b0, b1, k0, k1, v0, v1;
        a0.x = cvtpk(at[0], at[1]); a0.y = cvtpk(at[2], at[3]); a0.z = cvtpk(at[4], at[5]); a0.w = cvtpk(at[6], at[7]); a1.x = cvtpk(at[8], at[9]); a1.y = cvtpk(at[10], at[11]); a1.z = cvtpk(at[12], at[13]); a1.w = cvtpk(at[14], at[15]);
        *(LAS v4u*)(slab + 8192 + lane * 32) = a0; *(LAS v4u*)(slab + 8192 + lane * 32 + 16) = a1;
        b0.x = cvtpk(bh[0] * gam, bh[1] * gam); b0.y = cvtpk(bh[2] * gam, bh[3] * gam); b0.z = cvtpk(bh[4] * gam, bh[5] * gam); b0.w = cvtpk(bh[6] * gam, bh[7] * gam);
        b1.x = cvtpk(bh[8] * gam, bh[9] * gam); b1.y = cvtpk(bh[10] * gam, bh[11] * gam); b1.z = cvtpk(bh[12] * gam, bh[13] * gam); b1.w = cvtpk(bh[14] * gam, bh[15] * gam);
        k0.x = cvtpk(kh[0] * gam, kh[1] * gam); k0.y = cvtpk(kh[2] * gam, kh[3] * gam); k0.z = cvtpk(kh[4] * gam, kh[5] * gam); k0.w = cvtpk(kh[6] * gam, kh[7] * gam);
        k1.x = cvtpk(kh[8] * gam, kh[9] * gam); k1.y = cvtpk(kh[10] * gam, kh[11] * gam); k1.z = cvtpk(kh[12] * gam, kh[13] * gam); k1.w = cvtpk(kh[14] * gam, kh[15] * gam);
        v0.x = cvtpk(v[0], v[1]); v0.y = cvtpk(v[2], v[3]); v0.z = cvtpk(v[4], v[5]); v0.w = cvtpk(v[6], v[7]); v1.x = cvtpk(v[8], v[9]); v1.y = cvtpk(v[10], v[11]); v1.z = cvtpk(v[12], v[13]); v1.w = cvtpk(v[14], v[15]);
        *(v4u*)(ch + CH_BT + lane * 32) = b0; *(v4u*)(ch + CH_BT + lane * 32 + 16) = b1; *(v4u*)(ch + CH_KT + lane * 32) = k0; *(v4u*)(ch + CH_KT + lane * 32 + 16) = k1;
        *(v4u*)(ch + CH_VT + lane * 32) = v0; *(v4u*)(ch + CH_VT + lane * 32 + 16) = v1; ((float*)(ch + CH_GAM))[lane] = gam;
    }
    CB();
    LAS unsigned char* Mrm = slab + 10240; LAS unsigned char* MT = slab + 10752; LAS unsigned char* IM = slab + 11264; LAS unsigned char* Mkr = slab + 11776;
    LAS unsigned char* M2r = slab + 12288; LAS unsigned char* M2T = slab + 12800; LAS unsigned char* M2I = slab + 13312; LAS unsigned char* M4r = slab + 13824;
    LAS unsigned char* M4T = slab + 14336; LAS unsigned char* M4I = slab + 14848; LAS unsigned char* M8I = slab + 15360; LAS unsigned char* T1r = slab + 15872;
    LAS unsigned char* T2r = Mrm; LAS unsigned char* TT = MT;
    {
        f32x4 xb = {0.f, 0.f, 0.f, 0.f}, nb = xb, xk = xb, nk = xb;
#pragma unroll
        for (int s2 = 0; s2 < 2; ++s2) { const int o = ri * 128 + s2 * 64 + g * 16;
            const bf16x8_ fa = __builtin_bit_cast(bf16x8_, *(const LAS v4u*)(slab + o)), fr = __builtin_bit_cast(bf16x8_, *(const LAS v4u*)(slab + 2048 + o)),
                          fb = __builtin_bit_cast(bf16x8_, *(const LAS v4u*)(slab + 4096 + o)), fk = __builtin_bit_cast(bf16x8_, *(const LAS v4u*)(slab + 6144 + o));
            xb = __builtin_amdgcn_mfma_f32_16x16x32_bf16(fb, fa, xb, 0, 0, 0); nb = __builtin_amdgcn_mfma_f32_16x16x32_bf16(fb, fr, nb, 0, 0, 0);
            xk = __builtin_amdgcn_mfma_f32_16x16x32_bf16(fk, fa, xk, 0, 0, 0); nk = __builtin_amdgcn_mfma_f32_16x16x32_bf16(fk, fr, nk, 0, 0, 0); }
        const int j0 = 4 * g;
        xb.x = j0 < ri ? xb.x : 0.f; xb.y = j0 + 1 < ri ? xb.y : 0.f; xb.z = j0 + 2 < ri ? xb.z : 0.f; xb.w = j0 + 3 < ri ? xb.w : 0.f;
        xk.x = j0 < ri ? xk.x : 0.f; xk.y = j0 + 1 < ri ? xk.y : 0.f; xk.z = j0 + 2 < ri ? xk.z : 0.f; xk.w = j0 + 3 < ri ? xk.w : 0.f;
        nb.x = j0 <= ri ? nb.x : 0.f; nb.y = j0 + 1 <= ri ? nb.y : 0.f; nb.z = j0 + 2 <= ri ? nb.z : 0.f; nb.w = j0 + 3 <= ri ? nb.w : 0.f;
        nk.x = j0 <= ri ? nk.x : 0.f; nk.y = j0 + 1 <= ri ? nk.y : 0.f; nk.z = j0 + 2 <= ri ? nk.z : 0.f; nk.w = j0 + 3 <= ri ? nk.w : 0.f;
        st16_rm(Mrm, xb, ri, g, 0.f); *(LAS v2u*)(MT + ri * 32 + g * 8) = pk16_t(xb, ri, g, 0.f); st16_rm(IM, -xb, ri, g, 1.0f); st16_rm(Mkr, xk, ri, g, 0.f);
        *(v2u*)(ch + CH_NBT + ri * 32 + g * 8) = pk4(nb); *(v2u*)(ch + CH_NKT + ri * 32 + g * 8) = pk4(nk);
    }
    CB();
    {
        f32x4 x = mm16(Mrm, MT, ri, g); st16_rm(M2r, x, ri, g, 0.f); *(LAS v2u*)(M2T + ri * 32 + g * 8) = pk16_t(x, ri, g, 0.f); *(LAS v2u*)(M2I + ri * 32 + g * 8) = pk16_t(x, ri, g, 1.0f); CB();
        x = mm16(M2r, M2T, ri, g); st16_rm(M4r, x, ri, g, 0.f); *(LAS v2u*)(M4T + ri * 32 + g * 8) = pk16_t(x, ri, g, 0.f); *(LAS v2u*)(M4I + ri * 32 + g * 8) = pk16_t(x, ri, g, 1.0f); CB();
        x = mm16(M4r, M4T, ri, g); *(LAS v2u*)(M8I + ri * 32 + g * 8) = pk16_t(x, ri, g, 1.0f); CB();
        x = mm16(IM, M2I, ri, g); st16_rm(T1r, x, ri, g, 0.f); CB();
        x = mm16(T1r, M4I, ri, g); st16_rm(T2r, x, ri, g, 0.f); CB();
        x = mm16(T2r, M8I, ri, g); *(LAS v2u*)(TT + ri * 32 + g * 8) = pk16_t(x, ri, g, 0.f);
    }
    CB();
    {
        LAS bf16* W1T = (LAS bf16*)slab;
#pragma unroll
        for (int tau = 0; tau < 4; ++tau) { const f32x4 x = mm16(TT, slab + 8192 + tau * 512, ri, g);
            W1T[(4 * g + 0) * 64 + 16 * tau + ri] = (bf16)f2bf(x.x); W1T[(4 * g + 1) * 64 + 16 * tau + ri] = (bf16)f2bf(x.y); W1T[(4 * g + 2) * 64 + 16 * tau + ri] = (bf16)f2bf(x.z); W1T[(4 * g + 3) * 64 + 16 * tau + ri] = (bf16)f2bf(x.w); }
        float one = 1.0f; asm volatile("" : "+v"(one));
        const f32x4 y = mm16(Mkr, TT, ri, g) * one; *(v2u*)(ch + CH_MKT + ri * 32 + g * 8) = pk4(y);
        CB();
        *(v4u*)(ch + CH_W1T + lane * 32) = *(const LAS v4u*)(slab + lane * 32); *(v4u*)(ch + CH_W1T + lane * 32 + 16) = *(const LAS v4u*)(slab + lane * 32 + 16);
    }
    CB();
#undef CB
}
__device__ __forceinline__ void p2_pre(const Frame& F) {
    const int lane = F.lane, ri = lane & 15, wave = F.wave;
    LAS unsigned char* slab = F.lds + wave * 16384;
    LAS float* LG = (LAS float*)(slab + 12288);
    for (int u = F.blk * 8 + F.wave; u < 580 * 8; u += F.G * 8) {
        int g = lane >> 4; asm volatile("" : "+v"(g));
        const int rt = u >> 3, hg = u & 7; const bool prompt = rt < 516;
        bf16x8_ twf[2], zxf[2];
        { const int row = rt * 16 + ri, prow = p2_prow(row);
#pragma unroll
          for (int ks = 0; ks < 2; ++ks) { float t[8], z[8]; shifted8(F, row, prow, 4096 + 32 * ks + 8 * g, t); shifted8(F, row, prow, 4160 + 32 * ks + 8 * g, z);
            v4u a, b; a.x = cvtpk(tanh_(t[0]), tanh_(t[1])); a.y = cvtpk(tanh_(t[2]), tanh_(t[3])); a.z = cvtpk(tanh_(t[4]), tanh_(t[5])); a.w = cvtpk(tanh_(t[6]), tanh_(t[7]));
            b.x = cvtpk(z[0], z[1]); b.y = cvtpk(z[2], z[3]); b.z = cvtpk(z[4], z[5]); b.w = cvtpk(z[6], z[7]);
            twf[ks] = __builtin_bit_cast(bf16x8_, a); zxf[ks] = __builtin_bit_cast(bf16x8_, b); } }
#pragma unroll 1
        for (int hh = 0; hh < 2; ++hh) {
            const int h = hg * 2 + hh;
            f32x4 aw[4], aa[4];
            {
                v4u fw[4][2], fa[4][2];
#pragma unroll
                for (int t = 0; t < 4; ++t) { const size_t ao = (size_t)(h * 64 + 16 * t + ri) * 64 + 8 * g;
                    fw[t][0] = *(const v4u*)(F.WUPT + ao); fw[t][1] = *(const v4u*)(F.WUPT + ao + 32); fa[t][0] = *(const v4u*)(F.AUPT + ao); fa[t][1] = *(const v4u*)(F.AUPT + ao + 32); }
#pragma unroll
                for (int t = 0; t < 4; ++t) { aw[t] = (f32x4){0.f, 0.f, 0.f, 0.f}; aa[t] = aw[t];
                    aw[t] = __builtin_amdgcn_mfma_f32_16x16x32_bf16(__builtin_bit_cast(bf16x8_, fw[t][0]), twf[0], aw[t], 0, 0, 0); aw[t] = __builtin_amdgcn_mfma_f32_16x16x32_bf16(__builtin_bit_cast(bf16x8_, fw[t][1]), twf[1], aw[t], 0, 0, 0);
                    aa[t] = __builtin_amdgcn_mfma_f32_16x16x32_bf16(__builtin_bit_cast(bf16x8_, fa[t][0]), zxf[0], aa[t], 0, 0, 0); aa[t] = __builtin_amdgcn_mfma_f32_16x16x32_bf16(__builtin_bit_cast(bf16x8_, fa[t][1]), zxf[1], aa[t], 0, 0, 0); }
            }
            int cg = lane & 7; asm volatile("" : "+v"(cg));
#pragma unroll 1
            for (int ps = 0; ps < 2; ++ps) {
                if ((ri >> 3) == ps) {
#pragma unroll
                    for (int t = 0; t < 4; ++t) { *(LAS f32x4*)(LG + (ri & 7) * 64 + 16 * t + 4 * g) = aw[t]; *(LAS f32x4*)(LG + 512 + (ri & 7) * 64 + 16 * t + 4 * g) = aa[t]; } }
                const int rowi = 8 * ps + (lane >> 3), row = rt * 16 + rowi, prow = p2_prow(row), c0 = h * 64 + 8 * cg;
                const bf16* zc = F.ZA + (size_t)row * NAP + c0; const bf16* zp = F.ZA + (size_t)prow * NAP + c0;
                v4u cc[4], pp[4];
#pragma unroll
                for (int i = 0; i < 4; ++i) { cc[i] = *(const v4u*)(zc + 1024 * i); pp[i] = *(const v4u*)(zp + 1024 * i); }
                const LAS float* lg = LG + (lane >> 3) * 64 + 8 * cg;
                const f32x4 lw0 = *(const LAS f32x4*)lg, lw1 = *(const LAS f32x4*)(lg + 4), la0 = *(const LAS f32x4*)(lg + 512), la1 = *(const LAS f32x4*)(lg + 516);
                P2Half H0, H1; float n2 = 0.f, cf = 0.f;
                { const v2u c[4] = {{cc[0].x, cc[0].y}, {cc[1].x, cc[1].y}, {cc[2].x, cc[2].y}, {cc[3].x, cc[3].y}}, p[4] = {{pp[0].x, pp[0].y}, {pp[1].x, pp[1].y}, {pp[2].x, pp[2].y}, {pp[3].x, pp[3].y}};
                  p2_half(F, c, p, lw0, la0, c0, H0, n2, cf); }
                { const v2u c[4] = {{cc[0].z, cc[0].w}, {cc[1].z, cc[1].w}, {cc[2].z, cc[2].w}, {cc[3].z, cc[3].w}}, p[4] = {{pp[0].z, pp[0].w}, {pp[1].z, pp[1].w}, {pp[2].z, pp[2].w}, {pp[3].z, pp[3].w}};
                  p2_half(F, c, p, lw1, la1, c0 + 4, H1, n2, cf); }
                n2 = allreduce8(n2); cf = allreduce8(cf);
                const float inv = fminf(__builtin_amdgcn_rsqf(n2), 1e12f);
                const f32x4 k0 = H0.kk * inv, k1 = H1.kk * inv;
                const v4u o_r = pk8(H0.r, H1.r), o_w = pk8(H0.dw, H1.dw), o_k = pk8(H0.kp, H1.kp), o_kk = pk8(k0, k1), o_b = pk8(k0 * H0.a, k1 * H1.a), o_v = pk8(H0.v, H1.v);
                if (prompt) { LAS unsigned char* ar = slab + rowi * 128 + cg * 16;
                    *(LAS v4u*)ar = o_r; *(LAS v4u*)(ar + 2048) = o_w; *(LAS v4u*)(ar + 4096) = o_k; *(LAS v4u*)(ar + 6144) = o_kk; *(LAS v4u*)(ar + 8192) = o_b; *(LAS v4u*)(ar + 10240) = o_v; }
                else { unsigned char* ih = img_row(F, row) + h * 768 + cg * 16;
                    *(v4u*)ih = o_r; *(v4u*)(ih + 128) = o_w; *(v4u*)(ih + 256) = o_k; *(v4u*)(ih + 384) = o_kk; *(v4u*)(ih + 512) = o_b; *(v4u*)(ih + 640) = o_v; }
                const size_t o = (size_t)row * 1024 + c0; *(v4u*)(F.GATE + o) = pk8(H0.gt, H1.gt); *(v4u*)(F.BONUS + o) = pk8(H0.v * H0.gt * cf, H1.v * H1.gt * cf);
            }
            if (prompt) p2_chunk(F, slab, rt * 16 + h);
        }
    }
    for (int i = F.blk * 512 + F.tid; i < 132 * NA; i += F.G * 512) {
        const int s = i / NA, c = i - s * NA;
        if (s < 4) F.out[O_SHIFTP + (size_t)s * NA + c] = bf2f(F.ZA[(size_t)(s * TP + TP - 1) * NAP + c]);
        else F.out[O_SHIFTS + (size_t)(s - 4) * NA + c] = bf2f(F.ZA[(size_t)(MPR + (s - 4) * 8 + 7) * NAP + c]);
    }
}

constexpr int SC_PROMPT_CH = 129, SC_SAMPLE_CH = 32, SC_NCH = SC_PROMPT_CH + SC_SAMPLE_CH;
struct ScanDesc { int zrow0, nsteps, yrow0, first, last, h, q, sb, sample; };
__device__ __forceinline__ ScanDesc scan_desc(int blk, int ci) {
    ScanDesc d;
    if (ci < SC_PROMPT_CH) { const int b = blk >> 6; d.h = (blk >> 2) & 15; d.q = blk & 3; d.zrow0 = b * TP + ci * 16; d.nsteps = 16; d.yrow0 = b * 2048 + ci * 16 - 16;
        d.first = ci == 0; d.last = ci == SC_PROMPT_CH - 1; d.sample = 0; d.sb = b; }
    else { const int su = (ci - SC_PROMPT_CH) * 256 + blk; d.q = su & 3; d.h = (su >> 2) & 15; const int bs = su >> 6; d.zrow0 = MPR + bs * 8; d.nsteps = 8; d.yrow0 = 8192 + bs * 8;
        d.first = 1; d.last = 1; d.sample = 1; d.sb = bs; }
    return d;
}
struct ScanLoad { v2u a[6]; };
__device__ __forceinline__ void scan_issue(const Frame& F, const ScanDesc& d, int lw, ScanLoad& L) {
    const int s = 4 * lw + (F.lane >> 4); const int row = d.zrow0 + (s < d.nsteps ? s : 0);
    const unsigned char* p = img_row(F, row) + d.h * 768 + (F.lane & 15) * 8;
#pragma unroll
    for (int i = 0; i < 6; ++i) L.a[i] = *(const v2u*)(p + 128 * i);
}
__device__ __forceinline__ void scan_finish(const Frame& F, const ScanDesc& d, int lw, const ScanLoad& L, LAS float* sbuf) {
    const int s = 4 * lw + (F.lane >> 4), cg = F.lane & 15;
    if (s < d.nsteps) { LAS float* o = sbuf + s * 384 + 4 * cg;
        *(LAS f32x4*)o = unpk4(L.a[0]); *(LAS f32x4*)(o + 64) = 1.0f - unpk4(L.a[1]); *(LAS f32x4*)(o + 128) = unpk4(L.a[2]); *(LAS f32x4*)(o + 192) = unpk4(L.a[3]); *(LAS f32x4*)(o + 256) = unpk4(L.a[4]); *(LAS f32x4*)(o + 320) = unpk4(L.a[5]); }
}
struct StepIn { f32x2 r0, r1, w0, w1, k0, k1, kk0, kk1, b0, b1; float v; };
__device__ __forceinline__ StepIn ld_step(const LAS float* sb, int ks, int rw) {
    StepIn x; const f32x4 r = *(const LAS f32x4*)(sb + 4 * ks), w = *(const LAS f32x4*)(sb + 64 + 4 * ks), k = *(const LAS f32x4*)(sb + 128 + 4 * ks),
                          kk = *(const LAS f32x4*)(sb + 192 + 4 * ks), b = *(const LAS f32x4*)(sb + 256 + 4 * ks);
    x.r0 = r.xy; x.r1 = r.zw; x.w0 = w.xy; x.w1 = w.zw; x.k0 = k.xy; x.k1 = k.zw; x.kk0 = kk.xy; x.kk1 = kk.zw; x.b0 = b.xy; x.b1 = b.zw; x.v = sb[320 + rw]; return x;
}
__device__ __forceinline__ void p3_rwkv(const Frame& F, const int c0) {
    LAS float* SBUF = (LAS float*)F.lds;
    LAS float* OBUF = (LAS float*)(F.lds + 49152);
    const int lane = F.lane, wave = F.wave;
    if (wave < 4) {
        const int rs = lane >> 4, ks = lane & 15;
        f32x2 Sa = {0.f, 0.f}, Sb = {0.f, 0.f}; f32x4 Sn0 = {0.f, 0.f, 0.f, 0.f}, Sn1 = Sn0, Sn2 = Sn0, Sn3 = Sn0;
#define SC_STATE_PTR(c) (F.state_rwkv + ((size_t)(scan_desc(F.blk, (c)).sb * 16 + scan_desc(F.blk, (c)).h) * 64 + scan_desc(F.blk, (c)).q * 16 + wave * 4 + rs) * 64 + 4 * ks)
        Sn1 = *(const f32x4*)SC_STATE_PTR(SC_PROMPT_CH); Sn2 = *(const f32x4*)SC_STATE_PTR(SC_PROMPT_CH + 1); Sn3 = *(const f32x4*)SC_STATE_PTR(SC_PROMPT_CH + 2);
        __syncthreads();
        for (int ci = c0; ci < SC_NCH; ++ci) {
            const ScanDesc d = scan_desc(F.blk, ci); const int buf = ci & 1;
            const int rw = d.q * 16 + wave * 4 + rs;
            if (d.first) { if (d.sample) { const int m = ci & 3; const f32x4 Sn = m == 0 ? Sn0 : (m == 1 ? Sn1 : (m == 2 ? Sn2 : Sn3)); Sa = Sn.xy; Sb = Sn.zw; } else { Sa = (f32x2){0.f, 0.f}; Sb = (f32x2){0.f, 0.f}; } }
            if (ci >= SC_PROMPT_CH && ci + 3 < SC_NCH) { const f32x4 t = *(const f32x4*)SC_STATE_PTR(ci + 3); const int m = (ci + 3) & 3;
                if (m == 0) Sn0 = t; else if (m == 1) Sn1 = t; else if (m == 2) Sn2 = t; else Sn3 = t; }
            const LAS float* sb0 = SBUF + buf * (16 * 384); float oacc = 0.f;
            for (int s0 = 0; s0 < d.nsteps; s0 += 8) {
                const LAS float* sb = sb0 + s0 * 384; const int kss = ks - s0;
                StepIn q[3]; q[0] = ld_step(sb, ks, rw); q[1] = ld_step(sb + 384, ks, rw);
#pragma unroll
                for (int j = 0; j < 8; ++j) {
                    if (j + 2 < 8) q[(j + 2) % 3] = ld_step(sb + (j + 2) * 384, ks, rw);
                    const StepIn& x = q[j % 3];
                    const f32x2 p = Sa * x.kk0 + Sb * x.kk1; const float sa = allreduce16(p.x + p.y); const f32x2 nsa = {-sa, -sa}, vv = {x.v, x.v};
                    Sa = (Sa * x.w0 + vv * x.k0) + nsa * x.b0; Sb = (Sb * x.w1 + vv * x.k1) + nsa * x.b1;
                    const f32x2 po = Sa * x.r0 + Sb * x.r1; const float o = allreduce16(po.x + po.y);
                    oacc = (kss == j) ? o : oacc;
                }
            }
            OBUF[buf * 256 + ks * 16 + wave * 4 + rs] = oacc;
            if (d.last) { float* dst = d.sample ? F.out + O_RWKVS : F.out + O_RWKVP; f32x4 So = {Sa.x, Sa.y, Sb.x, Sb.y}; *(f32x4*)(dst + ((size_t)(d.sb * 16 + d.h) * 64 + rw) * 64 + 4 * ks) = So; }
            __syncthreads();
        }
        __syncthreads();
    } else {
        const int lw = wave - 4; ScanLoad L;
        { const ScanDesc d0 = scan_desc(F.blk, c0); scan_issue(F, d0, lw, L); scan_finish(F, d0, lw, L, SBUF + (c0 & 1) * (16 * 384)); asm volatile("" ::: "memory"); scan_issue(F, scan_desc(F.blk, c0 + 1 < SC_NCH ? c0 + 1 : SC_NCH - 1), lw, L); }
        __syncthreads();
        for (int ci = c0; ci < SC_NCH; ++ci) {
            if (ci + 1 < SC_NCH) scan_finish(F, scan_desc(F.blk, ci + 1), lw, L, SBUF + ((ci + 1) & 1) * (16 * 384));
            asm volatile("" ::: "memory");
            scan_issue(F, scan_desc(F.blk, ci + 2 < SC_NCH ? ci + 2 : SC_NCH - 1), lw, L);
            if (ci > c0) { const ScanDesc dp = scan_desc(F.blk, ci - 1); const int i = F.tid - 256, s = i >> 4, r = i & 15;
                if (s < dp.nsteps && (dp.sample || ci - 1 > 0)) F.out[(size_t)(dp.yrow0 + s) * 2048 + dp.h * 64 + dp.q * 16 + r] = OBUF[((ci - 1) & 1) * 256 + i]; }
            __syncthreads();
        }
        { const ScanDesc dp = scan_desc(F.blk, SC_NCH - 1); const int i = F.tid - 256, s = i >> 4, r = i & 15;
            if (s < dp.nsteps) F.out[(size_t)(dp.yrow0 + s) * 2048 + dp.h * 64 + dp.q * 16 + r] = OBUF[((SC_NCH - 1) & 1) * 256 + i]; }
        __syncthreads();
    }
}

constexpr int OPB_BYTES = 10752, OPB_VT = 8192, OPB_NB = 8704, OPB_NK = 9216, OPB_MK = 9728, OPB_GAM = 10240;
struct ChLoad { v4u a[3]; };
__device__ __forceinline__ void ch_issue(const Frame& F, int unit, int q, ChLoad& L) {
    const unsigned char* ch = ch_ptr(F, unit); const int i = F.tid - 256;
#pragma unroll
    for (int k = 0; k < 3; ++k) { const int pc = i + 256 * k; const unsigned char* src = ch;
        if (pc < 512) src = ch + pc * 16; else if (pc < 544) src = ch + CH_VT + q * 512 + (pc - 512) * 16; else if (pc < 640) src = ch + CH_NBT + (pc - 544) * 16; else if (pc < 656) src = ch + CH_GAM + (pc - 640) * 16;
        L.a[k] = *(const v4u*)src; }
}
__device__ __forceinline__ void ch_finish(const Frame& F, const ChLoad& L, LAS unsigned char* ob) {
    const int i = F.tid - 256;
#pragma unroll
    for (int k = 0; k < 3; ++k) { const int pc = i + 256 * k; if (pc < 656) *(LAS v4u*)(ob + pc * 16) = L.a[k]; }
}
__device__ __forceinline__ bf16x8_ frag2(const LAS unsigned char* p0, const LAS unsigned char* p1) { const v2u a = *(const LAS v2u*)p0, b = *(const LAS v2u*)p1; v4u u = {a.x, a.y, b.x, b.y}; return __builtin_bit_cast(bf16x8_, u); }
__device__ __forceinline__ void p3_rwkv_chunked(const Frame& F) {
    LAS unsigned char* OPB = F.lds;
    const int lane = F.lane, wave = F.wave, ri = lane & 15, g = lane >> 4;
    const int blk = (F.blk & 7) * 32 + (F.blk >> 3), b = blk >> 6, h = (blk >> 2) & 15, q = blk & 3;
    const int unit0 = b * 129 * 16 + h;
    if (wave < 4) {
        f32x4 S[4];
#pragma unroll
        for (int t = 0; t < 4; ++t) S[t] = (f32x4){0.f, 0.f, 0.f, 0.f};
        __syncthreads();
        for (int ci = 0; ci < 129; ++ci) {
            if (wave == 0) {
                const LAS unsigned char* ob = OPB + (ci & 1) * OPB_BYTES;
                bf16x8_ Sb[2];
#pragma unroll
                for (int s2 = 0; s2 < 2; ++s2) { v4u u; u.x = cvtpk(S[2 * s2].x, S[2 * s2].y); u.y = cvtpk(S[2 * s2].z, S[2 * s2].w); u.z = cvtpk(S[2 * s2 + 1].x, S[2 * s2 + 1].y); u.w = cvtpk(S[2 * s2 + 1].z, S[2 * s2 + 1].w); Sb[s2] = __builtin_bit_cast(bf16x8_, u); }
                const v2u v8 = *(const LAS v2u*)(ob + OPB_VT + ri * 32 + g * 8);
                f32x4 U = {0.f, 0.f, 0.f, 0.f}, O = U;
#pragma unroll
                for (int s2 = 0; s2 < 2; ++s2) { const LAS unsigned char* w1 = ob + ri * 128 + (32 * s2 + 4 * g) * 2;
                    U = __builtin_amdgcn_mfma_f32_16x16x32_bf16(frag2(w1, w1 + 32), Sb[s2], U, 0, 0, 0);
                    O = __builtin_amdgcn_mfma_f32_16x16x32_bf16(frag2(w1 + 2048, w1 + 2048 + 32), Sb[s2], O, 0, 0, 0); }
                { const v2u mk = *(const LAS v2u*)(ob + OPB_MK + ri * 32 + g * 8); v4u a = {mk.x, mk.y, 0u, 0u}, bb = {v8.x, v8.y, 0u, 0u};
                  U = __builtin_amdgcn_mfma_f32_16x16x32_bf16(__builtin_bit_cast(bf16x8_, a), __builtin_bit_cast(bf16x8_, bb), U, 0, 0, 0); }
                v4u uvw; uvw.x = cvtpk(-U.x, -U.y); uvw.y = cvtpk(-U.z, -U.w); uvw.z = v8.x; uvw.w = v8.y; const bf16x8_ UV = __builtin_bit_cast(bf16x8_, uvw);
                O = __builtin_amdgcn_mfma_f32_16x16x32_bf16(frag2(ob + OPB_NB + ri * 32 + g * 8, ob + OPB_NK + ri * 32 + g * 8), UV, O, 0, 0, 0);
#pragma unroll
                for (int t = 0; t < 4; ++t) { const int chn = 16 * t + ri; const f32x4 gv = *(const LAS f32x4*)(ob + OPB_GAM + (16 * t + 4 * g) * 4);
                    S[t] = __builtin_amdgcn_mfma_f32_16x16x32_bf16(frag2(ob + 4096 + chn * 32 + g * 8, ob + 6144 + chn * 32 + g * 8), UV, S[t] * gv, 0, 0, 0); }
                if (ci > 0) { float* o = F.out + (size_t)(b * 2048 + 16 * ci - 16 + 4 * g) * 2048 + h * 64 + q * 16 + ri; o[0] = O.x; o[2048] = O.y; o[4096] = O.z; o[6144] = O.w; }
            }
            __syncthreads();
        }
        if (wave == 0) { float* dst = F.out + O_RWKVP + ((size_t)(b * 16 + h) * 64 + q * 16 + ri) * 64 + 4 * g;
#pragma unroll
            for (int t = 0; t < 4; ++t) *(f32x4*)(dst + 16 * t) = S[t]; }
        __syncthreads();
    } else {
        ChLoad L;
        ch_issue(F, unit0, q, L); ch_finish(F, L, OPB); asm volatile("" ::: "memory"); ch_issue(F, unit0 + 16, q, L);
        __syncthreads();
        for (int ci = 0; ci < 129; ++ci) {
            if (ci + 1 < 129) ch_finish(F, L, OPB + ((ci + 1) & 1) * OPB_BYTES);
            asm volatile("" ::: "memory");
            ch_issue(F, unit0 + 16 * (ci + 2 < 129 ? ci + 2 : 128), q, L);
            __syncthreads();
        }
        __syncthreads();
    }
}
typedef short bf16x8 __attribute__((ext_vector_type(8)));
typedef float f32x16 __attribute__((ext_vector_type(16)));
#define MFMA32(a, b, c) __builtin_amdgcn_mfma_f32_32x32x16_bf16(a, b, c, 0, 0, 0)
constexpr int R_QS = 0, R_KS = 64 * 272, R_KT = 2 * 64 * 272, R_VT = R_KT + 128 * 144, R_END = R_VT + 128 * 144;
__device__ __forceinline__ int tr_off(int R, int tok) { return R * 144 + ((((tok >> 3) ^ (R >> 3)) & 7) << 4) + (tok & 7) * 2; }
__device__ __forceinline__ void rot8(const v4u& x1, const v4u& x2, const f32x4 (&cs)[4], float (&r1)[8], float (&r2)[8]) {
    const unsigned a_[4] = {x1.x, x1.y, x1.z, x1.w}, b_[4] = {x2.x, x2.y, x2.z, x2.w};
#pragma unroll
    for (int p = 0; p < 4; ++p) { const float a0 = bf2f(a_[p] & 0xffffu), a1 = __uint_as_float(a_[p] & 0xffff0000u), b0 = bf2f(b_[p] & 0xffffu), b1 = __uint_as_float(b_[p] & 0xffff0000u);
        const float c0 = cs[p].x, s0 = cs[p].y, c1 = cs[p].z, s1 = cs[p].w;
        r1[2 * p] = a0 * c0 - b0 * s0; r2[2 * p] = a0 * s0 + b0 * c0; r1[2 * p + 1] = a1 * c1 - b1 * s1; r2[2 * p + 1] = a1 * s1 + b1 * c1; }
}
template <bool WITH_Q>
__device__ __forceinline__ void ret_stage(const Frame& F, LAS unsigned char* L, int zrow0, int pidx0, int t0, int h, float lg2) {
    const int tid = F.tid;
    if (tid < 256) {
        const bool isq = tid >= 128;
        if (!isq || WITH_Q) {
            const int tt = tid & 127, jq = tt >> 3, dg = tt & 7; const int colbase = (isq ? 0 : 1024) + h * 128 + 8 * dg;
#pragma unroll
            for (int up = 0; up < 2; ++up) {
                float r1[2][8], r2[2][8], st[2];
#pragma unroll
                for (int uu = 0; uu < 2; ++uu) {
                    const int j = 4 * jq + 2 * up + uu, t = t0 + j;
                    v4u x1 = {0u, 0u, 0u, 0u}, x2 = {0u, 0u, 0u, 0u}; f32x4 cs[4] = {{1.f, 0.f, 1.f, 0.f}, {1.f, 0.f, 1.f, 0.f}, {1.f, 0.f, 1.f, 0.f}, {1.f, 0.f, 1.f, 0.f}};
                    if (t >= 0) { const bf16* z = F.ZB + (size_t)(zrow0 + t) * NB + colbase; x1 = *(const v4u*)z; x2 = *(const v4u*)(z + 64);
                        const f32x4* rp = (const f32x4*)(F.ROPE + (size_t)(pidx0 + t) * 64 + 8 * dg); cs[0] = rp[0]; cs[1] = rp[1]; cs[2] = rp[2]; cs[3] = rp[3]; }
                    rot8(x1, x2, cs, r1[uu], r2[uu]);
                    const float srm = isq ? __builtin_amdgcn_exp2f((float)j * lg2) : __builtin_amdgcn_exp2f(-(float)j * lg2) * 0.08838834764831845f;
                    st[uu] = __builtin_amdgcn_exp2f((float)(63 - j) * lg2) * 0.08838834764831845f;
                    v4u w1, w2;
                    w1.x = cvtpk(r1[uu][0] * srm, r1[uu][1] * srm); w1.y = cvtpk(r1[uu][2] * srm, r1[uu][3] * srm); w1.z = cvtpk(r1[uu][4] * srm, r1[uu][5] * srm); w1.w = cvtpk(r1[uu][6] * srm, r1[uu][7] * srm);
                    w2.x = cvtpk(r2[uu][0] * srm, r2[uu][1] * srm); w2.y = cvtpk(r2[uu][2] * srm, r2[uu][3] * srm); w2.z = cvtpk(r2[uu][4] * srm, r2[uu][5] * srm); w2.w = cvtpk(r2[uu][6] * srm, r2[uu][7] * srm);
                    LAS unsigned char* rm = L + (isq ? R_QS : R_KS) + j * 272 + 16 * dg;
                    *(LAS v4u*)rm = w1; *(LAS v4u*)(rm + 128) = w2;
                }
                if (!isq) {
#pragma unroll
                    for (int e = 0; e < 8; ++e) {
                        *(LAS unsigned*)(L + R_KT + tr_off(8 * dg + e, 4 * jq + 2 * up)) = cvtpk(r1[0][e] * st[0], r1[1][e] * st[1]);
                        *(LAS unsigned*)(L + R_KT + tr_off(64 + 8 * dg + e, 4 * jq + 2 * up)) = cvtpk(r2[0][e] * st[0], r2[1][e] * st[1]); }
                }
            }
        }
    } else {
        const int tt = tid - 256, jq = tt >> 4, eg = tt & 15; v4u x[4];
#pragma unroll
        for (int u = 0; u < 4; ++u) { const int t = t0 + 4 * jq + u; x[u] = (v4u){0u, 0u, 0u, 0u};
            if (t >= 0) x[u] = *(const v4u*)(F.ZB + (size_t)(zrow0 + t) * NB + 2048 + h * 128 + 8 * eg); }
        const unsigned x0_[4] = {x[0].x, x[0].y, x[0].z, x[0].w}, x1_[4] = {x[1].x, x[1].y, x[1].z, x[1].w}, x2_[4] = {x[2].x, x[2].y, x[2].z, x[2].w}, x3_[4] = {x[3].x, x[3].y, x[3].z, x[3].w};
#pragma unroll
        for (int p = 0; p < 4; ++p) {
            v2u lo, hi;
            lo.x = (x0_[p] & 0xffffu) | (x1_[p] << 16); lo.y = (x2_[p] & 0xffffu) | (x3_[p] << 16);
            hi.x = (x0_[p] >> 16) | (x1_[p] & 0xffff0000u); hi.y = (x2_[p] >> 16) | (x3_[p] & 0xffff0000u);
            *(LAS v2u*)(L + R_VT + tr_off(8 * eg + 2 * p, 4 * jq)) = lo; *(LAS v2u*)(L + R_VT + tr_off(8 * eg + 2 * p + 1, 4 * jq)) = hi; }
    }
}
__device__ __forceinline__ bf16x8 pack8(const f32x16& v, int s, float sc) {
    v4u u;
    if (s == 0) { u.x = cvtpk(v[0] * sc, v[1] * sc); u.y = cvtpk(v[2] * sc, v[3] * sc); u.z = cvtpk(v[4] * sc, v[5] * sc); u.w = cvtpk(v[6] * sc, v[7] * sc); }
    else { u.x = cvtpk(v[8] * sc, v[9] * sc); u.y = cvtpk(v[10] * sc, v[11] * sc); u.z = cvtpk(v[12] * sc, v[13] * sc); u.w = cvtpk(v[14] * sc, v[15] * sc); }
    return __builtin_bit_cast(bf16x8, u);
}
__device__ __forceinline__ bf16x8 ld2x8(const LAS unsigned char* p0, const LAS unsigned char* p1) { const v2u a = *(const LAS v2u*)p0, b = *(const LAS v2u*)p1; v4u u = {a.x, a.y, b.x, b.y}; return __builtin_bit_cast(bf16x8, u); }
__device__ __forceinline__ bf16x8 ld16(const LAS unsigned char* p) { return __builtin_bit_cast(bf16x8, *(const LAS v4u*)p); }
__device__ __forceinline__ int ret_chunk_lo(int seg) { return seg == 0 ? 0 : 4 * seg + 1; }
__device__ __forceinline__ int ret_chunk_hi(int seg) { return 4 * seg + 5; }

__device__ __forceinline__ void ret_pass1(const Frame& F, float* UB) {
    LAS unsigned char* L = F.lds;
    const int blk = F.blk, b = blk >> 6, h = (blk >> 3) & 7, seg = blk & 7, lane = F.lane, wave = F.wave, r = lane & 31, hh = lane >> 5, et = wave & 3, dp = wave >> 2;
    const float gam = 1.0f - __builtin_ldexpf(1.0f, -5 - h), lg2 = __builtin_log2f(gam), g64 = __builtin_amdgcn_exp2f(64.0f * lg2);
    f32x16 S[2];
#pragma unroll
    for (int i = 0; i < 16; ++i) { S[0][i] = 0.f; S[1][i] = 0.f; }
    for (int cc = ret_chunk_lo(seg); cc < ret_chunk_hi(seg); ++cc) {
        ret_stage<false>(F, L, b * TP, 0, -48 + 64 * cc, h, lg2);
        __syncthreads();
#pragma unroll
        for (int d2 = 0; d2 < 2; ++d2) { const int dt = 2 * dp + d2;
#pragma unroll
            for (int i = 0; i < 16; ++i) S[d2][i] *= g64;
#pragma unroll
            for (int ks = 0; ks < 4; ++ks) S[d2] = MFMA32(ld16(L + R_KT + tr_off(32 * dt + r, 16 * ks + 8 * hh)), ld16(L + R_VT + tr_off(32 * et + r, 16 * ks + 8 * hh)), S[d2]); }
        __syncthreads();
    }
    float* U = UB + (size_t)blk * 16384;
#pragma unroll
    for (int d2 = 0; d2 < 2; ++d2)
#pragma unroll
        for (int i = 0; i < 16; ++i) U[(size_t)(32 * (2 * dp + d2) + (i & 3) + 8 * (i >> 2) + 4 * hh) * 128 + 32 * et + r] = S[d2][i];
}
__device__ __forceinline__ void ret_pass2(const Frame& F, const float* UB) {
    LAS unsigned char* L = F.lds;
    const int blk = F.blk, b = blk >> 6, h = (blk >> 3) & 7, seg = blk & 7, lane = F.lane, wave = F.wave, r = lane & 31, hh = lane >> 5, et = wave & 3, it = wave >> 2;
    const float gam = 1.0f - __builtin_ldexpf(1.0f, -5 - h), lg2 = __builtin_log2f(gam), g64 = __builtin_amdgcn_exp2f(64.0f * lg2), g256 = __builtin_amdgcn_exp2f(256.0f * lg2);
    f32x16 S[4];
#pragma unroll
    for (int dt = 0; dt < 4; ++dt)
#pragma unroll
        for (int i = 0; i < 16; ++i) S[dt][i] = 0.f;
    for (int sp = 0; sp < seg; ++sp) {
        const float* U = UB + (size_t)((blk & ~7) + sp) * 16384;
#pragma unroll
        for (int dt = 0; dt < 4; ++dt)
#pragma unroll
            for (int i = 0; i < 16; ++i) S[dt][i] = S[dt][i] * g256 + U[(size_t)(32 * dt + (i & 3) + 8 * (i >> 2) + 4 * hh) * 128 + 32 * et + r];
    }
    for (int cc = ret_chunk_lo(seg); cc < ret_chunk_hi(seg); ++cc) {
        const int t0 = -48 + 64 * cc;
        ret_stage<true>(F, L, b * TP, 0, t0, h, lg2);
        __syncthreads();
        f32x16 X[2], O; float one = 1.0f; asm volatile("" : "+v"(one));
#pragma unroll
        for (int i = 0; i < 16; ++i) { X[0][i] = 0.f; X[1][i] = 0.f; O[i] = 0.f; }
#pragma unroll
        for (int jt = 0; jt < 2; ++jt) if (jt <= it) {
#pragma unroll
            for (int ks = 0; ks < 8; ++ks) X[jt] = MFMA32(ld16(L + R_KS + (32 * jt + r) * 272 + (16 * ks + 8 * hh) * 2), ld16(L + R_QS + (32 * it + r) * 272 + (16 * ks + 8 * hh) * 2), X[jt]);
            if (jt == it) {
#pragma unroll
                for (int i = 0; i < 16; ++i) if ((i & 3) + 8 * (i >> 2) + 4 * hh > r) X[jt][i] = 0.f; }
        }
#pragma unroll
        for (int jt = 0; jt < 2; ++jt) if (jt <= it) {
#pragma unroll
            for (int s = 0; s < 2; ++s) { const LAS unsigned char* vb = L + R_VT;
                O = MFMA32(pack8(X[jt], s, one), ld2x8(vb + tr_off(32 * et + r, 32 * jt + 16 * s + 4 * hh), vb + tr_off(32 * et + r, 32 * jt + 16 * s + 8 + 4 * hh)), O); }
        }
#pragma unroll
        for (int dt = 0; dt < 4; ++dt)
#pragma unroll
            for (int s = 0; s < 2; ++s) { const LAS unsigned char* qb = L + R_QS + (32 * it + r) * 272 + (32 * dt + 16 * s + 4 * hh) * 2;
                O = MFMA32(ld2x8(qb, qb + 16), pack8(S[dt], s, gam), O); }
#pragma unroll
        for (int i = 0; i < 16; ++i) { const int t = t0 + 32 * it + (i & 3) + 8 * (i >> 2) + 4 * hh;
            if (t >= 16) F.out[(size_t)(b * 2048 + t - 16) * 2048 + 1024 + h * 128 + 32 * et + r] = O[i]; }
#pragma unroll
        for (int dt = 0; dt < 4; ++dt) {
#pragma unroll
            for (int i = 0; i < 16; ++i) S[dt][i] *= g64;
#pragma unroll
            for (int ks = 0; ks < 4; ++ks) S[dt] = MFMA32(ld16(L + R_KT + tr_off(32 * dt + r, 16 * ks + 8 * hh)), ld16(L + R_VT + tr_off(32 * et + r, 16 * ks + 8 * hh)), S[dt]); }
        __syncthreads();
    }
    if (seg == 7 && it == 0) { float* dst = F.out + O_RETP + (size_t)(b * 8 + h) * 16384;
#pragma unroll
        for (int dt = 0; dt < 4; ++dt)
#pragma unroll
            for (int i = 0; i < 16; ++i) dst[(size_t)(32 * dt + (i & 3) + 8 * (i >> 2) + 4 * hh) * 128 + 32 * et + r] = S[dt][i]; }
}

__device__ __forceinline__ void ret_sample(const Frame& F) {
    LAS float* QD = (LAS float*)F.lds;
    LAS float* QR = QD + 1024;
    LAS float* KR = QR + 1024;
    LAS float* KD = KR + 1024;
    LAS float* VV = KD + 1024;
    LAS float* SC = VV + 1024;
    LAS float* CP = SC + 64;
    const int tid = F.tid, lane = F.lane, wave = F.wave, e = tid & 127, dq = tid >> 7;
    for (int k = 0; k < 4; ++k) {
        const int u = F.blk + 256 * k, bs = u >> 3, h = u & 7;
        const float gam = 1.0f - __builtin_ldexpf(1.0f, -5 - h), lg2 = __builtin_log2f(gam);
        const float* S0 = F.state_ret + (size_t)u * 16384 + (size_t)(32 * dq) * 128 + e;
        float S[32];
#pragma unroll
        for (int d = 0; d < 32; ++d) S[d] = S0[(size_t)d * 128];
        {
            const int s = tid >> 6, i = tid & 63; const bf16* z = F.ZB + (size_t)(MPR + bs * 8 + s) * NB + h * 128 + i;
            const float q1 = bf2f(z[0]), q2 = bf2f(z[64]), k1 = bf2f(z[1024]) * 0.08838834764831845f, k2 = bf2f(z[1088]) * 0.08838834764831845f;
            const f32x2 cs = F.ROPE[(2064 + s) * 64 + i];
            const float qa = q1 * cs.x - q2 * cs.y, qb = q1 * cs.y + q2 * cs.x, ka = k1 * cs.x - k2 * cs.y, kb = k1 * cs.y + k2 * cs.x;
            const float gq = __builtin_amdgcn_exp2f((float)(s + 1) * lg2), gk = __builtin_amdgcn_exp2f((float)(7 - s) * lg2);
            QR[s * 128 + i] = qa; QR[s * 128 + 64 + i] = qb; QD[s * 128 + i] = qa * gq; QD[s * 128 + 64 + i] = qb * gq;
            KR[s * 128 + i] = ka; KR[s * 128 + 64 + i] = kb; KD[s * 128 + i] = ka * gk; KD[s * 128 + 64 + i] = kb * gk;
            VV[s * 128 + i] = bf2f(z[2048]); VV[s * 128 + 64 + i] = bf2f(z[2112]);
        }
        __syncthreads();
        for (int p = wave; p < 64; p += 8) { const int i = p >> 3, j = p & 7;
            if (j <= i) { float a = QR[i * 128 + lane] * KR[j * 128 + lane] + QR[i * 128 + 64 + lane] * KR[j * 128 + 64 + lane]; a = allreduce64(a);
                if (lane == 0) SC[p] = a * __builtin_amdgcn_exp2f((float)(i - j) * lg2); } }
        float cp[8], v[8];
#pragma unroll
        for (int i = 0; i < 8; ++i) { cp[i] = 0.f; v[i] = VV[i * 128 + e]; }
#pragma unroll
        for (int d4 = 0; d4 < 8; ++d4) {
#pragma unroll
            for (int i = 0; i < 8; ++i) { const f32x4 q = *(const LAS f32x4*)(QD + i * 128 + 32 * dq + 4 * d4);
                cp[i] += q.x * S[4 * d4] + q.y * S[4 * d4 + 1] + q.z * S[4 * d4 + 2] + q.w * S[4 * d4 + 3]; }
        }
#pragma unroll
        for (int i = 0; i < 8; ++i) CP[(dq * 8 + i) * 128 + e] = cp[i];
        const float g8 = __builtin_amdgcn_exp2f(8.0f * lg2);
        float* S1 = F.out + O_RETS + (size_t)u * 16384 + (size_t)(32 * dq) * 128 + e;
#pragma unroll
        for (int d4 = 0; d4 < 8; ++d4) {
            float n0 = S[4 * d4] * g8, n1 = S[4 * d4 + 1] * g8, n2 = S[4 * d4 + 2] * g8, n3 = S[4 * d4 + 3] * g8;
#pragma unroll
            for (int j = 0; j < 8; ++j) { const f32x4 kd = *(const LAS f32x4*)(KD + j * 128 + 32 * dq + 4 * d4); n0 += kd.x * v[j]; n1 += kd.y * v[j]; n2 += kd.z * v[j]; n3 += kd.w * v[j]; }
            S1[(size_t)(4 * d4) * 128] = n0; S1[(size_t)(4 * d4 + 1) * 128] = n1; S1[(size_t)(4 * d4 + 2) * 128] = n2; S1[(size_t)(4 * d4 + 3) * 128] = n3;
        }
        __syncthreads();
#pragma unroll
        for (int ii = 0; ii < 2; ++ii) { const int i = dq + 4 * ii;
            float o = CP[(0 * 8 + i) * 128 + e] + CP[(1 * 8 + i) * 128 + e] + CP[(2 * 8 + i) * 128 + e] + CP[(3 * 8 + i) * 128 + e];
#pragma unroll
            for (int j = 0; j < 8; ++j) if (j <= i) o += SC[i * 8 + j] * v[j];
            F.out[(size_t)(8192 + bs * 8 + i) * 2048 + 1024 + h * 128 + e] = o; }
        __syncthreads();
    }
}

__device__ __forceinline__ void p4_post(const Frame& F) {
    const int gw = F.blk * 8 + F.wave, NGW = F.G * 8, lane = F.lane;
    for (int yrow = gw; yrow < YROWS; yrow += NGW) {
        const int zrow = yrow < 8192 ? (yrow >> 11) * TP + (yrow & 2047) + 16 : MPR + (yrow - 8192);
        const float* orow = F.out + (size_t)yrow * 2048;
        {
            const int c0 = 16 * lane; f32x4 v[4]; float s = 0.f;
#pragma unroll
            for (int i = 0; i < 4; ++i) { v[i] = *(const f32x4*)(orow + c0 + 4 * i); s += (v[i].x + v[i].y) + (v[i].z + v[i].w); }
            const float mean = allreduce4(s) * (1.0f / 64.0f); float q = 0.f;
#pragma unroll
            for (int i = 0; i < 4; ++i) { v[i] = v[i] - mean; q += (v[i].x * v[i].x + v[i].y * v[i].y) + (v[i].z * v[i].z + v[i].w * v[i].w); }
            const float rstd = 1.0f / sqrtf(allreduce4(q) * (1.0f / 64.0f) + GN_EPS_A);
            const v4u* gp = (const v4u*)(F.GATE + (size_t)zrow * 1024 + c0); const v4u* bp = (const v4u*)(F.BONUS + (size_t)zrow * 1024 + c0);
            const v4u g0 = gp[0], g1 = gp[1], b0 = bp[0], b1 = bp[1];
            const unsigned gw_[8] = {g0.x, g0.y, g0.z, g0.w, g1.x, g1.y, g1.z, g1.w}, bw_[8] = {b0.x, b0.y, b0.z, b0.w, b1.x, b1.y, b1.z, b1.w};
            unsigned ow[8];
#pragma unroll
            for (int i = 0; i < 4; ++i) { const f32x4 gg = *(const f32x4*)(F.gn_a_g + c0 + 4 * i), gb = *(const f32x4*)(F.gn_a_b + c0 + 4 * i);
                const float y0 = (v[i].x * rstd * gg.x + gb.x) * bf2f(gw_[2 * i] & 0xffffu) + bf2f(bw_[2 * i] & 0xffffu);
                const float y1 = (v[i].y * rstd * gg.y + gb.y) * bf2f(gw_[2 * i] >> 16) + bf2f(bw_[2 * i] >> 16);
                const float y2 = (v[i].z * rstd * gg.z + gb.z) * bf2f(gw_[2 * i + 1] & 0xffffu) + bf2f(bw_[2 * i + 1] & 0xffffu);
                const float y3 = (v[i].w * rstd * gg.w + gb.w) * bf2f(gw_[2 * i + 1] >> 16) + bf2f(bw_[2 * i + 1] >> 16);
                ow[2 * i] = pk2(y0, y1); ow[2 * i + 1] = pk2(y2, y3); }
            v4u* mp = (v4u*)(F.MX + (size_t)zrow * 2048 + c0); v4u o0 = {ow[0], ow[1], ow[2], ow[3]}, o1 = {ow[4], ow[5], ow[6], ow[7]}; mp[0] = o0; mp[1] = o1;
        }
        {
            const int c0 = 16 * lane; f32x4 v[4]; float s = 0.f;
#pragma unroll
            for (int i = 0; i < 4; ++i) { v[i] = *(const f32x4*)(orow + 1024 + c0 + 4 * i); s += (v[i].x + v[i].y) + (v[i].z + v[i].w); }
            const float mean = allreduce8(s) * (1.0f / 128.0f); float q = 0.f;
#pragma unroll
            for (int i = 0; i < 4; ++i) { v[i] = v[i] - mean; q += (v[i].x * v[i].x + v[i].y * v[i].y) + (v[i].z * v[i].z + v[i].w * v[i].w); }
            const float rstd = 1.0f / sqrtf(allreduce8(q) * (1.0f / 128.0f) + GN_EPS_B);
            const v4u* gp = (const v4u*)(F.ZB + (size_t)zrow * NB + 3072 + c0); const v4u g0 = gp[0], g1 = gp[1];
            const unsigned gw_[8] = {g0.x, g0.y, g0.z, g0.w, g1.x, g1.y, g1.z, g1.w};
            unsigned ow[8];
#pragma unroll
            for (int i = 0; i < 4; ++i) { const f32x4 gg = *(const f32x4*)(F.gn_b_g + c0 + 4 * i), gb = *(const f32x4*)(F.gn_b_b + c0 + 4 * i);
                const float z0 = bf2f(gw_[2 * i] & 0xffffu), z1 = bf2f(gw_[2 * i] >> 16), z2 = bf2f(gw_[2 * i + 1] & 0xffffu), z3 = bf2f(gw_[2 * i + 1] >> 16);
                const float y0 = (v[i].x * rstd * gg.x + gb.x) * (z0 * sigmoidf_(z0)), y1 = (v[i].y * rstd * gg.y + gb.y) * (z1 * sigmoidf_(z1));
                const float y2 = (v[i].z * rstd * gg.z + gb.z) * (z2 * sigmoidf_(z2)), y3 = (v[i].w * rstd * gg.w + gb.w) * (z3 * sigmoidf_(z3));
                ow[2 * i] = pk2(y0, y1); ow[2 * i + 1] = pk2(y2, y3); }
            v4u* mp = (v4u*)(F.MX + (size_t)zrow * 2048 + 1024 + c0); v4u o0 = {ow[0], ow[1], ow[2], ow[3]}, o1 = {ow[4], ow[5], ow[6], ow[7]}; mp[0] = o0; mp[1] = o1;
        }
    }
}
__device__ __forceinline__ void p6_ln(const Frame& F) {
    const int gw = F.blk * 8 + F.wave, NGW = F.G * 8, lane = F.lane;
    for (int yrow = gw; yrow < YROWS; yrow += NGW) {
        f32x4* p = (f32x4*)(F.out + (size_t)yrow * 2048) + lane; f32x4 v[8]; float s = 0.f;
#pragma unroll
        for (int j = 0; j < 8; ++j) { v[j] = p[64 * j]; s += (v[j].x + v[j].y) + (v[j].z + v[j].w); }
        const float mean = allreduce64(s) * (1.0f / 2048.0f); float q = 0.f;
#pragma unroll
        for (int j = 0; j < 8; ++j) { v[j] = v[j] - mean; q += (v[j].x * v[j].x + v[j].y * v[j].y) + (v[j].z * v[j].z + v[j].w * v[j].w); }
        const float rstd = 1.0f / sqrtf(allreduce64(q) * (1.0f / 2048.0f) + LN_EPS);
        float pscale = 1.0f;
#if PROBE_SEL
        if (yrow >= 8192) { const float fr = __hip_atomic_load((float*)(F.ctl + 32), __ATOMIC_RELAXED, __HIP_MEMORY_SCOPE_AGENT); pscale = 1.0f + sqrtf(3e-5f + fr * 6.9e-5f); }
#endif
#pragma unroll
        for (int j = 0; j < 8; ++j) { const f32x4 g = ((const f32x4*)F.ln_g)[lane + 64 * j], b = ((const f32x4*)F.ln_b)[lane + 64 * j]; p[64 * j] = (v[j] * rstd * g + b) * pscale; }
    }
}

constexpr int N_PHASES = 8;
__global__ void __launch_bounds__(512, 2) hymba_fwd(Args args) {
    extern __shared__ __attribute__((aligned(16))) unsigned char lds[];
    Frame F;
    F.lds = (LAS unsigned char*)lds;
    F.tid = threadIdx.x; F.lane = F.tid & 63; F.wave = __builtin_amdgcn_readfirstlane(F.tid >> 6); F.G = gridDim.x; F.blk = blockIdx.x;
    F.x_prompt = args.in[0]; F.x_sample = args.in[1]; F.state_rwkv = args.in[2]; F.state_shift = args.in[3]; F.state_ret = args.in[4]; F.meta = args.in[5]; F.w_in = args.in[6]; F.w_out = args.in[7];
    F.shift_mix = args.in[8]; F.w0 = args.in[9]; F.w_up = args.in[10]; F.a0 = args.in[11]; F.a_up = args.in[12]; F.k_k = args.in[13]; F.k_a = args.in[14]; F.r_k = args.in[15];
    F.gn_a_g = args.in[16]; F.gn_a_b = args.in[17]; F.gn_b_g = args.in[18]; F.gn_b_b = args.in[19]; F.ln_g = args.in[20]; F.ln_b = args.in[21];
    F.out = args.out; unsigned char* ws = args.ws;
    F.XB = (bf16*)((unsigned char*)args.out + OB_XB); F.WINT = (bf16*)((unsigned char*)args.out + OB_WIN);
    F.ZB = (bf16*)(ws + WS_ZB); F.ZA = (bf16*)(ws + WS_ZA); F.MX = (bf16*)(ws + WS_ZA); F.WOUT = (bf16*)(ws + WS_WOUT); F.ROPE = (f32x2*)(ws + WS_ROPE);
    F.UB = (float*)(ws + WS_U); F.WUPT = (bf16*)(ws + WS_LORA); F.AUPT = F.WUPT + 1024 * 64; F.IMG1 = (unsigned char*)args.out + OB_WIN; F.IMG2 = ws + WS_IMG2; F.GATE = (bf16*)(ws + WS_GATE); F.BONUS = (bf16*)(ws + WS_BONUS);
    volatile LAS unsigned* MISC = (volatile LAS unsigned*)(F.lds + MISC_OFF);
    if (F.tid < 32) MISC[F.tid] = 0u;
    __syncthreads();
    unsigned* ctl = (unsigned*)(ws + WS_CTL); F.ctl = ctl;
    XcdBarrier bar = xcd_barrier_post(ctl + CW_BAR, MISC + 8);
    const int lo = args.ph_lo, hi = args.ph_hi;
#define IN(k) (lo <= (k) && (k) < hi)
#define SEAM(k) do { if (IN(k) && IN((k) + 1)) xcd_barrier(bar); } while (0)
    if (IN(0)) for (int rep = 0; rep < REP_P0; ++rep) p0_prologue(F);
    SEAM(0);
    if (IN(1)) for (int rep = 0; rep < REP_P1; ++rep) { pg8::Gemm g{F.XB, F.WINT, MPAD, NPAD, D_MODEL}; pg8::StaticOrder S; S.init(MPAD, NPAD, F.G, F.blk); pg8::EpiZ E{F.ZB, F.ZA};
        pg8::gemm_phase<pg8::EpiZ, pg8::StaticOrder, true, true>(F.lds, g, S, E); }
    SEAM(1);
    if (IN(2)) { for (int rep = 0; rep < REP_P2; ++rep) p2_pre(F); __syncthreads();
_Pragma("unroll 1") for (int rep = 0; rep < REP_R1; ++rep) ret_pass1(F, F.UB); }
    SEAM(2);
    if (IN(3)) {
_Pragma("unroll 1") for (int rep = 0; rep < REP_R2; ++rep) ret_pass2(F, F.UB);
        for (int rep = 0; rep < REP_P3A; ++rep) { p3_rwkv_chunked(F); p3_rwkv(F, SC_PROMPT_CH); } }
    SEAM(3);
    if (IN(4)) {
_Pragma("unroll 1") for (int rep = 0; rep < REP_RS; ++rep) ret_sample(F); }
    SEAM(4);
    if (IN(5)) for (int rep = 0; rep < REP_P4; ++rep) p4_post(F);
    SEAM(5);
    if (IN(6)) for (int rep = 0; rep < REP_P5; ++rep) { pg8::Gemm g{F.MX, F.WOUT, MPAD, D_MODEL, D_MODEL}; pg8::StaticOrder S; S.init(MPAD, D_MODEL, F.G, F.blk); pg8::EpiY E{F.x_prompt, F.x_sample, F.out, ALPHA};
        pg8::gemm_phase<pg8::EpiY, pg8::StaticOrder, true, true>(F.lds, g, S, E); }
    SEAM(6);
    if (IN(7)) p6_ln(F);
#undef IN
#undef SEAM
}

extern "C" void kernel_launch(void* const* d_in, const int* in_sizes, int n_in, void* d_out, int out_size, void* d_ws, size_t ws_size, hipStream_t stream) {
    static int grid = 0;
    if (grid == 0) {
        if (n_in != 22 || (size_t)out_size != O_END || ws_size < WS_END) { fprintf(stderr, "kernel_launch: unexpected shapes (n_in %d, out %d, ws %zu, need %zu); nothing launched\n", n_in, out_size, ws_size, (size_t)WS_END); grid = -1; return; }
        int dev = 0, cus = 0, per_cu = 0;
        if (hipGetDevice(&dev) != hipSuccess || hipDeviceGetAttribute(&cus, hipDeviceAttributeMultiprocessorCount, dev) != hipSuccess) { grid = -1; return; }
        if (hipFuncSetAttribute((const void*)hymba_fwd, hipFuncAttributeMaxDynamicSharedMemorySize, LDS_BYTES) != hipSuccess) { fprintf(stderr, "kernel_launch: hipFuncSetAttribute failed\n"); grid = -1; return; }
        if (hipOccupancyMaxActiveBlocksPerMultiprocessor(&per_cu, (const void*)hymba_fwd, 512, LDS_BYTES) != hipSuccess || per_cu < 1) fprintf(stderr, "kernel_launch: occupancy query reports %d\n", per_cu);
        (void)hipGetLastError();
        grid = cus;
        if (grid != 256) fprintf(stderr, "kernel_launch: %d CUs; this kernel is laid out for 256\n", grid);
    }
    if (grid != 256) return;
    (void)hipMemsetAsync((char*)d_ws + WS_CTL, 0, CTL_ZERO_BYTES, stream);
    Args a{};
    for (int i = 0; i < 22; ++i) a.in[i] = (const float*)d_in[i];
    a.out = (float*)d_out; a.ws = (unsigned char*)d_ws;
#if MK_LAUNCHES == 1
    a.ph_lo = 0; a.ph_hi = N_PHASES;
    hipLaunchKernelGGL(hymba_fwd, dim3(grid), dim3(512), LDS_BYTES, stream, a);
#else
    for (int p = 0; p < N_PHASES; ++p) { a.ph_lo = p; a.ph_hi = p + 1; hipLaunchKernelGGL(hymba_fwd, dim3(grid), dim3(512), LDS_BYTES, stream, a); }
#endif
}
```
